# Optimizing an MI355X kernel written in HIP

```python
import math
import jax, jax.numpy as jnp
from jax import lax
import numpy as np

D_MODEL = 1024
BATCH = 8
SEQ = 2048
DEPTH = 1
DEC_BATCH = 32
DEC_SEQ = 32
PAST_LEN = 4096

CHUNK = 64
Q_BLOCK = 128
D_INNER = 2 * D_MODEL
SSM_HEAD_DIM = 64
SSM_HEADS = D_INNER // SSM_HEAD_DIM
SSM_GROUPS = 8
HEADS_PER_GROUP = SSM_HEADS // SSM_GROUPS
SSM_STATE = 128
CONV_WIDTH = 4
CONV_DIM = D_INNER + 2 * SSM_GROUPS * SSM_STATE
MLA_HEADS = 16
QK_NOPE = 128
QK_ROPE = 64
V_HEAD = 128
Q_RANK = 512
KV_RANK = 512
ROPE_THETA = 10000.0
ATTN_SCALE = (QK_NOPE + QK_ROPE) ** -0.5
D_FF = 4 * D_MODEL
RMS_EPS = 1e-6
LN_EPS = 1e-5
ALPHA = (2 * DEPTH) ** 0.25
BETA = (8 * DEPTH) ** -0.25
IN_SPLITS = [2 * D_MODEL,
             2 * D_MODEL + D_INNER,
             2 * D_MODEL + D_INNER + CONV_DIM,
             2 * D_MODEL + D_INNER + CONV_DIM + SSM_HEADS,
             2 * D_MODEL + D_INNER + CONV_DIM + SSM_HEADS + Q_RANK]
IN_COLS = 2 * D_MODEL + D_INNER + CONV_DIM + SSM_HEADS + Q_RANK + KV_RANK + QK_ROPE

kernel_name = 'hybrid_ssd_mla_deepnorm_stream_step'


def _rmsnorm(t):
    tf = t.astype(jnp.float32)
    return (tf * lax.rsqrt(jnp.mean(tf * tf, axis=-1, keepdims=True) + RMS_EPS)).astype(t.dtype)


def _layernorm(t, g, b):
    tf = t.astype(jnp.float32)
    mu = jnp.mean(tf, axis=-1, keepdims=True)
    var = jnp.mean(jnp.square(tf - mu), axis=-1, keepdims=True)
    return ((tf - mu) * lax.rsqrt(var + LN_EPS)).astype(t.dtype) * g + b


def _rope(t, pos):
    inv = ROPE_THETA ** (-jnp.arange(0, QK_ROPE, 2, dtype=jnp.float32) / QK_ROPE)
    ang = pos.astype(jnp.float32)[:, None] * inv[None, :]
    cos = jnp.cos(ang)[None, :, None, :].astype(t.dtype)
    sin = jnp.sin(ang)[None, :, None, :].astype(t.dtype)
    t1, t2 = jnp.split(t, 2, axis=-1)
    return jnp.concatenate([t1 * cos - t2 * sin, t1 * sin + t2 * cos], axis=-1)


def _causal_conv(xbc, conv_state, conv_w, conv_b):
    L = xbc.shape[1]
    xp = jnp.concatenate([conv_state, xbc], axis=1)
    out = conv_b + sum(xp[:, k:k + L] * conv_w[k] for k in range(CONV_WIDTH))
    return jax.nn.silu(out), xp[:, L:]


def _ssd(xh, dt, a, bm, cm, s0, chunk):
    bsz, L = xh.shape[:2]
    nc = L // chunk

    def blocks(t):
        return jnp.moveaxis(t.reshape(bsz, nc, chunk, *t.shape[2:]), 1, 0)

    causal = jnp.tril(jnp.ones((chunk, chunk), dtype=bool))[None, :, :, None, None]

    def step(s, inp):
        xc, dtc, bc, cc = inp
        dtype = xc.dtype
        acum = jnp.cumsum((dtc * a).astype(jnp.float32), axis=1)
        seg = jnp.where(causal, acum[:, :, None] - acum[:, None, :], -jnp.inf)
        xdt = xc * dtc[..., None]
        cb = jnp.einsum('bign,bjgn->bijg', cc, bc)
        y = jnp.einsum('bijg,bijgr,bjgrp->bigrp', cb, jnp.exp(seg).astype(dtype), xdt)
        y = y + jnp.einsum('bign,bgrpn->bigrp', cc, s) * jnp.exp(acum).astype(dtype)[..., None]
        w_end = jnp.exp(acum[:, -1:] - acum).astype(dtype)
        s_new = (s * jnp.exp(acum[:, -1]).astype(dtype)[..., None, None]
                 + jnp.einsum('bjgr,bjgn,bjgrp->bgrpn', w_end, bc, xdt))
        return s_new.astype(s.dtype), y

    s_fin, ys = lax.scan(step, s0, (blocks(xh), blocks(dt), blocks(bm), blocks(cm)))
    return jnp.moveaxis(ys, 0, 1).reshape(xh.shape), s_fin


def _mla_attend(q_nope, q_pe, ckv, kpe, w_uk, w_uv, q_pos, k_pos):
    q_lat = jnp.einsum('bqhd,chd->bqhc', q_nope, w_uk)
    s = (jnp.einsum('bqhc,bkc->bhqk', q_lat, ckv)
         + jnp.einsum('bqhr,bkr->bhqk', q_pe, kpe)).astype(jnp.float32) * ATTN_SCALE
    mask = (k_pos[None, :] // CHUNK) <= (q_pos[:, None] // CHUNK)
    p = jax.nn.softmax(jnp.where(mask[None, None], s, -jnp.inf), axis=-1).astype(ckv.dtype)
    o_lat = jnp.einsum('bhqk,bkc->bqhc', p, ckv)
    return jnp.einsum('bqhc,chv->bqhv', o_lat, w_uv)


def _layer(x, pos0, lp, past):
    bsz, L, _ = x.shape
    dtype = x.dtype
    proj = x @ lp['w_in']
    gate_pre, z, xbc, dt_raw, q_a, kv_a = jnp.split(proj, IN_SPLITS, axis=-1)
    g_ssm, g_mla = jnp.split(jax.nn.sigmoid(gate_pre + lp['b_gate']), 2, axis=-1)
    pos = pos0 + jnp.arange(L, dtype=jnp.int32)

    if past is None:
        conv_state = jnp.zeros((bsz, CONV_WIDTH - 1, CONV_DIM), dtype)
        s0 = jnp.zeros((bsz, SSM_GROUPS, HEADS_PER_GROUP, SSM_HEAD_DIM, SSM_STATE), dtype)
        chunk = CHUNK
    else:
        conv_state = past['conv']
        s0 = past['ssm'].reshape(bsz, SSM_GROUPS, HEADS_PER_GROUP, SSM_HEAD_DIM, SSM_STATE)
        chunk = L
    xbc, conv_new = _causal_conv(xbc, conv_state, lp['conv_w'], lp['conv_b'])
    xs, bm, cm = jnp.split(xbc, [D_INNER, D_INNER + SSM_GROUPS * SSM_STATE], axis=-1)
    xh = xs.reshape(bsz, L, SSM_GROUPS, HEADS_PER_GROUP, SSM_HEAD_DIM)
    bm = bm.reshape(bsz, L, SSM_GROUPS, SSM_STATE)
    cm = cm.reshape(bsz, L, SSM_GROUPS, SSM_STATE)
    dt = jax.nn.softplus(dt_raw + lp['dt_bias']).reshape(bsz, L, SSM_GROUPS, HEADS_PER_GROUP)
    a = -jnp.exp(lp['a_log']).reshape(SSM_GROUPS, HEADS_PER_GROUP)
    yh, s_fin = _ssd(xh, dt, a, bm, cm, s0, chunk)
    yh = yh + xh * lp['d_skip'].reshape(SSM_GROUPS, HEADS_PER_GROUP, 1)
    yg = (yh.reshape(bsz, L, D_INNER) * jax.nn.silu(z)).reshape(bsz, L, SSM_GROUPS, D_INNER // SSM_GROUPS)
    yg = _rmsnorm(yg).reshape(bsz, L, D_INNER) * lp['ssm_norm_g']
    y_ssm = yg @ lp['w_ssm_proj']

    q = ((_rmsnorm(q_a) * lp['q_norm_g']) @ lp['w_q_b']).reshape(bsz, L, MLA_HEADS, QK_NOPE + QK_ROPE)
    q_nope, q_pe = jnp.split(q, [QK_NOPE], axis=-1)
    q_pe = _rope(q_pe, pos)
    ckv, kpe = jnp.split(kv_a, [KV_RANK], axis=-1)
    ckv = _rmsnorm(ckv) * lp['kv_norm_g']
    kpe = _rope(kpe[:, :, None, :], pos)[:, :, 0, :]
    if past is None:
        def block(i):
            q0 = i * Q_BLOCK
            return _mla_attend(lax.dynamic_slice_in_dim(q_nope, q0, Q_BLOCK, axis=1),
                               lax.dynamic_slice_in_dim(q_pe, q0, Q_BLOCK, axis=1),
                               ckv, kpe, lp['w_uk'], lp['w_uv'],
                               q0 + jnp.arange(Q_BLOCK, dtype=jnp.int32), pos)
        o = lax.map(block, jnp.arange(L // Q_BLOCK, dtype=jnp.int32))
        o = jnp.moveaxis(o, 0, 1).reshape(bsz, L, MLA_HEADS * V_HEAD)
    else:
        ckv_all = jnp.concatenate([past['ckv'], ckv], axis=1)
        kpe_all = jnp.concatenate([past['kpe'], kpe], axis=1)
        k_pos = jnp.arange(ckv_all.shape[1], dtype=jnp.int32)
        o = _mla_attend(q_nope, q_pe, ckv_all, kpe_all, lp['w_uk'], lp['w_uv'], pos, k_pos)
        o = o.reshape(bsz, L, MLA_HEADS * V_HEAD)
    y_mla = o @ lp['w_mla_proj']

    mix = (g_ssm * y_ssm + g_mla * y_mla) @ lp['w_out']
    h = _layernorm(ALPHA * x + mix, lp['ln1_g'], lp['ln1_b'])
    ff = jnp.square(jax.nn.relu(h @ lp['w_up'])) @ lp['w_down']
    y = _layernorm(ALPHA * h + ff, lp['ln2_g'], lp['ln2_b'])
    s_fin = s_fin.reshape(bsz, SSM_HEADS, SSM_HEAD_DIM, SSM_STATE)
    return y, ckv, kpe, s_fin, conv_new


def setup_inputs(seed: int = 0) -> dict:
    key = jax.random.key(seed)
    ks = jax.random.split(key, 32)
    f32 = jnp.float32
    nrm = lambda k, shape, s: jax.random.normal(k, shape, f32) * s
    dt0 = jnp.exp(jax.random.uniform(ks[8], (DEPTH, SSM_HEADS), f32) * (math.log(0.1) - math.log(0.001)) + math.log(0.001))
    return {
        'x_prompt': nrm(ks[0], (BATCH, SEQ, D_MODEL), 1.0),
        'x_sample': nrm(ks[1], (DEC_BATCH, DEC_SEQ, D_MODEL), 1.0),
        'cache_ckv': nrm(ks[2], (DEPTH, DEC_BATCH, PAST_LEN, KV_RANK), 1.0),
        'cache_kpe': nrm(ks[3], (DEPTH, DEC_BATCH, PAST_LEN, QK_ROPE), 1.0),
        'state_ssm': nrm(ks[4], (DEPTH, DEC_BATCH, SSM_HEADS, SSM_HEAD_DIM, SSM_STATE), 0.5),
        'state_conv': nrm(ks[5], (DEPTH, DEC_BATCH, CONV_WIDTH - 1, CONV_DIM), 1.0),
        'w_in': nrm(ks[6], (DEPTH, D_MODEL, IN_COLS), D_MODEL ** -0.5),
        'b_gate': nrm(ks[7], (DEPTH, 2 * D_MODEL), 0.02),
        'conv_w': nrm(ks[9], (DEPTH, CONV_WIDTH, CONV_DIM), CONV_WIDTH ** -0.5),
        'conv_b': nrm(ks[10], (DEPTH, CONV_DIM), 0.02),
        'dt_bias': dt0 + jnp.log(-jnp.expm1(-dt0)),
        'a_log': jnp.log(jax.random.uniform(ks[11], (DEPTH, SSM_HEADS), f32, 1.0, 16.0)),
        'd_skip': 1.0 + nrm(ks[12], (DEPTH, SSM_HEADS), 0.02),
        'ssm_norm_g': 1.0 + nrm(ks[13], (DEPTH, D_INNER), 0.02),
        'w_ssm_proj': nrm(ks[14], (DEPTH, D_INNER, D_MODEL), BETA * D_INNER ** -0.5),
        'q_norm_g': 1.0 + nrm(ks[15], (DEPTH, Q_RANK), 0.02),
        'w_q_b': nrm(ks[16], (DEPTH, Q_RANK, MLA_HEADS * (QK_NOPE + QK_ROPE)), Q_RANK ** -0.5),
        'kv_norm_g': 1.0 + nrm(ks[17], (DEPTH, KV_RANK), 0.02),
        'w_uk': nrm(ks[18], (DEPTH, KV_RANK, MLA_HEADS, QK_NOPE), KV_RANK ** -0.5),
        'w_uv': nrm(ks[19], (DEPTH, KV_RANK, MLA_HEADS, V_HEAD), BETA * KV_RANK ** -0.5),
        'w_mla_proj': nrm(ks[20], (DEPTH, MLA_HEADS * V_HEAD, D_MODEL), BETA * (MLA_HEADS * V_HEAD) ** -0.5),
        'w_out': nrm(ks[21], (DEPTH, D_MODEL, D_MODEL), BETA * D_MODEL ** -0.5),
        'ln1_g': 1.0 + nrm(ks[22], (DEPTH, D_MODEL), 0.02),
        'ln1_b': nrm(ks[23], (DEPTH, D_MODEL), 0.02),
        'w_up': nrm(ks[24], (DEPTH, D_MODEL, D_FF), BETA * D_MODEL ** -0.5),
        'w_down': nrm(ks[25], (DEPTH, D_FF, D_MODEL), BETA * D_FF ** -0.5),
        'ln2_g': 1.0 + nrm(ks[26], (DEPTH, D_MODEL), 0.02),
        'ln2_b': nrm(ks[27], (DEPTH, D_MODEL), 0.02),
    }


def reference(x_prompt, x_sample, cache_ckv, cache_kpe, state_ssm, state_conv,
              w_in, b_gate, conv_w, conv_b, dt_bias, a_log, d_skip, ssm_norm_g, w_ssm_proj,
              q_norm_g, w_q_b, kv_norm_g, w_uk, w_uv, w_mla_proj, w_out,
              ln1_g, ln1_b, w_up, w_down, ln2_g, ln2_b):
    yp, ys = x_prompt, x_sample
    st_p, st_s = [], []
    for i in range(DEPTH):
        lp = dict(w_in=w_in[i], b_gate=b_gate[i], conv_w=conv_w[i], conv_b=conv_b[i],
                  dt_bias=dt_bias[i], a_log=a_log[i], d_skip=d_skip[i], ssm_norm_g=ssm_norm_g[i],
                  w_ssm_proj=w_ssm_proj[i], q_norm_g=q_norm_g[i], w_q_b=w_q_b[i],
                  kv_norm_g=kv_norm_g[i], w_uk=w_uk[i], w_uv=w_uv[i], w_mla_proj=w_mla_proj[i],
                  w_out=w_out[i], ln1_g=ln1_g[i], ln1_b=ln1_b[i], w_up=w_up[i], w_down=w_down[i],
                  ln2_g=ln2_g[i], ln2_b=ln2_b[i])
        yp, ckv_p, kpe_p, ssm_p, conv_p = _layer(yp, 0, lp, None)
        past = dict(ckv=cache_ckv[i], kpe=cache_kpe[i], ssm=state_ssm[i], conv=state_conv[i])
        ys, ckv_s, kpe_s, ssm_s, conv_s = _layer(ys, PAST_LEN, lp, past)
        st_p.append((ckv_p, kpe_p, ssm_p, conv_p))
        st_s.append((ckv_s, kpe_s, ssm_s, conv_s))
    new_ckv_p = jnp.stack([t[0] for t in st_p])
    new_kpe_p = jnp.stack([t[1] for t in st_p])
    new_ssm_p = jnp.stack([t[2] for t in st_p])
    new_conv_p = jnp.stack([t[3] for t in st_p])
    new_ckv_s = jnp.stack([t[0] for t in st_s])
    new_kpe_s = jnp.stack([t[1] for t in st_s])
    new_ssm_s = jnp.stack([t[2] for t in st_s])
    new_conv_s = jnp.stack([t[3] for t in st_s])
    return (yp, ys, new_ckv_p, new_kpe_p, new_ssm_p, new_conv_p, new_ckv_s, new_kpe_s, new_ssm_s, new_conv_s)
```

```cpp
#include <hip/hip_runtime.h>
#include <cstdio>
#include <cstdint>

#ifndef MK_PER_PHASE
#define MK_PER_PHASE 0
#endif

#ifndef DIAG_REP
#define DIAG_REP 0
#endif
#ifndef DIAG_DUP_G1
#define DIAG_DUP_G1 1
#define DIAG_DUP_G2 1
#define DIAG_DUP_SSD 1
#define DIAG_DUP_ATT 0
#define DIAG_SMODE 0
#define DIAG_PMODE 0
#endif
#define NREP(k) (((DIAG_REP >> (k)) & 1) ? 2 : 1)
#define LAS __attribute__((address_space(3)))
#define GAS __attribute__((address_space(1)))
typedef unsigned short bf16_t;
typedef short bf16x8 __attribute__((ext_vector_type(8)));
typedef float f32x4 __attribute__((ext_vector_type(4)));
typedef float f32x2 __attribute__((ext_vector_type(2)));
typedef unsigned u32x4 __attribute__((ext_vector_type(4)));
typedef unsigned u32x2 __attribute__((ext_vector_type(2)));

constexpr int D_MODEL = 1024, BATCH = 8, SEQ = 2048, DEC_BATCH = 32, DEC_SEQ = 32, PAST = 4096;
constexpr int MP = BATCH * SEQ, MS = DEC_BATCH * DEC_SEQ, M = MP + MS;
constexpr int D_INNER = 2048, NHEADS = 32, HDIM = 64, NGROUPS = 8, NSTATE = 128, CONV_DIM = 4096;
constexpr int MLA_H = 16, QK_NOPE = 128, QK_ROPE = 64, V_HEAD = 128, Q_RANK = 512, KV_RANK = 512, QHD = 192;
constexpr int D_FF = 4096, IN_COLS = 9312, NPROJ = 9472;
constexpr float RMS_EPS = 1e-6f, LN_EPS = 1e-5f;
constexpr float ALPHA = 1.189207115002721f;
constexpr int SMALL_LD = 1280;

constexpr size_t O_YP = 0, O_YS = 16777216, O_CKVP = 17825792, O_KPEP = 26214400, O_SSMP = 27262976, O_CONVP = 29360128,
                 O_CKVS = 29458432, O_KPES = 29982720, O_SSMS = 30048256, O_CONVS = 38436864;

constexpr size_t MiB = 1u << 20;
constexpr size_t WS_CTL = 0, CTL_ZERO_BYTES = 1 * MiB;
constexpr size_t WS_ROPE = 1 * MiB;
constexpr size_t WS_WIN = 2 * MiB, WS_WQ = 21 * MiB, WS_WUK = 24 * MiB, WS_WUV = 26 * MiB, WS_BQL = 28 * MiB, WS_WUKB = 32 * MiB,
                 WS_WQL = 35 * MiB, WS_WSSM = 43 * MiB, WS_WMLA = 47 * MiB, WS_WOUT = 51 * MiB, WS_WUP = 53 * MiB, WS_WDOWN = 61 * MiB;
constexpr size_t WS_XBC = 72 * MiB;
constexpr size_t WS_Z = 208 * MiB;
constexpr size_t WS_G = 276 * MiB;
constexpr size_t WS_SMALL = 344 * MiB;
constexpr size_t WS_KN = 344 * MiB, WS_V = 408 * MiB;
constexpr size_t WS_XB = 472 * MiB;
constexpr size_t WS_QAN = 472 * MiB, WS_CKVN = 489 * MiB;
constexpr size_t WS_Q = 506 * MiB;
constexpr size_t WS_U = 506 * MiB, WS_HB = 540 * MiB;
constexpr size_t WS_QLAT = 608 * MiB;
constexpr size_t WS_YZ = 624 * MiB;
constexpr size_t WS_O = 692 * MiB;
constexpr size_t WS_KPER = 760 * MiB, WS_DT = 763 * MiB, WS_SSQ = 766 * MiB;
constexpr size_t WS_CACHE = 769 * MiB;
constexpr int KVLEN = PAST + DEC_SEQ;
constexpr size_t WS_XACT = 692 * MiB;
constexpr size_t WS_BCACT = 916 * MiB;
constexpr size_t WS_GWP = 984 * MiB;
constexpr size_t WS_GW = 985 * MiB;
constexpr size_t WS_ST = 986 * MiB;
constexpr size_t WS_END = 987 * MiB;
constexpr size_t WS_A1 = WS_XBC, WS_T1 = WS_Z, WS_V2 = WS_Z, WS_HF = WS_G;

constexpr int CW_BAR = 4096;
constexpr int CW_QUEUE = 16384;

constexpr int LDS_BYTES = 147456;
constexpr int LDSCTL_OFF = LDS_BYTES - 512, MISC_OFF = LDSCTL_OFF + 320;
constexpr int NWAVES = 8, NTHREADS = 512;

#define LDS_WAIT() asm volatile("s_waitcnt lgkmcnt(0)" ::: "memory")
#define VM_WAIT() asm volatile("s_waitcnt vmcnt(0)" ::: "memory")
__device__ __forceinline__ unsigned f2bf(float f) { unsigned u = __builtin_bit_cast(unsigned, f); return (u + 0x7fffu + ((u >> 16) & 1u)) >> 16; }
__device__ __forceinline__ unsigned pk2(float lo, float hi) { return f2bf(lo) | (f2bf(hi) << 16); }
__device__ __forceinline__ float bf2f(unsigned short b) { return __builtin_bit_cast(float, (unsigned)b << 16); }
__device__ __forceinline__ float bflo(unsigned w) { return __builtin_bit_cast(float, w << 16); }
__device__ __forceinline__ float bfhi(unsigned w) { return __builtin_bit_cast(float, w & 0xffff0000u); }
__device__ __forceinline__ float wave_sum(float v) {
#pragma unroll
    for (int o = 1; o < 64; o <<= 1) v += __shfl_xor(v, o);
    return v;
}
__device__ __forceinline__ float sigmoidf_(float x) { return __builtin_amdgcn_rcpf(1.f + __builtin_amdgcn_exp2f(-1.4426950408889634f * x)); }
__device__ __forceinline__ float siluf_(float x) { return x * __builtin_amdgcn_rcpf(1.f + __builtin_amdgcn_exp2f(-1.4426950408889634f * x)); }

namespace pg8 {
constexpr int BM = 256, BK = 64, HALF = 128, HTB = HALF * BK * 2, STAGE_BYTES = 8 * HTB;
__host__ __device__ __forceinline__ int lds_byte(int r, int c) { const int st = (r >> 4) * 2 + (c >> 5), rr = r & 15, cc = c & 31, ob = rr * 64 + cc * 2; return st * 1024 + (ob ^ (((ob >> 9) & 1) << 5)); }
__host__ __device__ __forceinline__ void stage_rc(int b, int& R, int& C) { const int st = b / 1024, sb = b % 1024, swz = sb ^ (((sb >> 9) & 1) << 5); R = (st >> 1) * 16 + swz / 64; C = (st & 1) * 32 + (swz % 64) / 2; }
__host__ __device__ __forceinline__ int perm32(int rho) { const int n = rho >> 4, i = rho & 15; return 8 * (i >> 2) + 4 * n + (i & 3); }

struct Unit { const char* a; const char* b; int pm, pn, seg; };

__device__ __forceinline__ unsigned cvt_pk_bf16(float lo, float hi) { unsigned r; asm volatile("v_cvt_pk_bf16_f32 %0, %1, %2" : "=v"(r) : "v"(lo), "v"(hi)); return r; }

template <class Epi, class Sched>
__device__ __forceinline__ void gemm_phase(LAS unsigned char* lds, const int K, const int lda, const int ldb, const Sched& S, const Epi& E) {
    const int tid = threadIdx.x, wid = __builtin_amdgcn_readfirstlane(tid >> 6), lane = tid & 63, wr = wid >> 2, wc = wid & 3, fr = lane & 15, fq = lane >> 4;
    const int nt = K / BK;
    unsigned voffA[2], voffB[2];
#pragma unroll
    for (int i = 0; i < 2; ++i) { int R, C; stage_rc(tid * 16 + i * 8192, R, C); const int Rb = Epi::PERM ? ((R & ~31) + perm32(R & 31)) : R;
        voffA[i] = (unsigned)(R * lda + C) * 2u; voffB[i] = (unsigned)(Rb * ldb + C) * 2u; }
    const size_t kstep = (size_t)(BK * 2);
    const size_t hstepA = (size_t)HALF * lda * 2, hstepB = (size_t)HALF * ldb * 2;
    const unsigned ldsw = (unsigned)wid * 1024u;
    const int aoff = lds_byte(wr * 64 + fr, fq * 8), boff = lds_byte(wc * 32 + fr, fq * 8);
#define PG8_SA(b, h) (((b) * 2 + (h)) * HTB)
#define PG8_SB(b, h) ((4 + (b) * 2 + (h)) * HTB)
#define PG8_STAGE(bufoff, gbase, voff) do { _Pragma("unroll") for (int _i = 0; _i < 2; ++_i) \
        __builtin_amdgcn_global_load_lds((const unsigned*)((const char*)(gbase) + (voff)[_i]), (LAS unsigned*)(lds + (bufoff) + ldsw + _i * 8192), 16, 0, 0); } while (0)
#define PG8_LDA(dst, b, h) do { _Pragma("unroll") for (int m = 0; m < 4; ++m) _Pragma("unroll") for (int k = 0; k < 2; ++k) dst[m][k] = *(const LAS bf16x8*)(lds + PG8_SA(b, h) + aoff + m * 2048 + k * 1024); } while (0)
#define PG8_LDB(dst, b, h) do { _Pragma("unroll") for (int n = 0; n < 2; ++n) _Pragma("unroll") for (int k = 0; k < 2; ++k) dst[n][k] = *(const LAS bf16x8*)(lds + PG8_SB(b, h) + boff + n * 2048 + k * 1024); } while (0)
#define PG8_MMA(ai, bj, At, Bt) do { __builtin_amdgcn_s_setprio(1); _Pragma("unroll") for (int m = 0; m < 4; ++m) _Pragma("unroll") for (int n = 0; n < 2; ++n) _Pragma("unroll") for (int k = 0; k < 2; ++k) \
        acc[ai][bj][m][n] = __builtin_amdgcn_mfma_f32_16x16x32_bf16(Bt[n][k], At[m][k], acc[ai][bj][m][n], 0, 0, 0); __builtin_amdgcn_s_setprio(0); } while (0)
#define PG8_WAIT_V(n) asm volatile("s_waitcnt vmcnt(" #n ")" ::: "memory")
#define PG8_WAIT_L(n) asm volatile("s_waitcnt lgkmcnt(" #n ")" ::: "memory")
#define PG8_BAR __builtin_amdgcn_s_barrier()
#define PG8_SCHED __builtin_amdgcn_sched_barrier(0)
    Unit cur, nxt; int ui = 0;
    if (!S.next(0, cur)) return;
    f32x4 acc[2][2][4][2];
#pragma unroll
    for (int a = 0; a < 2; ++a)
#pragma unroll
        for (int b = 0; b < 2; ++b)
#pragma unroll
            for (int m = 0; m < 4; ++m)
#pragma unroll
                for (int n = 0; n < 2; ++n) acc[a][b][m][n] = (f32x4){0.f, 0.f, 0.f, 0.f};
    bf16x8 At[4][2], B0[2][2], B1[2][2];
    const char* cA = cur.a; const char* cB = cur.b;
    PG8_STAGE(PG8_SB(0, 0), cB, voffB); PG8_STAGE(PG8_SB(0, 1), cB + hstepB, voffB); PG8_STAGE(PG8_SA(0, 0), cA, voffA); PG8_STAGE(PG8_SA(0, 1), cA + hstepA, voffA);
    if (wr == 1) PG8_BAR;
    PG8_WAIT_V(2); PG8_BAR;
    PG8_STAGE(PG8_SB(1, 0), cB + kstep, voffB); PG8_STAGE(PG8_SA(1, 0), cA + kstep, voffA); PG8_STAGE(PG8_SB(1, 1), cB + hstepB + kstep, voffB);
    PG8_WAIT_V(6); PG8_BAR;
    for (;;) {
        const bool has_next = S.next(ui + 1, nxt);
        const char* nA = has_next ? nxt.a : cA; const char* nB = has_next ? nxt.b : cB;
#pragma unroll 1
        for (int t = 0; t < nt; t += 2) {
            const bool last = (t == nt - 2);
            const char* a1 = cA + (size_t)(t + 1) * kstep;
            const char* a2 = last ? nA : cA + (size_t)(t + 2) * kstep; const char* b2 = last ? nB : cB + (size_t)(t + 2) * kstep;
            const char* a3 = a2 + kstep; const char* b3 = b2 + kstep;
            PG8_LDB(B0, 0, 0); PG8_LDB(B1, 0, 1); PG8_SCHED; PG8_LDA(At, 0, 0); PG8_STAGE(PG8_SA(1, 1), a1 + hstepA, voffA);
            PG8_WAIT_V(8); PG8_WAIT_L(0); PG8_BAR; PG8_MMA(0, 0, At, B0); PG8_MMA(0, 1, At, B1); PG8_BAR; PG8_SCHED;
            PG8_LDA(At, 0, 1); PG8_STAGE(PG8_SB(0, 0), b2, voffB); PG8_STAGE(PG8_SB(0, 1), b2 + hstepB, voffB); PG8_STAGE(PG8_SA(0, 0), a2, voffA);
            PG8_WAIT_V(8); PG8_WAIT_L(0); PG8_BAR; PG8_MMA(1, 0, At, B0); PG8_MMA(1, 1, At, B1); PG8_BAR; PG8_SCHED;
            PG8_LDB(B0, 1, 0); PG8_LDB(B1, 1, 1); PG8_SCHED; PG8_LDA(At, 1, 0); PG8_STAGE(PG8_SA(0, 1), a2 + hstepA, voffA);
            PG8_WAIT_V(8); PG8_WAIT_L(0); PG8_BAR; PG8_MMA(0, 0, At, B0); PG8_MMA(0, 1, At, B1); PG8_BAR; PG8_SCHED;
            PG8_LDA(At, 1, 1); PG8_STAGE(PG8_SB(1, 0), b3, voffB); PG8_STAGE(PG8_SB(1, 1), b3 + hstepB, voffB); PG8_STAGE(PG8_SA(1, 0), a3, voffA);
            PG8_WAIT_V(8); PG8_WAIT_L(0); PG8_BAR; PG8_MMA(1, 0, At, B0); PG8_MMA(1, 1, At, B1); PG8_BAR; PG8_SCHED;
        }
        if (wr == 0) PG8_BAR;
        E(acc, cur, wr, wc, fr, fq);
        if (!has_next) break;
#pragma unroll
        for (int a = 0; a < 2; ++a)
#pragma unroll
            for (int b = 0; b < 2; ++b)
#pragma unroll
                for (int m = 0; m < 4; ++m)
#pragma unroll
                    for (int n = 0; n < 2; ++n) acc[a][b][m][n] = (f32x4){0.f, 0.f, 0.f, 0.f};
        cur = nxt; cA = nA; cB = nB; ++ui;
        if (wr == 1) PG8_BAR;
    }
    PG8_WAIT_V(0);
    PG8_BAR;
#undef PG8_SA
#undef PG8_SB
#undef PG8_STAGE
#undef PG8_LDA
#undef PG8_LDB
#undef PG8_MMA
#undef PG8_WAIT_V
#undef PG8_WAIT_L
#undef PG8_BAR
#undef PG8_SCHED
}

struct Seg { const char* A; const char* B; int nM, nN, start, count; size_t a_tile, b_tile; };
struct SegOrder {
    Seg s[4]; int nseg, total, G, c, dup;
    __device__ __forceinline__ bool next(int i, Unit& u) const {
        int L = i * G + c; if (L >= total * dup) return false; if (L >= total) L -= total;
        int k = 0; const char* gA = s[0].A; const char* gB = s[0].B; int gnM = s[0].nM, gnN = s[0].nN, gstart = 0, nwg = s[0].count; size_t gat = s[0].a_tile, gbt = s[0].b_tile;
#pragma unroll
        for (int j = 1; j < 4; ++j) if (j < nseg && L >= s[j].start) { k = j; gA = s[j].A; gB = s[j].B; gnM = s[j].nM; gnN = s[j].nN; gstart = s[j].start; nwg = s[j].count; gat = s[j].a_tile; gbt = s[j].b_tile; }
        int wgid = L - gstart;
        { const int q = nwg / 8, r = nwg % 8, xcd = wgid % 8, off = wgid / 8; wgid = (xcd < r ? xcd * (q + 1) : r * (q + 1) + (xcd - r) * q) + off; }
        const int nig = 8 * gnN, gid = wgid / nig, fm = gid * 8, gsz = (gnM - fm) < 8 ? (gnM - fm) : 8;
        u.pm = fm + ((wgid % nig) % gsz); u.pn = (wgid % nig) / gsz; u.seg = k;
        u.a = gA + (size_t)u.pm * gat; u.b = gB + (size_t)u.pn * gbt; return true;
    }
};
struct WqlOrder {
    const char* A; const char* B; int G, c;
    __device__ __forceinline__ bool next(int i, Unit& u) const {
        const int L = i * G + c; if (L >= 64) return false;
        const int h = L >> 2, pm = (L >> 1) & 1, pn = L & 1;
        u.pm = h * 2 + pm; u.pn = pn; u.seg = 1;
        u.a = A + (size_t)pm * 256 * 2048 * 2 + (size_t)h * 128 * 2; u.b = B + (size_t)h * 512 * 256 * 2 + (size_t)pn * 256 * 256 * 2; return true;
    }
};
}

#define XB_TMO      128
#define XB_XCNT(j)  (256  + 64 * (j))
#define XB_XSUB(j)  (1280 + 64 * (j))
#define XB_XGEN(j)  (2304 + 64 * (j))
#define XB_TOP      3328
#define XB_TOPGEN   3392
#define XCD_BAR_WORDS 3456
#define XB_SPIN_CAP (1u << 18)
__device__ __forceinline__ unsigned xb_ld(unsigned* p)              { return __hip_atomic_load(p, __ATOMIC_RELAXED, __HIP_MEMORY_SCOPE_AGENT); }
__device__ __forceinline__ unsigned xb_add(unsigned* p, unsigned v) { return __hip_atomic_fetch_add(p, v, __ATOMIC_RELAXED, __HIP_MEMORY_SCOPE_AGENT); }
__device__ __forceinline__ unsigned xb_xcc_id() { return (unsigned)__builtin_amdgcn_s_getreg((3 << 11) | 20) & 0xFu; }
#define XB_SPIN(cond, bar) do { unsigned _sp = 0; while (cond) { __builtin_amdgcn_s_sleep(1); \
    if ((++_sp & 255u) == 0u) { if (xb_ld(&(bar)[XB_TMO])) break; if (_sp > XB_SPIN_CAP) { atomicAdd(&(bar)[XB_TMO], 1u); break; } } } } while (0)
struct XcdBarrier { unsigned* bar; unsigned x; volatile LAS unsigned* st; };
__device__ __forceinline__ XcdBarrier xcd_barrier_post(unsigned* bar, volatile LAS unsigned* st) {
    XcdBarrier b; b.bar = bar; b.x = xb_xcc_id(); b.st = st;
    if (threadIdx.x == 0) (void)xb_add(&bar[XB_XCNT(b.x)], 1u);
    return b;
}
__device__ __forceinline__ void xcd_barrier_complete(unsigned* bar, unsigned x, unsigned& nloc, unsigned& nx) {
    const unsigned G = gridDim.x * gridDim.y * gridDim.z;
    unsigned sum, cnt, mine, sp = 0u;
    for (;;) {
        sum = 0u; cnt = 0u; mine = 0u;
#pragma unroll
        for (unsigned j = 0; j < 16; ++j) { const unsigned c = xb_ld(&bar[XB_XCNT(j)]); sum += c; cnt += (c > 0u) ? 1u : 0u; mine = (j == x) ? c : mine; }
        if (sum == G) break;
        __builtin_amdgcn_s_sleep(1);
        if ((++sp & 255u) == 0u) { if (xb_ld(&bar[XB_TMO])) break; if (sp > XB_SPIN_CAP) { atomicAdd(&bar[XB_TMO], 1u); break; } }
    }
    nloc = mine > 0u ? mine : 1u; nx = cnt > 0u ? cnt : 1u;
}
__device__ __forceinline__ void xcd_barrier(const XcdBarrier& b) {
    asm volatile("s_waitcnt vmcnt(0)" ::: "memory");
    __syncthreads();
    if (threadIdx.x == 0) {
        unsigned* bar = b.bar;
        __builtin_amdgcn_s_waitcnt(0);
        unsigned nloc = b.st[0], nx = b.st[1];
        if (nloc == 0u) { xcd_barrier_complete(bar, b.x, nloc, nx); b.st[0] = nloc; b.st[1] = nx; }
        const unsigned old = xb_add(&bar[XB_XSUB(b.x)], 1u);
        const unsigned gen = old / nloc;
        if (old + 1u == (gen + 1u) * nloc) {
            __builtin_amdgcn_fence(__ATOMIC_RELEASE, "agent");
            asm volatile("s_waitcnt vmcnt(0)" ::: "memory");
            const unsigned og = xb_add(&bar[XB_TOP], 1u);
            const unsigned tg = og / nx;
            if (og + 1u == (tg + 1u) * nx) xb_add(&bar[XB_TOPGEN], 1u);
            else XB_SPIN(xb_ld(&bar[XB_TOPGEN]) == tg, bar);
            __builtin_amdgcn_fence(__ATOMIC_ACQUIRE, "agent");
            xb_add(&bar[XB_XGEN(b.x)], 1u);
            asm volatile("s_waitcnt vmcnt(0)" ::: "memory");
        } else {
            XB_SPIN(xb_ld(&bar[XB_XGEN(b.x)]) == gen, bar);
            __builtin_amdgcn_fence(__ATOMIC_ACQUIRE, "agent");
            asm volatile("s_waitcnt vmcnt(0)" ::: "memory");
        }
    }
    __syncthreads();
}

struct Args { const float* in[28]; float* out; unsigned char* ws; int ph_lo, ph_hi; };
struct Frame {
    LAS unsigned char* lds;
    int tid, lane, wave, vcu, G;
    unsigned char* ws; float* out;
};

__device__ __forceinline__ void p0_transpose_item(const float* W, int K, int N, bf16_t* WT, int ldt, int k0, int n0, int drow0, LAS float* scr, int lane) {
    float tv[32];
#pragma unroll
    for (int i = 0; i < 32; ++i) { const int kk = 2 * i + (lane >> 5); tv[i] = __builtin_nontemporal_load(W + (size_t)(k0 + kk) * N + n0 + (lane & 31)); }
#pragma unroll
    for (int i = 0; i < 32; ++i) { const int kk = 2 * i + (lane >> 5); scr[kk * 33 + (lane & 31)] = tv[i]; }
    LDS_WAIT(); asm volatile("" ::: "memory");
    const int c = lane & 7;
#pragma unroll
    for (int j = 0; j < 4; ++j) { const int n = (lane >> 3) + 8 * j; const LAS float* s = scr + (8 * c) * 33 + n;
        u32x4 o; o.x = pk2(s[0 * 33], s[1 * 33]); o.y = pk2(s[2 * 33], s[3 * 33]); o.z = pk2(s[4 * 33], s[5 * 33]); o.w = pk2(s[6 * 33], s[7 * 33]);
        *(u32x4*)(WT + (size_t)(drow0 + n) * ldt + k0 + 8 * c) = o; }
    LDS_WAIT(); asm volatile("" ::: "memory");
}
__device__ __forceinline__ int win_dst_col(int n0) {
    if (n0 < 8192) return n0;
    if (n0 < 8224) return 9280 + (n0 - 8192);
    if (n0 < 8736) return 8192 + (n0 - 8224);
    if (n0 < 9248) return 8704 + (n0 - 8736);
    return 9216 + (n0 - 9248);
}
struct TItem { const float* W; int K, N; bf16_t* WT; int kind; };

__device__ __forceinline__ void p0_prologue(Frame& F, const Args& args) {
    LAS float* scr = (LAS float*)(F.lds + F.wave * 16384);
    const int gw = F.vcu * NWAVES + F.wave, NGW = F.G * NWAVES, lane = F.lane;
    unsigned char* ws = F.ws;
    {
        const float* Ws[9] = {args.in[6], args.in[16], args.in[18], args.in[19], args.in[14], args.in[20], args.in[21], args.in[24], args.in[25]};
        const int Ks[9] = {1024, 512, 512, 512, 2048, 2048, 1024, 1024, 4096};
        const int Ns[9] = {IN_COLS, 3072, 2048, 2048, 1024, 1024, 1024, 4096, 1024};
        const size_t Os[9] = {WS_WIN, WS_WQ, WS_WUK, WS_WUV, WS_WSSM, WS_WMLA, WS_WOUT, WS_WUP, WS_WDOWN};
        int base = 0;
#pragma unroll
        for (int w = 0; w < 9; ++w) {
            const int nblk = Ns[w] / 32, nitems = (Ks[w] / 64) * nblk;
            int first = gw - (base % NGW); if (first < 0) first += NGW;
            for (int it = first; it < nitems; it += NGW) {
                const int kb = it / nblk, nb = it % nblk, n0 = 32 * nb;
                const int drow0 = (w == 0) ? win_dst_col(n0) : n0;
                p0_transpose_item(Ws[w], Ks[w], Ns[w], (bf16_t*)(ws + Os[w]), Ks[w], 64 * kb, n0, drow0, scr, lane);
            }
            base += nitems;
        }
    }
    const int gt = F.vcu * NTHREADS + F.tid, NGT = F.G * NTHREADS;
    for (int i = gt; i < 20480; i += NGT) ((u32x4*)(ws + WS_WIN + (size_t)9312 * 1024 * 2))[i] = (u32x4){0u, 0u, 0u, 0u};
    {
        const f32x4* xp = (const f32x4*)args.in[0]; const f32x4* xs = (const f32x4*)args.in[1]; u32x4* xb = (u32x4*)(ws + WS_XB);
        const int n8p = MP * D_MODEL / 8, n8 = M * D_MODEL / 8;
        for (int i0 = gt; i0 < n8; i0 += 4 * NGT) {
            f32x4 a[4], b[4];
#pragma unroll
            for (int u = 0; u < 4; ++u) { const int i = i0 + u * NGT; const int ii = (i < n8) ? i : 0; const f32x4* src = (ii < n8p) ? xp + 2 * (size_t)ii : xs + 2 * (size_t)(ii - n8p); a[u] = __builtin_nontemporal_load(src); b[u] = __builtin_nontemporal_load(src + 1); }
#pragma unroll
            for (int u = 0; u < 4; ++u) { const int i = i0 + u * NGT; if (i < n8) xb[i] = (u32x4){pk2(a[u].x, a[u].y), pk2(a[u].z, a[u].w), pk2(b[u].x, b[u].y), pk2(b[u].z, b[u].w)}; }
        }
    }
    {
        const f32x4* src = (const f32x4*)args.in[18]; u32x4* dst = (u32x4*)(ws + WS_WUKB);
        for (int i = gt; i < 512 * 2048 / 8; i += NGT) { const f32x4 a = src[2 * (size_t)i], b = src[2 * (size_t)i + 1]; dst[i] = (u32x4){pk2(a.x, a.y), pk2(a.z, a.w), pk2(b.x, b.y), pk2(b.z, b.w)}; }
        for (int i = gt; i < 64; i += NGT) dst[512 * 2048 / 8 + i] = (u32x4){0u, 0u, 0u, 0u};
    }
    {
        const float* wq = args.in[16]; u32x4* dst = (u32x4*)(ws + WS_BQL);
        for (int i = gt; i < 16 * 512 * 32; i += NGT) {
            const int d8 = i & 31, r = (i >> 5) & 511, h = i >> 14;
            u32x4 o = (u32x4){0u, 0u, 0u, 0u};
            if (d8 < 16) { const f32x4* s = (const f32x4*)(wq + (size_t)r * 3072 + h * 192 + d8 * 8); const f32x4 a = s[0], b = s[1]; o = (u32x4){pk2(a.x, a.y), pk2(a.z, a.w), pk2(b.x, b.y), pk2(b.z, b.w)}; }
            dst[i] = o;
        }
    }
    {
        float* ct = (float*)(ws + WS_ROPE); float* st = ct + 2080 * 32;
        for (int i = gt; i < 2080 * 32; i += NGT) {
            const int p = i >> 5, j = i & 31; const float pos = (float)(p < 2048 ? p : 4096 + (p - 2048));
            const float inv = powf(10000.0f, -(float)(2 * j) / 64.0f); const float ang = pos * inv;
            ct[i] = cosf(ang); st[i] = sinf(ang);
        }
    }
    {
        const float* wup = args.in[24]; const float* g1 = args.in[22]; const float* b1 = args.in[23]; float* part = (float*)(ws + WS_GWP);
        for (int i = gt; i < 32 * 4096; i += NGT) { const int n = i & 4095, ks = i >> 12; float sg = 0.f, sb = 0.f;
#pragma unroll 8
            for (int k = 0; k < 32; ++k) { const float wv_ = wup[(size_t)(ks * 32 + k) * 4096 + n]; sg += g1[ks * 32 + k] * wv_; sb += b1[ks * 32 + k] * wv_; }
            part[(ks * 2) * 4096 + n] = sg; part[(ks * 2 + 1) * 4096 + n] = sb; }
    }
}

struct EpiStore {
    static constexpr bool PERM = true;
    bf16_t *b0, *b1, *b2, *b3; int l0, l1, l2, l3;
    __device__ __forceinline__ void operator()(const f32x4 (&acc)[2][2][4][2], const pg8::Unit& u, int wr, int wc, int fr, int fq) const {
        bf16_t* b = (u.seg == 0) ? b0 : (u.seg == 1) ? b1 : (u.seg == 2) ? b2 : b3;
        const int ld = (u.seg == 0) ? l0 : (u.seg == 1) ? l1 : (u.seg == 2) ? l2 : l3;
        bf16_t* p = b + (size_t)(u.pm * 256 + wr * 64 + fr) * ld + u.pn * 256 + wc * 32 + 8 * fq;
#pragma unroll
        for (int ai = 0; ai < 2; ++ai)
#pragma unroll
            for (int m = 0; m < 4; ++m) { bf16_t* rowp = p + (size_t)(ai * 128 + m * 16) * ld;
#pragma unroll
                for (int bj = 0; bj < 2; ++bj) { const f32x4 v0 = acc[ai][bj][m][0], v1 = acc[ai][bj][m][1];
                    *(u32x4*)(rowp + bj * 128) = (u32x4){pg8::cvt_pk_bf16(v0[0], v0[1]), pg8::cvt_pk_bf16(v0[2], v0[3]), pg8::cvt_pk_bf16(v1[0], v1[1]), pg8::cvt_pk_bf16(v1[2], v1[3])}; } }
    }
};

struct EpiProj {
    static constexpr bool PERM = true;
    unsigned char* ws; float* out;
    __device__ __forceinline__ void operator()(const f32x4 (&acc)[2][2][4][2], const pg8::Unit& u, int wr, int wc, int fr, int fq) const {
        const int row0 = u.pm * 256 + wr * 64 + fr, colt = wc * 32 + 8 * fq;
        if (u.pn < 32) {
            bf16_t* base; int ldc, c0;
            if (u.pn < 8) { base = (bf16_t*)(ws + WS_G); ldc = 2048; c0 = u.pn * 256; }
            else if (u.pn < 16) { base = (bf16_t*)(ws + WS_Z); ldc = 2048; c0 = (u.pn - 8) * 256; }
            else { base = (bf16_t*)(ws + WS_XBC); ldc = 4096; c0 = (u.pn - 16) * 256; }
#pragma unroll
            for (int ai = 0; ai < 2; ++ai)
#pragma unroll
                for (int m = 0; m < 4; ++m) { const int row = row0 + ai * 128 + m * 16; bf16_t* rowp = base + (size_t)row * ldc + c0 + colt;
#pragma unroll
                    for (int bj = 0; bj < 2; ++bj) { const f32x4 v0 = acc[ai][bj][m][0], v1 = acc[ai][bj][m][1];
                        *(u32x4*)(rowp + bj * 128) = (u32x4){pg8::cvt_pk_bf16(v0[0], v0[1]), pg8::cvt_pk_bf16(v0[2], v0[3]), pg8::cvt_pk_bf16(v1[0], v1[1]), pg8::cvt_pk_bf16(v1[2], v1[3])}; } }
            if (u.pn >= 16 && ((u.pm & 7) == 7 || u.pm >= MP / 256)) {
#pragma unroll
                for (int ai = 0; ai < 2; ++ai)
#pragma unroll
                    for (int m = 0; m < 4; ++m) { const int row = row0 + ai * 128 + m * 16;
                        long off = -1;
                        if (row < MP) { const int t = row & 2047; if (t >= 2045) off = (long)O_CONVP + ((long)(row >> 11) * 3 + (t - 2045)) * 4096; }
                        else { const int q = (row - MP) & 31; if (q >= 29) off = (long)O_CONVS + ((long)((row - MP) >> 5) * 3 + (q - 29)) * 4096; }
                        if (off >= 0) { float* cp = out + off + c0 + colt;
#pragma unroll
                            for (int bj = 0; bj < 2; ++bj) { *(f32x4*)(cp + bj * 128) = acc[ai][bj][m][0]; *(f32x4*)(cp + bj * 128 + 4) = acc[ai][bj][m][1]; } } }
            }
        } else {
            float* base = (float*)(ws + WS_SMALL); const int c0 = (u.pn - 32) * 256;
#pragma unroll
            for (int ai = 0; ai < 2; ++ai)
#pragma unroll
                for (int m = 0; m < 4; ++m) { float* rowp = base + (size_t)(row0 + ai * 128 + m * 16) * SMALL_LD + c0 + colt;
#pragma unroll
                    for (int bj = 0; bj < 2; ++bj) { *(f32x4*)(rowp + bj * 128) = acc[ai][bj][m][0]; *(f32x4*)(rowp + bj * 128 + 4) = acc[ai][bj][m][1]; } }
        }
    }
};

__device__ __forceinline__ void p1b_rows(Frame& F, const Args& args) {
    const int gw = F.vcu * NWAVES + F.wave, NGW = F.G * NWAVES, lane = F.lane;
    unsigned char* ws = F.ws;
    const float* gq = args.in[15]; const float* gkv = args.in[17]; const float* dtb = args.in[10];
    const float* ct = (const float*)(ws + WS_ROPE); const float* st = ct + 2080 * 32;
    const f32x4 gq0 = *(const f32x4*)(gq + 4 * lane), gq1 = *(const f32x4*)(gq + 256 + 4 * lane);
    const f32x4 gk0 = *(const f32x4*)(gkv + 4 * lane), gk1 = *(const f32x4*)(gkv + 256 + 4 * lane);
    for (int m = gw; m < M; m += NGW) {
        const float* srow = (const float*)(ws + WS_SMALL) + (size_t)m * SMALL_LD;
        const f32x4 q0 = __builtin_nontemporal_load((const f32x4*)(srow + 4 * lane)), q1 = __builtin_nontemporal_load((const f32x4*)(srow + 256 + 4 * lane));
        const f32x4 k0 = __builtin_nontemporal_load((const f32x4*)(srow + 512 + 4 * lane)), k1 = __builtin_nontemporal_load((const f32x4*)(srow + 768 + 4 * lane));
        float sq = (q0.x * q0.x + q0.y * q0.y) + (q0.z * q0.z + q0.w * q0.w) + (q1.x * q1.x + q1.y * q1.y) + (q1.z * q1.z + q1.w * q1.w);
        float sk = (k0.x * k0.x + k0.y * k0.y) + (k0.z * k0.z + k0.w * k0.w) + (k1.x * k1.x + k1.y * k1.y) + (k1.z * k1.z + k1.w * k1.w);
        sq = wave_sum(sq); sk = wave_sum(sk);
        const float rq = 1.0f / sqrtf(sq * (1.0f / 512.0f) + RMS_EPS), rk = 1.0f / sqrtf(sk * (1.0f / 512.0f) + RMS_EPS);
        { bf16_t* o = (bf16_t*)(ws + WS_QAN) + (size_t)m * 512;
          const f32x4 a = q0 * rq * gq0, b = q1 * rq * gq1;
          *(u32x2*)(o + 4 * lane) = (u32x2){pk2(a.x, a.y), pk2(a.z, a.w)}; *(u32x2*)(o + 256 + 4 * lane) = (u32x2){pk2(b.x, b.y), pk2(b.z, b.w)}; }
        { bf16_t* o = (bf16_t*)(ws + WS_CKVN) + (size_t)m * 512;
          const f32x4 a = k0 * rk * gk0, b = k1 * rk * gk1;
          *(u32x2*)(o + 4 * lane) = (u32x2){pk2(a.x, a.y), pk2(a.z, a.w)}; *(u32x2*)(o + 256 + 4 * lane) = (u32x2){pk2(b.x, b.y), pk2(b.z, b.w)};
          float* fo = (m < MP) ? F.out + O_CKVP + (size_t)m * 512 : F.out + O_CKVS + (size_t)(m - MP) * 512;
          __builtin_nontemporal_store(a, (f32x4*)(fo + 4 * lane)); __builtin_nontemporal_store(b, (f32x4*)(fo + 256 + 4 * lane));
          if (m >= MP) { bf16_t* cr = (bf16_t*)(ws + WS_CACHE) + ((size_t)((m - MP) >> 5) * KVLEN + PAST + ((m - MP) & 31)) * 576;
              *(u32x2*)(cr + 4 * lane) = (u32x2){pk2(a.x, a.y), pk2(a.z, a.w)}; *(u32x2*)(cr + 256 + 4 * lane) = (u32x2){pk2(b.x, b.y), pk2(b.z, b.w)}; } }
        const int pidx = (m < MP) ? (m & 2047) : 2048 + ((m - MP) & 31);
        if (lane < 32) {
            const float t1 = srow[1024 + lane], t2 = srow[1056 + lane]; const float c = ct[pidx * 32 + lane], s = st[pidx * 32 + lane];
            const float o1 = t1 * c - t2 * s, o2 = t1 * s + t2 * c;
            float* fo = (m < MP) ? F.out + O_KPEP + (size_t)m * 64 : F.out + O_KPES + (size_t)(m - MP) * 64;
            fo[lane] = o1; fo[32 + lane] = o2;
            bf16_t* o = (bf16_t*)(ws + WS_KPER) + (size_t)m * 64; o[lane] = (bf16_t)f2bf(o1); o[32 + lane] = (bf16_t)f2bf(o2);
            if (m >= MP) { bf16_t* cr = (bf16_t*)(ws + WS_CACHE) + ((size_t)((m - MP) >> 5) * KVLEN + PAST + ((m - MP) & 31)) * 576 + 512; cr[lane] = (bf16_t)f2bf(o1); cr[32 + lane] = (bf16_t)f2bf(o2); }
        } else {
            const int hh = lane - 32; const float x = srow[1088 + hh] + dtb[hh];
            const float sp = (x > 20.f) ? x : log1pf(expf(x));
            ((float*)(ws + WS_DT))[(size_t)m * 32 + hh] = sp;
        }
    }
}


__device__ __forceinline__ void conv_item(Frame& F, const Args& args, int item) {
    int tid_o = F.tid; asm volatile("" : "+v"(tid_o));
    const int tid = tid_o, rb = item >> 3, sl = item & 7, ch = sl * 512 + (tid & 63) * 8, r0 = rb * 64 + (tid >> 6) * 8;
    unsigned char* ws = F.ws; const bf16_t* xbc = (const bf16_t*)(ws + WS_XBC);
    const float* conv_w = args.in[8]; const float* conv_b = args.in[9];
    float wv[4][8], bv[8];
#pragma unroll
    for (int k = 0; k < 4; ++k) { const f32x4 a = *(const f32x4*)(conv_w + k * 4096 + ch), c = *(const f32x4*)(conv_w + k * 4096 + ch + 4);
        wv[k][0] = a[0]; wv[k][1] = a[1]; wv[k][2] = a[2]; wv[k][3] = a[3]; wv[k][4] = c[0]; wv[k][5] = c[1]; wv[k][6] = c[2]; wv[k][7] = c[3]; }
    { const f32x4 a = *(const f32x4*)(conv_b + ch), c = *(const f32x4*)(conv_b + ch + 4); bv[0] = a[0]; bv[1] = a[1]; bv[2] = a[2]; bv[3] = a[3]; bv[4] = c[0]; bv[5] = c[1]; bv[6] = c[2]; bv[7] = c[3]; }
    float h0[8], h1[8], h2[8];
    const bool prompt = r0 < MP; const int t0 = prompt ? (r0 & 2047) : ((r0 - MP) & 31);
    u32x4 hv[3];
    if (t0 == 0) {
        if (prompt) { hv[0] = hv[1] = hv[2] = (u32x4){0u, 0u, 0u, 0u}; }
        else { const float* sc = args.in[5] + (size_t)((r0 - MP) >> 5) * 3 * 4096 + ch;
#pragma unroll
            for (int k = 0; k < 3; ++k) { const f32x4 a = *(const f32x4*)(sc + k * 4096), c = *(const f32x4*)(sc + k * 4096 + 4); hv[k] = (u32x4){pk2(a.x, a.y), pk2(a.z, a.w), pk2(c.x, c.y), pk2(c.z, c.w)}; } }
    } else {
#pragma unroll
        for (int k = 0; k < 3; ++k) hv[k] = *(const u32x4*)(xbc + (size_t)(r0 - 3 + k) * 4096 + ch);
    }
#pragma unroll
    for (int e = 0; e < 4; ++e) { h0[2 * e] = bflo(hv[0][e]); h0[2 * e + 1] = bfhi(hv[0][e]); h1[2 * e] = bflo(hv[1][e]); h1[2 * e + 1] = bfhi(hv[1][e]); h2[2 * e] = bflo(hv[2][e]); h2[2 * e + 1] = bfhi(hv[2][e]); }
    u32x4 rv[8];
#pragma unroll
    for (int i = 0; i < 8; ++i) rv[i] = (i < 5) ? __builtin_nontemporal_load((const u32x4*)(xbc + (size_t)(r0 + i) * 4096 + ch)) : *(const u32x4*)(xbc + (size_t)(r0 + i) * 4096 + ch);
    bf16_t* dst = (ch < 2048) ? (bf16_t*)(ws + WS_XACT) + (size_t)r0 * 2048 + ch : (bf16_t*)(ws + WS_BCACT) + (size_t)r0 * 2048 + (ch - 2048);
#pragma unroll
    for (int i = 0; i < 8; ++i) {
        float x[8], o[8];
#pragma unroll
        for (int e = 0; e < 4; ++e) { x[2 * e] = bflo(rv[i][e]); x[2 * e + 1] = bfhi(rv[i][e]); }
#pragma unroll
        for (int e = 0; e < 8; ++e) { o[e] = siluf_(bv[e] + wv[0][e] * h0[e] + wv[1][e] * h1[e] + wv[2][e] * h2[e] + wv[3][e] * x[e]); h0[e] = h1[e]; h1[e] = h2[e]; h2[e] = x[e]; }
        *(u32x4*)(dst + (size_t)i * 2048) = (u32x4){pk2(o[0], o[1]), pk2(o[2], o[3]), pk2(o[4], o[5]), pk2(o[6], o[7])};
    }
}

namespace ssd {
constexpr int SC = 272, SX = 144;
constexpr int L_CT = 0, L_BN = L_CT + 64 * SC, L_SB = L_BN + 64 * SC, L_XT = L_SB + 64 * SC, L_XS = L_XT + 64 * SX, L_MM = L_XS + 64 * SX, L_YO = L_MM + 64 * SX, L_SCAL = L_YO + 64 * SX, L_END = L_SCAL + 1024;
static_assert(L_END <= LDSCTL_OFF, "ssd LDS map");
typedef short v4i16 __attribute__((ext_vector_type(4)));
__device__ __forceinline__ v4i16 tr16(LAS const unsigned char* p) { return __builtin_amdgcn_ds_read_tr16_b64_v4i16((LAS v4i16*)p); }
}
__device__ __forceinline__ void ssd_item(Frame& F, const Args& args, int item) {
    using namespace ssd;
    LAS unsigned char* lds = F.lds;
    int tid_o = F.tid; asm volatile("" : "+v"(tid_o));
    const int tid = tid_o, lane = tid & 63, w = F.wave, g = lane >> 4, c16 = lane & 15;
    const bool sample = item >= 256;
    const int bb = sample ? (item - 256) >> 5 : item >> 5, h = item & 31, grp = h >> 2;
    const int nchunks = sample ? 1 : 32, nvalid = sample ? 32 : 64;
    const int rowbase = sample ? MP + bb * 32 : bb * 2048;
    unsigned char* ws = F.ws;
    const bf16_t* xact = (const bf16_t*)(ws + WS_XACT); const bf16_t* bcact = (const bf16_t*)(ws + WS_BCACT); const bf16_t* zbuf = (const bf16_t*)(ws + WS_Z); const float* dtbuf = (const float*)(ws + WS_DT);
    const float a_h = -__expf(args.in[11][h]); const float d_h = args.in[12][h];
    const int it = w >> 1, half = w & 1;
    f32x4 st[4];
#pragma unroll
    for (int nt = 0; nt < 4; ++nt) st[nt] = (f32x4){0.f, 0.f, 0.f, 0.f};
    if (sample) {
        const float* s0 = args.in[4] + ((size_t)(bb * 32 + h) * 64) * 128;
#pragma unroll
        for (int nt = 0; nt < 4; ++nt) st[nt] = *(const f32x4*)(s0 + (size_t)(16 * it + c16) * 128 + 16 * (4 * half + nt) + 4 * g);
    }
    __syncthreads();
#pragma unroll
    for (int nt = 0; nt < 4; ++nt) *(LAS u32x2*)(lds + L_SB + (16 * it + c16) * SC + (16 * (4 * half + nt) + 4 * g) * 2) = (u32x2){pk2(st[nt][0], st[nt][1]), pk2(st[nt][2], st[nt][3])};

    struct PF { u32x4 px, pb[2], pc[2]; float pdt; u32x2 pz[2]; };
    PF pfA, pfB;
    const int prow = tid >> 3, ppx = tid & 7, brow = tid >> 4, bpc = tid & 15;
    auto prefetch = [&](PF& P, int c) {
        const size_t r0 = (size_t)(rowbase + c * 64);
        const u32x4 zero4 = (u32x4){0u, 0u, 0u, 0u};
        P.px = (prow < nvalid) ? *(const u32x4*)(xact + (r0 + prow) * 2048 + h * 64 + ppx * 8) : zero4;
#pragma unroll
        for (int q = 0; q < 2; ++q) { const int rr = brow + 32 * q;
            P.pb[q] = (rr < nvalid) ? *(const u32x4*)(bcact + (r0 + rr) * 2048 + grp * 128 + bpc * 8) : zero4;
            P.pc[q] = (rr < nvalid) ? *(const u32x4*)(bcact + (r0 + rr) * 2048 + 1024 + grp * 128 + bpc * 8) : zero4; }
        P.pdt = (lane < nvalid) ? dtbuf[(r0 + lane) * 32 + h] : 0.f;
#pragma unroll
        for (int pt = 0; pt < 2; ++pt) P.pz[pt] = (16 * it + c16 < nvalid) ? *(const u32x2*)(zbuf + (r0 + 16 * it + c16) * 2048 + h * 64 + 16 * (2 * half + pt) + 4 * g) : (u32x2){0u, 0u};
    };
    prefetch(pfA, 0); if (nchunks > 1) prefetch(pfB, 1);
    const float* cache_c = args.in[2]; const float* cache_k = args.in[3]; bf16_t* cache_dst = (bf16_t*)(ws + WS_CACHE);
    constexpr int NPIECES = DEC_BATCH * PAST * 72;
    auto chunk = [&](PF& P, int c) {
        const size_t r0 = (size_t)(rowbase + c * 64);
        f32x4 cva[3], cvc[3]; int cdo[3];
        if (!sample) {
#pragma unroll
            for (int u = 0; u < 3; ++u) { const int i = ((item * 32 + c) * 3 + u) * 512 + tid; const bool ok = i < NPIECES; const int ii = ok ? i : 0;
                const int pc = ii % 72, row = ii / 72;
                const float* src = (pc < 64) ? cache_c + (size_t)row * 512 + pc * 8 : cache_k + (size_t)row * 64 + (pc - 64) * 8;
                cva[u] = __builtin_nontemporal_load((const f32x4*)src); cvc[u] = __builtin_nontemporal_load((const f32x4*)(src + 4)); cdo[u] = ok ? ((row >> 12) * KVLEN + (row & 4095)) * 72 + pc : -1; }
        }
        const float dtl = P.pdt; float acl = dtl * a_h; const u32x4 px = P.px; const u32x4 pb0 = P.pb[0], pb1 = P.pb[1], pc0 = P.pc[0], pc1 = P.pc[1];
#pragma unroll
        for (int o = 1; o < 64; o <<= 1) { const float t = __shfl_up(acl, o); if (lane >= o) acl += t; }
        const float tot = __shfl(acl, 63), dec = __expf(tot);
        const float s4l = dtl * __expf(tot - acl);
        {
            const float s4r = __shfl(s4l, prow);
            *(LAS u32x4*)(lds + L_XT + prow * SX + ppx * 16) = px;
            *(LAS u32x4*)(lds + L_XS + prow * SX + ppx * 16) = (u32x4){pk2(bflo(px[0]) * s4r, bfhi(px[0]) * s4r), pk2(bflo(px[1]) * s4r, bfhi(px[1]) * s4r), pk2(bflo(px[2]) * s4r, bfhi(px[2]) * s4r), pk2(bflo(px[3]) * s4r, bfhi(px[3]) * s4r)};
            *(LAS u32x4*)(lds + L_BN + brow * SC + bpc * 16) = pb0; *(LAS u32x4*)(lds + L_CT + brow * SC + bpc * 16) = pc0;
            *(LAS u32x4*)(lds + L_BN + (brow + 32) * SC + bpc * 16) = pb1; *(LAS u32x4*)(lds + L_CT + (brow + 32) * SC + bpc * 16) = pc1;
        }
        const u32x2 zc0 = P.pz[0], zc1 = P.pz[1];
        const float acum_i = __shfl(acl, 16 * it + c16);
        if (c + 2 < nchunks) prefetch(P, c + 2);
        __syncthreads();
        f32x4 acc3[2];
        {
            bf16x8 cb[4];
#pragma unroll
            for (int ks = 0; ks < 4; ++ks) cb[ks] = *(LAS const bf16x8*)(lds + L_CT + (16 * it + c16) * SC + (32 * ks + 8 * g) * 2);
#pragma unroll
            for (int t2 = 0; t2 < 2; ++t2) { const int jt = 2 * half + t2; f32x4 a1 = (f32x4){0.f, 0.f, 0.f, 0.f}, a3 = (f32x4){0.f, 0.f, 0.f, 0.f};
                bf16x8 bfr[4], sfr[4];
#pragma unroll
                for (int ks = 0; ks < 4; ++ks) { bfr[ks] = *(LAS const bf16x8*)(lds + L_BN + (16 * jt + c16) * SC + (32 * ks + 8 * g) * 2); sfr[ks] = *(LAS const bf16x8*)(lds + L_SB + (16 * jt + c16) * SC + (32 * ks + 8 * g) * 2); }
#pragma unroll
                for (int ks = 0; ks < 4; ++ks) { a1 = __builtin_amdgcn_mfma_f32_16x16x32_bf16(bfr[ks], cb[ks], a1, 0, 0, 0); a3 = __builtin_amdgcn_mfma_f32_16x16x32_bf16(sfr[ks], cb[ks], a3, 0, 0, 0); }
                acc3[t2] = a3;
                const int i = 16 * it + c16; float mv[4];
#pragma unroll
                for (int r = 0; r < 4; ++r) { const int j = 16 * jt + 4 * g + r; const float acj = __shfl(acl, j), dtj = __shfl(dtl, j); mv[r] = (j <= i) ? a1[r] * __expf(acum_i - acj) * dtj : 0.f; }
                *(LAS u32x2*)(lds + L_MM + i * SX + (16 * jt + 4 * g) * 2) = (u32x2){pk2(mv[0], mv[1]), pk2(mv[2], mv[3])};
            }
        }
        {
            bf16x8 xb[2];
#pragma unroll
            for (int ks = 0; ks < 2; ++ks) { LAS const unsigned char* tp = lds + L_XS + (32 * ks + 8 * g + (c16 >> 2)) * SX + (16 * it + 4 * (c16 & 3)) * 2;
                const v4i16 lo = tr16(tp), hi = tr16(tp + 4 * SX); xb[ks] = (bf16x8){lo[0], lo[1], lo[2], lo[3], hi[0], hi[1], hi[2], hi[3]}; }
#pragma unroll
            for (int nt = 0; nt < 4; ++nt) { f32x4 a4 = st[nt] * dec; const int n0 = 16 * (4 * half + nt);
#pragma unroll
                for (int ks = 0; ks < 2; ++ks) {
                    LAS const unsigned char* tp = lds + L_BN + (32 * ks + 8 * g + (c16 >> 2)) * SC + (n0 + 4 * (c16 & 3)) * 2;
                    const v4i16 lo = tr16(tp), hi = tr16(tp + 4 * SC);
                    a4 = __builtin_amdgcn_mfma_f32_16x16x32_bf16((bf16x8){lo[0], lo[1], lo[2], lo[3], hi[0], hi[1], hi[2], hi[3]}, xb[ks], a4, 0, 0, 0);
                }
                st[nt] = a4; }
        }
        __syncthreads();
        {
            bf16x8 mb[2];
#pragma unroll
            for (int ks = 0; ks < 2; ++ks) mb[ks] = *(LAS const bf16x8*)(lds + L_MM + (16 * it + c16) * SX + (32 * ks + 8 * g) * 2);
            const float ea = __expf(acum_i); const int i = 16 * it + c16;
            float ss = 0.f;
#pragma unroll
            for (int t2 = 0; t2 < 2; ++t2) { const int pt = 2 * half + t2;
                f32x4 y = acc3[t2] * ea;
#pragma unroll
                for (int ks = 0; ks < 2; ++ks) { LAS const unsigned char* tp = lds + L_XT + (32 * ks + 8 * g + (c16 >> 2)) * SX + (16 * pt + 4 * (c16 & 3)) * 2;
                    const v4i16 lo = tr16(tp), hi = tr16(tp + 4 * SX);
                    y = __builtin_amdgcn_mfma_f32_16x16x32_bf16((bf16x8){lo[0], lo[1], lo[2], lo[3], hi[0], hi[1], hi[2], hi[3]}, mb[ks], y, 0, 0, 0); }
                const u32x2 xi = *(LAS const u32x2*)(lds + L_XT + i * SX + (16 * pt + 4 * g) * 2); const u32x2 zz = t2 ? zc1 : zc0;
                const float y0 = (y[0] + d_h * bflo(xi.x)) * siluf_(bflo(zz.x)), y1 = (y[1] + d_h * bfhi(xi.x)) * siluf_(bfhi(zz.x)), y2 = (y[2] + d_h * bflo(xi.y)) * siluf_(bflo(zz.y)), y3 = (y[3] + d_h * bfhi(xi.y)) * siluf_(bfhi(zz.y));
                ss += (y0 * y0 + y1 * y1) + (y2 * y2 + y3 * y3);
                *(LAS u32x2*)(lds + L_YO + i * SX + (16 * pt + 4 * g) * 2) = (u32x2){pk2(y0, y1), pk2(y2, y3)};
            }
            ss += __shfl_xor(ss, 16); ss += __shfl_xor(ss, 32);
            if (g == 0) *(LAS float*)(lds + L_SCAL + half * 256 + i * 4) = ss;
#pragma unroll
            for (int nt = 0; nt < 4; ++nt) *(LAS u32x2*)(lds + L_SB + (16 * it + c16) * SC + (16 * (4 * half + nt) + 4 * g) * 2) = (u32x2){pk2(st[nt][0], st[nt][1]), pk2(st[nt][2], st[nt][3])};
        }
        __syncthreads();
        {
            const int row = tid >> 3, pc8 = tid & 7;
            if (row < nvalid) { const u32x4 v = *(LAS const u32x4*)(lds + L_YO + row * SX + pc8 * 16);
                *(u32x4*)((bf16_t*)(ws + WS_YZ) + (r0 + row) * 2048 + h * 64 + pc8 * 8) = v; }
            if (tid < nvalid) { LAS const float* pp = (LAS const float*)(lds + L_SCAL); ((float*)(ws + WS_SSQ))[(r0 + tid) * 32 + h] = pp[tid] + pp[64 + tid]; }
            if (!sample) {
#pragma unroll
                for (int u = 0; u < 3; ++u) if (cdo[u] >= 0) *(u32x4*)(cache_dst + (size_t)cdo[u] * 8) = (u32x4){pk2(cva[u].x, cva[u].y), pk2(cva[u].z, cva[u].w), pk2(cvc[u].x, cvc[u].y), pk2(cvc[u].z, cvc[u].w)};
            }
        }
    };
    for (int c = 0; c < nchunks; c += 2) { chunk(pfA, c); if (c + 1 < nchunks) chunk(pfB, c + 1); }
    {
        float* so = sample ? F.out + O_SSMS + ((size_t)(bb * 32 + h) * 64) * 128 : F.out + O_SSMP + ((size_t)(bb * 32 + h) * 64) * 128;
#pragma unroll
        for (int nt = 0; nt < 4; ++nt) __builtin_nontemporal_store(st[nt], (f32x4*)(so + (size_t)(16 * it + c16) * 128 + 16 * (4 * half + nt) + 4 * g));
    }
    __syncthreads();
}

namespace att {
typedef float f32x16 __attribute__((ext_vector_type(16)));
typedef short v4i16 __attribute__((ext_vector_type(4)));
__device__ __forceinline__ v4i16 tr16(LAS const unsigned char* p) { return __builtin_amdgcn_ds_read_tr16_b64_v4i16((LAS v4i16*)p); }
constexpr float QSCALE = 0.07216878364870322f * 1.4426950408889634f;
constexpr int PK_STR = 400, PV_STR = 320, PK_BYTES = 64 * PK_STR, PV_BYTES = 64 * PV_STR, PBUF = PK_BYTES + PV_BYTES;
static_assert(2 * PBUF <= LDSCTL_OFF, "prompt attention LDS");
constexpr int SK_STR = 1056, SK_MAIN = 32 * SK_STR, SK_TAIL = 32 * 128, SK_BUF = SK_MAIN + SK_TAIL;
constexpr int SQ_STR = 528, SQ_WAVE = 16 * SQ_STR, SQ_OFF = 2 * SK_BUF;
static_assert(SQ_OFF + 8 * SQ_WAVE <= LDSCTL_OFF, "sample attention LDS");
__device__ __forceinline__ unsigned pkbf(float lo, float hi) { return pg8::cvt_pk_bf16(lo, hi); }
__device__ __forceinline__ void glds16(const void* gsrc, unsigned lds_dst) { unsigned keep;
    asm volatile("s_mov_b32 %0, m0\n\ts_mov_b32 m0, %2\n\ts_nop 0\n\tglobal_load_lds_dwordx4 %1, off\n\ts_mov_b32 m0, %0" : "=&s"(keep) : "v"(gsrc), "s"(lds_dst) : "memory"); }
__device__ __forceinline__ void glds16s(const void* sbase, unsigned voff, unsigned lds_dst) { unsigned keep;
    asm volatile("s_mov_b32 %0, m0\n\ts_mov_b32 m0, %2\n\ts_nop 4\n\tglobal_load_lds_dwordx4 %1, %3\n\ts_mov_b32 m0, %0" : "=&s"(keep) : "v"(voff), "s"(lds_dst), "s"(sbase) : "memory"); }
}

template <int MODE> __device__ __forceinline__ void attn_prompt_unit(Frame& F, int b, int h, int qb) {
    using namespace att;
    LAS unsigned char* lds = F.lds; unsigned char* ws = F.ws;
    int tid_o = F.tid; asm volatile("" : "+v"(tid_o));
    const int tid = tid_o, lane = tid & 63, w = F.wave, r32 = lane & 31, hi = lane >> 5, i16 = lane & 15, gi = lane >> 4;
    const bf16_t* qg = (const bf16_t*)(ws + WS_Q); const bf16_t* kn = (const bf16_t*)(ws + WS_KN); const bf16_t* vv = (const bf16_t*)(ws + WS_V); const bf16_t* kpe = (const bf16_t*)(ws + WS_KPER);
    const float* ct = (const float*)(ws + WS_ROPE); const float* st = ct + 2080 * 32;
    const size_t rowb = (size_t)b * SEQ;
    const int NT = 4 * qb + 4, my_last = 4 * qb + (w >> 1);
    bf16x8 qf[12];
    {
        const int pos = 256 * qb + 32 * w + r32; const bf16_t* qrow = qg + (rowb + pos) * 3072 + h * 192 + 8 * hi;
#pragma unroll
        for (int ks = 0; ks < 8; ++ks) { const u32x4 v = *(const u32x4*)(qrow + 16 * ks); u32x4 o;
#pragma unroll
            for (int e = 0; e < 4; ++e) o[e] = pkbf(bflo(v[e]) * QSCALE, bfhi(v[e]) * QSCALE);
            qf[ks] = __builtin_bit_cast(bf16x8, o); }
#pragma unroll
        for (int kp = 0; kp < 2; ++kp) {
            const u32x4 v1 = *(const u32x4*)(qrow + 128 + 16 * kp), v2 = *(const u32x4*)(qrow + 160 + 16 * kp);
            const float* cp = ct + pos * 32 + 16 * kp + 8 * hi; const float* sp = st + pos * 32 + 16 * kp + 8 * hi;
            const f32x4 c0 = *(const f32x4*)cp, c1 = *(const f32x4*)(cp + 4), s0 = *(const f32x4*)sp, s1 = *(const f32x4*)(sp + 4);
            float t1[8], t2[8], o1[8], o2[8];
#pragma unroll
            for (int e = 0; e < 4; ++e) { t1[2 * e] = bflo(v1[e]); t1[2 * e + 1] = bfhi(v1[e]); t2[2 * e] = bflo(v2[e]); t2[2 * e + 1] = bfhi(v2[e]); }
#pragma unroll
            for (int e = 0; e < 8; ++e) { const float c = (e < 4) ? c0[e & 3] : c1[e & 3], sn = (e < 4) ? s0[e & 3] : s1[e & 3];
                o1[e] = (t1[e] * c - t2[e] * sn) * QSCALE; o2[e] = (t1[e] * sn + t2[e] * c) * QSCALE; }
            qf[8 + kp] = __builtin_bit_cast(bf16x8, (u32x4){pkbf(o1[0], o1[1]), pkbf(o1[2], o1[3]), pkbf(o1[4], o1[5]), pkbf(o1[6], o1[7])});
            qf[10 + kp] = __builtin_bit_cast(bf16x8, (u32x4){pkbf(o2[0], o2[1]), pkbf(o2[2], o2[3]), pkbf(o2[4], o2[5]), pkbf(o2[6], o2[7])});
        }
    }
    f32x16 oT[4];
#pragma unroll
    for (int d = 0; d < 4; ++d)
#pragma unroll
        for (int r = 0; r < 16; ++r) oT[d][r] = 0.f;
    float m_run = -INFINITY, l_run = 0.f;
    u32x4 pk[3], pv[2];
    auto gload = [&](int t) {
        const size_t r0 = rowb + (size_t)t * 64;
#pragma unroll
        for (int i = 0; i < 3; ++i) { const int idx = tid + 512 * i, row = idx / 24, pc = idx % 24;
            pk[i] = (pc < 16) ? *(const u32x4*)(kn + (r0 + row) * 2048 + h * 128 + pc * 8) : *(const u32x4*)(kpe + (r0 + row) * 64 + (pc - 16) * 8); }
#pragma unroll
        for (int i = 0; i < 2; ++i) { const int idx = tid + 512 * i, row = idx >> 4, pc = idx & 15; pv[i] = *(const u32x4*)(vv + (r0 + row) * 2048 + h * 128 + pc * 8); }
    };
    auto lstore = [&](int buf) {
        LAS unsigned char* kb = lds + buf * PBUF; LAS unsigned char* vb = kb + PK_BYTES;
#pragma unroll
        for (int i = 0; i < 3; ++i) { const int idx = tid + 512 * i, row = idx / 24, pc = idx % 24; *(LAS u32x4*)(kb + row * PK_STR + pc * 16) = pk[i]; }
#pragma unroll
        for (int i = 0; i < 2; ++i) { const int idx = tid + 512 * i, row = idx >> 4, pc = idx & 15; *(LAS u32x4*)(vb + row * PV_STR + pc * 16) = pv[i]; }
    };
    __syncthreads();
    if (MODE != 1) { gload(0); lstore(0); }
    __syncthreads();
    for (int t = 0; t < NT; ++t) {
        if (MODE != 1 && t + 1 < NT) gload(t + 1);
        if (MODE != 2 && t <= my_last) {
            LAS const unsigned char* kb = lds + (t & 1) * PBUF; LAS const unsigned char* vb = kb + PK_BYTES;
#pragma unroll
            for (int T = 0; T < 2; ++T) {
                f32x16 sT;
#pragma unroll
                for (int r = 0; r < 16; ++r) sT[r] = 0.f;
                {
                    LAS const unsigned char* kp = kb + (32 * T + r32) * PK_STR + 16 * hi;
#define PA_LDK(dst, k0) do { _Pragma("unroll") for (int i_ = 0; i_ < 4; ++i_) dst[i_] = *(LAS const bf16x8*)(kp + ((k0) + i_) * 32); } while (0)
#define PA_MMK(src, k0) do { _Pragma("unroll") for (int i_ = 0; i_ < 4; ++i_) sT = __builtin_amdgcn_mfma_f32_32x32x16_bf16(src[i_], qf[(k0) + i_], sT, 0, 0, 0); } while (0)
                    bf16x8 ka[4], kc[4];
                    PA_LDK(ka, 0); PA_LDK(kc, 4); __builtin_amdgcn_sched_barrier(0);
                    PA_MMK(ka, 0); __builtin_amdgcn_sched_barrier(0);
                    PA_LDK(ka, 8); __builtin_amdgcn_sched_barrier(0);
                    PA_MMK(kc, 4); __builtin_amdgcn_sched_barrier(0);
                    PA_MMK(ka, 8); __builtin_amdgcn_sched_barrier(0);
#undef PA_LDK
#undef PA_MMK
                }
                float mt = sT[0];
#pragma unroll
                for (int r = 1; r < 16; ++r) mt = fmaxf(mt, sT[r]);
                mt = fmaxf(mt, __shfl_xor(mt, 32));
                if (__any(mt > m_run + 8.0f)) {
                    const float m_new = fmaxf(m_run, mt); const float alpha = __builtin_amdgcn_exp2f(m_run - m_new); m_run = m_new; l_run *= alpha;
#pragma unroll
                    for (int d = 0; d < 4; ++d)
#pragma unroll
                        for (int r = 0; r < 16; ++r) oT[d][r] *= alpha;
                }
                float ps = 0.f;
#pragma unroll
                for (int r = 0; r < 16; ++r) { const float p = __builtin_amdgcn_exp2f(sT[r] - m_run); sT[r] = p; ps += p; }
                l_run += ps;
                bf16x8 pf[2];
#pragma unroll
                for (int sp = 0; sp < 2; ++sp) pf[sp] = __builtin_bit_cast(bf16x8, (u32x4){pkbf(sT[8 * sp], sT[8 * sp + 1]), pkbf(sT[8 * sp + 2], sT[8 * sp + 3]), pkbf(sT[8 * sp + 4], sT[8 * sp + 5]), pkbf(sT[8 * sp + 6], sT[8 * sp + 7])});
                __builtin_amdgcn_sched_barrier(0);
                {
                    LAS const unsigned char* tp0 = vb + (32 * T + 4 * hi + (i16 >> 2)) * PV_STR + (16 * (gi & 1) + 4 * (i16 & 3)) * 2;
#define PA_LDV(dst, d_) do { dst[0] = tr16(tp0 + (d_) * 64); dst[1] = tr16(tp0 + (d_) * 64 + 8 * PV_STR); dst[2] = tr16(tp0 + (d_) * 64 + 16 * PV_STR); dst[3] = tr16(tp0 + (d_) * 64 + 24 * PV_STR); } while (0)
#define PA_MMV(src, d_) do { oT[d_] = __builtin_amdgcn_mfma_f32_32x32x16_bf16((bf16x8){src[0][0], src[0][1], src[0][2], src[0][3], src[1][0], src[1][1], src[1][2], src[1][3]}, pf[0], oT[d_], 0, 0, 0); \
                        oT[d_] = __builtin_amdgcn_mfma_f32_32x32x16_bf16((bf16x8){src[2][0], src[2][1], src[2][2], src[2][3], src[3][0], src[3][1], src[3][2], src[3][3]}, pf[1], oT[d_], 0, 0, 0); } while (0)
                    v4i16 va[4], vc[4];
                    PA_LDV(va, 0); PA_LDV(vc, 1); __builtin_amdgcn_sched_barrier(0);
                    PA_MMV(va, 0); __builtin_amdgcn_sched_barrier(0);
                    PA_LDV(va, 2); __builtin_amdgcn_sched_barrier(0);
                    PA_MMV(vc, 1); __builtin_amdgcn_sched_barrier(0);
                    PA_LDV(vc, 3); __builtin_amdgcn_sched_barrier(0);
                    PA_MMV(va, 2); __builtin_amdgcn_sched_barrier(0);
                    PA_MMV(vc, 3); __builtin_amdgcn_sched_barrier(0);
#undef PA_LDV
#undef PA_MMV
                }
            }
        }
        if (MODE != 1 && t + 1 < NT) lstore((t + 1) & 1);
        __syncthreads();
    }
    if (MODE != 0 && l_run != 12345.f) return;
    l_run += __shfl_xor(l_run, 32);
    const float rl = 1.0f / l_run;
    bf16_t* orow = (bf16_t*)(ws + WS_O) + (rowb + 256 * qb + 32 * w + r32) * 2048 + h * 128 + 4 * hi;
#pragma unroll
    for (int d = 0; d < 4; ++d)
#pragma unroll
        for (int u = 0; u < 4; ++u) *(u32x2*)(orow + 32 * d + 8 * u) = (u32x2){pkbf(oT[d][4 * u] * rl, oT[d][4 * u + 1] * rl), pkbf(oT[d][4 * u + 2] * rl, oT[d][4 * u + 3] * rl)};
}

template <int MODE> __device__ __forceinline__ void attn_sample_item(Frame& F, int b, int rg) {
    using namespace att;
    LAS unsigned char* lds = F.lds; unsigned char* ws = F.ws;
    int tid_o = F.tid; asm volatile("" : "+v"(tid_o));
    const int tid = tid_o, lane = tid & 63, w = F.wave, c16 = lane & 15, g = lane >> 4;
    const int hh = 4 * rg + (w >> 1), q0 = 16 * (w & 1);
    const bf16_t* cache = (const bf16_t*)(ws + WS_CACHE) + (size_t)b * KVLEN * 576;
    const float* ct = (const float*)(ws + WS_ROPE); const float* st = ct + 2080 * 32;
    __syncthreads();
    bf16x8 qf[10];
    {
        const int qrow = b * 32 + q0 + c16; const bf16_t* ql = (const bf16_t*)(ws + WS_QLAT) + (size_t)qrow * 8192 + hh * 512 + 8 * g;
        LAS unsigned char* qd = lds + SQ_OFF + w * SQ_WAVE + c16 * SQ_STR + 16 * g;
#pragma unroll
        for (int ks = 0; ks < 16; ++ks) { const u32x4 v = *(const u32x4*)(ql + 32 * ks); u32x4 o;
#pragma unroll
            for (int e = 0; e < 4; ++e) o[e] = pkbf(bflo(v[e]) * QSCALE, bfhi(v[e]) * QSCALE);
            if (ks < 10) qf[ks] = __builtin_bit_cast(bf16x8, o); else *(LAS u32x4*)(qd + (ks - 10) * 64) = o; }
        const bf16_t* qp = (const bf16_t*)(ws + WS_Q) + (size_t)(MP + qrow) * 3072 + hh * 192 + 128 + 8 * g;
        const u32x4 v1 = *(const u32x4*)qp, v2 = *(const u32x4*)(qp + 32);
        const int pidx = 2048 + q0 + c16; const float* cp = ct + pidx * 32 + 8 * g; const float* sp = st + pidx * 32 + 8 * g;
        const f32x4 c0 = *(const f32x4*)cp, c1 = *(const f32x4*)(cp + 4), s0 = *(const f32x4*)sp, s1 = *(const f32x4*)(sp + 4);
        float t1[8], t2[8], o1[8], o2[8];
#pragma unroll
        for (int e = 0; e < 4; ++e) { t1[2 * e] = bflo(v1[e]); t1[2 * e + 1] = bfhi(v1[e]); t2[2 * e] = bflo(v2[e]); t2[2 * e + 1] = bfhi(v2[e]); }
#pragma unroll
        for (int e = 0; e < 8; ++e) { const float c = (e < 4) ? c0[e & 3] : c1[e & 3], sn = (e < 4) ? s0[e & 3] : s1[e & 3];
            o1[e] = (t1[e] * c - t2[e] * sn) * QSCALE; o2[e] = (t1[e] * sn + t2[e] * c) * QSCALE; }
        *(LAS u32x4*)(qd + 6 * 64) = (u32x4){pkbf(o1[0], o1[1]), pkbf(o1[2], o1[3]), pkbf(o1[4], o1[5]), pkbf(o1[6], o1[7])};
        *(LAS u32x4*)(qd + 7 * 64) = (u32x4){pkbf(o2[0], o2[1]), pkbf(o2[2], o2[3]), pkbf(o2[4], o2[5]), pkbf(o2[6], o2[7])};
    }
    f32x4 oT[32];
#pragma unroll
    for (int c = 0; c < 32; ++c) oT[c] = (f32x4){0.f, 0.f, 0.f, 0.f};
    float m_run = -INFINITY, l_run = 0.f;
    const unsigned lds0 = (unsigned)(uintptr_t)lds;
    const unsigned voff_main = (unsigned)lane * 16u, voff_tail = (unsigned)(((lane & 31) * 576 + 512 + (lane >> 5) * 8) * 2);
    auto dma = [&](int t, int buf) {
        const unsigned long long src = (unsigned long long)(uintptr_t)(cache + (size_t)t * 32 * 576);
#pragma unroll
        for (int i = 0; i < 5; ++i) { const int p = w + 8 * i;
            if (p < 32) { const unsigned long long sb = src + (unsigned long long)p * 1152ull;
                glds16s((const void*)(uintptr_t)(((unsigned long long)(unsigned)__builtin_amdgcn_readfirstlane((unsigned)(sb >> 32)) << 32) | (unsigned)__builtin_amdgcn_readfirstlane((unsigned)sb)), voff_main, (unsigned)__builtin_amdgcn_readfirstlane(lds0 + buf * SK_BUF + p * SK_STR)); }
            else if (p < 36) { const unsigned long long sb = src + (unsigned long long)(p - 32) * 32ull;
                glds16s((const void*)(uintptr_t)(((unsigned long long)(unsigned)__builtin_amdgcn_readfirstlane((unsigned)(sb >> 32)) << 32) | (unsigned)__builtin_amdgcn_readfirstlane((unsigned)sb)), voff_tail, (unsigned)__builtin_amdgcn_readfirstlane(lds0 + buf * SK_BUF + SK_MAIN + (p - 32) * 1024)); } }
    };
    constexpr int NT = KVLEN / 32;
    dma(0, 0);
    asm volatile("s_waitcnt vmcnt(0)" ::: "memory");
    __syncthreads();
    for (int t = 0; t < NT; ++t) {
        if (t + 1 < NT) dma(t + 1, (t + 1) & 1);
        LAS const unsigned char* kb = lds + (t & 1) * SK_BUF;
        f32x4 sT[2];
        sT[0] = (f32x4){0.f, 0.f, 0.f, 0.f}; sT[1] = sT[0];
        {
            LAS const unsigned char* qlp = lds + SQ_OFF + w * SQ_WAVE + c16 * SQ_STR + 16 * g;
#define SB_KLD(ks, T) (((ks) < 16) ? *(LAS const bf16x8*)(kb + (16 * (T) + c16) * SK_STR + (32 * (ks) + 8 * g) * 2) : *(LAS const bf16x8*)(kb + SK_MAIN + (4 * ((ks) - 16) + g) * 512 + (16 * (T) + c16) * 16))
#define SB_LDB(dst, k0) do { dst[0] = SB_KLD((k0), 0); dst[1] = SB_KLD((k0), 1); dst[2] = SB_KLD((k0) + 1, 0); dst[3] = SB_KLD((k0) + 1, 1); } while (0)
#define SB_QF(ks) (((ks) < 10) ? qf[(ks) < 10 ? (ks) : 0] : *(LAS const bf16x8*)(qlp + ((ks) - 10) * 64))
#define SB_MMB(src, k0) do { const bf16x8 q0_ = SB_QF(k0), q1_ = SB_QF((k0) + 1); \
            sT[0] = __builtin_amdgcn_mfma_f32_16x16x32_bf16(src[0], q0_, sT[0], 0, 0, 0); sT[1] = __builtin_amdgcn_mfma_f32_16x16x32_bf16(src[1], q0_, sT[1], 0, 0, 0); \
            sT[0] = __builtin_amdgcn_mfma_f32_16x16x32_bf16(src[2], q1_, sT[0], 0, 0, 0); sT[1] = __builtin_amdgcn_mfma_f32_16x16x32_bf16(src[3], q1_, sT[1], 0, 0, 0); } while (0)
            bf16x8 ka[4], kc[4];
            SB_LDB(ka, 0);
#pragma unroll
            for (int bi = 0; bi < 9; bi += 2) {
                if (bi + 1 < 9) { SB_LDB(kc, 2 * (bi + 1)); } __builtin_amdgcn_sched_barrier(0);
                SB_MMB(ka, 2 * bi); __builtin_amdgcn_sched_barrier(0);
                if (bi + 2 < 9) { SB_LDB(ka, 2 * (bi + 2)); } __builtin_amdgcn_sched_barrier(0);
                if (bi + 1 < 9) { SB_MMB(kc, 2 * (bi + 1)); } __builtin_amdgcn_sched_barrier(0);
            }
#undef SB_KLD
#undef SB_LDB
#undef SB_QF
#undef SB_MMB
        }
        float mt = fmaxf(fmaxf(fmaxf(sT[0][0], sT[0][1]), fmaxf(sT[0][2], sT[0][3])), fmaxf(fmaxf(sT[1][0], sT[1][1]), fmaxf(sT[1][2], sT[1][3])));
        mt = fmaxf(mt, __shfl_xor(mt, 16)); mt = fmaxf(mt, __shfl_xor(mt, 32));
        if (__any(mt > m_run + 8.0f)) {
            const float m_new = fmaxf(m_run, mt); const float alpha = __builtin_amdgcn_exp2f(m_run - m_new); m_run = m_new; l_run *= alpha;
#pragma unroll
            for (int c = 0; c < 32; ++c) oT[c] = oT[c] * alpha;
        }
        float p[8];
#pragma unroll
        for (int T = 0; T < 2; ++T)
#pragma unroll
            for (int r = 0; r < 4; ++r) { p[4 * T + r] = __builtin_amdgcn_exp2f(sT[T][r] - m_run); l_run += p[4 * T + r]; }
        const bf16x8 pf = __builtin_bit_cast(bf16x8, (u32x4){pkbf(p[0], p[1]), pkbf(p[2], p[3]), pkbf(p[4], p[5]), pkbf(p[6], p[7])});
        {
            LAS const unsigned char* tp0 = kb + (4 * g + (c16 >> 2)) * SK_STR + (4 * (c16 & 3)) * 2;
#define SB_VLD(dst, c0) do { dst[0] = tr16(tp0 + (c0) * 32); dst[1] = tr16(tp0 + (c0) * 32 + 16 * SK_STR); dst[2] = tr16(tp0 + ((c0) + 1) * 32); dst[3] = tr16(tp0 + ((c0) + 1) * 32 + 16 * SK_STR); } while (0)
#define SB_VMM(src, c0) do { oT[(c0)] = __builtin_amdgcn_mfma_f32_16x16x32_bf16((bf16x8){src[0][0], src[0][1], src[0][2], src[0][3], src[1][0], src[1][1], src[1][2], src[1][3]}, pf, oT[(c0)], 0, 0, 0); \
                oT[(c0) + 1] = __builtin_amdgcn_mfma_f32_16x16x32_bf16((bf16x8){src[2][0], src[2][1], src[2][2], src[2][3], src[3][0], src[3][1], src[3][2], src[3][3]}, pf, oT[(c0) + 1], 0, 0, 0); } while (0)
            v4i16 va[4], vc[4];
            SB_VLD(va, 0);
#pragma unroll
            for (int cb = 0; cb < 16; cb += 2) {
                SB_VLD(vc, 2 * (cb + 1)); __builtin_amdgcn_sched_barrier(0);
                SB_VMM(va, 2 * cb); __builtin_amdgcn_sched_barrier(0);
                if (cb + 2 < 16) { SB_VLD(va, 2 * (cb + 2)); } __builtin_amdgcn_sched_barrier(0);
                SB_VMM(vc, 2 * (cb + 1)); __builtin_amdgcn_sched_barrier(0);
            }
#undef SB_VLD
#undef SB_VMM
        }
        asm volatile("s_waitcnt vmcnt(0)" ::: "memory");
        __syncthreads();
    }
    l_run += __shfl_xor(l_run, 16); l_run += __shfl_xor(l_run, 32);
    const float rl = 1.0f / l_run;
    bf16x8 of[16];
#pragma unroll
    for (int kb2 = 0; kb2 < 16; ++kb2) { const f32x4 a = oT[2 * kb2] * rl, c2 = oT[2 * kb2 + 1] * rl;
        of[kb2] = __builtin_bit_cast(bf16x8, (u32x4){pkbf(a[0], a[1]), pkbf(a[2], a[3]), pkbf(c2[0], c2[1]), pkbf(c2[2], c2[3])}); }
    const bf16_t* wuv = (const bf16_t*)(ws + WS_WUV) + (size_t)(hh * 128 + c16) * 512 + 4 * g;
    bf16_t* orow = (bf16_t*)(ws + WS_O) + (size_t)(MP + b * 32 + q0 + c16) * 2048 + hh * 128 + 4 * g;
#pragma unroll 2
    for (int vt = 0; vt < 8; ++vt) { f32x4 a = (f32x4){0.f, 0.f, 0.f, 0.f};
#pragma unroll
        for (int kb2 = 0; kb2 < 16; ++kb2) { const u32x2 w0 = *(const u32x2*)(wuv + (size_t)vt * 16 * 512 + 32 * kb2), w1 = *(const u32x2*)(wuv + (size_t)vt * 16 * 512 + 32 * kb2 + 16);
            a = __builtin_amdgcn_mfma_f32_16x16x32_bf16(__builtin_bit_cast(bf16x8, (u32x4){w0.x, w0.y, w1.x, w1.y}), of[kb2], a, 0, 0, 0); }
        *(u32x2*)(orow + 16 * vt) = (u32x2){pkbf(a[0], a[1]), pkbf(a[2], a[3])}; }
}


struct MixOrder {
    const char *A0, *B0, *A1, *B1; int G, c;
    __device__ __forceinline__ bool next(int i, pg8::Unit& u) const {
        const int idx = (i >> 1) * G + c; if (idx >= (MP / 256) * 4) return false;
        u.pm = idx >> 2; u.pn = idx & 3; u.seg = i & 1;
        u.a = ((i & 1) ? A1 : A0) + (size_t)u.pm * 256 * 2048 * 2; u.b = ((i & 1) ? B1 : B0) + (size_t)u.pn * 256 * 2048 * 2; return true;
    }
};
struct EpiMix {
    static constexpr bool PERM = true;
    const bf16_t* gates; const float* bgate; float* t1; bf16_t* uo;
    __device__ __forceinline__ void operator()(const f32x4 (&acc)[2][2][4][2], const pg8::Unit& u, int wr, int wc, int fr, int fq) const {
        const int row0 = u.pm * 256 + wr * 64 + fr, col0 = u.pn * 256 + wc * 32 + 8 * fq, gofs = u.seg ? 1024 : 0;
#pragma unroll
        for (int bj = 0; bj < 2; ++bj) { const int col = col0 + bj * 128;
            const f32x4 bg0 = *(const f32x4*)(bgate + gofs + col), bg1 = *(const f32x4*)(bgate + gofs + col + 4);
#pragma unroll
            for (int ai = 0; ai < 2; ++ai)
#pragma unroll
                for (int m = 0; m < 4; ++m) { const size_t row = (size_t)(row0 + ai * 128 + m * 16);
                    const u32x4 gv = *(const u32x4*)(gates + row * 2048 + gofs + col);
                    const f32x4 a0 = acc[ai][bj][m][0], a1 = acc[ai][bj][m][1];
                    f32x4 r0, r1;
                    r0[0] = sigmoidf_(bflo(gv[0]) + bg0[0]) * a0[0]; r0[1] = sigmoidf_(bfhi(gv[0]) + bg0[1]) * a0[1]; r0[2] = sigmoidf_(bflo(gv[1]) + bg0[2]) * a0[2]; r0[3] = sigmoidf_(bfhi(gv[1]) + bg0[3]) * a0[3];
                    r1[0] = sigmoidf_(bflo(gv[2]) + bg1[0]) * a1[0]; r1[1] = sigmoidf_(bfhi(gv[2]) + bg1[1]) * a1[1]; r1[2] = sigmoidf_(bflo(gv[3]) + bg1[2]) * a1[2]; r1[3] = sigmoidf_(bfhi(gv[3]) + bg1[3]) * a1[3];
                    float* tp = t1 + row * 1024 + col;
                    if (u.seg == 0) { *(f32x4*)tp = r0; *(f32x4*)(tp + 4) = r1; }
                    else { const f32x4 p0 = *(const f32x4*)tp, p1 = *(const f32x4*)(tp + 4); r0 = r0 + p0; r1 = r1 + p1;
                        *(u32x4*)(uo + row * 1024 + col) = (u32x4){pg8::cvt_pk_bf16(r0[0], r0[1]), pg8::cvt_pk_bf16(r0[2], r0[3]), pg8::cvt_pk_bf16(r1[0], r1[1]), pg8::cvt_pk_bf16(r1[2], r1[3])}; } } }
    }
};
struct EpiV1 {
    static constexpr bool PERM = true;
    const float* xin; const float* g1; float* v1o; bf16_t* ao; float* st;
    __device__ __forceinline__ void operator()(const f32x4 (&acc)[2][2][4][2], const pg8::Unit& u, int wr, int wc, int fr, int fq) const {
        const int row0 = u.pm * 256 + wr * 64 + fr, col0 = u.pn * 256 + wc * 32 + 8 * fq;
        f32x4 gA[2][2];
#pragma unroll
        for (int bj = 0; bj < 2; ++bj) { gA[bj][0] = *(const f32x4*)(g1 + col0 + bj * 128); gA[bj][1] = *(const f32x4*)(g1 + col0 + bj * 128 + 4); }
#pragma unroll
        for (int ai = 0; ai < 2; ++ai)
#pragma unroll
            for (int m = 0; m < 4; ++m) { const int row = row0 + ai * 128 + m * 16; const float* rp = xin + (size_t)row * 1024; float s1 = 0.f, s2 = 0.f;
#pragma unroll
                for (int bj = 0; bj < 2; ++bj) { const int col = col0 + bj * 128;
                    const f32x4 x0 = *(const f32x4*)(rp + col), x1 = *(const f32x4*)(rp + col + 4);
                    const f32x4 a = x0 * ALPHA + acc[ai][bj][m][0], b = x1 * ALPHA + acc[ai][bj][m][1];
                    *(f32x4*)(v1o + (size_t)row * 1024 + col) = a; *(f32x4*)(v1o + (size_t)row * 1024 + col + 4) = b;
                    s1 += ((a[0] + a[1]) + (a[2] + a[3])) + ((b[0] + b[1]) + (b[2] + b[3]));
                    s2 += ((a[0] * a[0] + a[1] * a[1]) + (a[2] * a[2] + a[3] * a[3])) + ((b[0] * b[0] + b[1] * b[1]) + (b[2] * b[2] + b[3] * b[3]));
                    const f32x4 ga = a * gA[bj][0], gb = b * gA[bj][1];
                    *(u32x4*)(ao + (size_t)row * 1024 + col) = (u32x4){pg8::cvt_pk_bf16(ga[0], ga[1]), pg8::cvt_pk_bf16(ga[2], ga[3]), pg8::cvt_pk_bf16(gb[0], gb[1]), pg8::cvt_pk_bf16(gb[2], gb[3])}; }
                s1 += __shfl_xor(s1, 16); s1 += __shfl_xor(s1, 32); s2 += __shfl_xor(s2, 16); s2 += __shfl_xor(s2, 32);
                if (fq == 0) { atomicAdd(st + 2 * (size_t)row, s1); atomicAdd(st + 2 * (size_t)row + 1, s2); } }
    }
};
struct EpiV2 {
    static constexpr bool PERM = true;
    const float* v1i; const float* st; const float* g1; const float* b1; float* out;
    __device__ __forceinline__ void operator()(const f32x4 (&acc)[2][2][4][2], const pg8::Unit& u, int wr, int wc, int fr, int fq) const {
        const int row0 = u.pm * 256 + wr * 64 + fr, col0 = u.pn * 256 + wc * 32 + 8 * fq;
        f32x4 gA[2][2], bA[2][2];
#pragma unroll
        for (int bj = 0; bj < 2; ++bj) { gA[bj][0] = *(const f32x4*)(g1 + col0 + bj * 128) * ALPHA; gA[bj][1] = *(const f32x4*)(g1 + col0 + bj * 128 + 4) * ALPHA; bA[bj][0] = *(const f32x4*)(b1 + col0 + bj * 128) * ALPHA; bA[bj][1] = *(const f32x4*)(b1 + col0 + bj * 128 + 4) * ALPHA; }
#pragma unroll
        for (int ai = 0; ai < 2; ++ai)
#pragma unroll
            for (int m = 0; m < 4; ++m) { const int row = row0 + ai * 128 + m * 16; const float* rp = v1i + (size_t)row * 1024;
                const f32x2 ss = *(const f32x2*)(st + 2 * (size_t)row); const float mu = ss.x * (1.f / 1024.f), rs = 1.0f / sqrtf(ss.y * (1.f / 1024.f) - mu * mu + LN_EPS);
#pragma unroll
                for (int bj = 0; bj < 2; ++bj) { const int col = col0 + bj * 128;
                    const f32x4 x0 = (*(const f32x4*)(rp + col) - mu) * rs, x1 = (*(const f32x4*)(rp + col + 4) - mu) * rs;
                    *(f32x4*)(out + (size_t)row * 1024 + col) = x0 * gA[bj][0] + bA[bj][0] + acc[ai][bj][m][0]; *(f32x4*)(out + (size_t)row * 1024 + col + 4) = x1 * gA[bj][1] + bA[bj][1] + acc[ai][bj][m][1]; } }
    }
};
struct EpiRelu2 {
    static constexpr bool PERM = true;
    bf16_t* out; const float* st; const float* gw;
    __device__ __forceinline__ void operator()(const f32x4 (&acc)[2][2][4][2], const pg8::Unit& u, int wr, int wc, int fr, int fq) const {
        const int row0 = u.pm * 256 + wr * 64 + fr, col0 = u.pn * 256 + wc * 32 + 8 * fq;
        bf16_t* p = out + (size_t)row0 * 4096 + col0;
        f32x4 gA[2][2], bA[2][2];
#pragma unroll
        for (int bj = 0; bj < 2; ++bj) { gA[bj][0] = *(const f32x4*)(gw + col0 + bj * 128); gA[bj][1] = *(const f32x4*)(gw + col0 + bj * 128 + 4); bA[bj][0] = *(const f32x4*)(gw + 4096 + col0 + bj * 128); bA[bj][1] = *(const f32x4*)(gw + 4096 + col0 + bj * 128 + 4); }
#pragma unroll
        for (int ai = 0; ai < 2; ++ai)
#pragma unroll
            for (int m = 0; m < 4; ++m) { const int row = row0 + ai * 128 + m * 16;
                const f32x2 ss = *(const f32x2*)(st + 2 * (size_t)row); const float mu = ss.x * (1.f / 1024.f), rs = 1.0f / sqrtf(ss.y * (1.f / 1024.f) - mu * mu + LN_EPS), rm = rs * mu;
#pragma unroll
                for (int bj = 0; bj < 2; ++bj) { f32x4 v0 = acc[ai][bj][m][0] * rs - gA[bj][0] * rm + bA[bj][0], v1 = acc[ai][bj][m][1] * rs - gA[bj][1] * rm + bA[bj][1];
#pragma unroll
                    for (int e = 0; e < 4; ++e) { const float a = fmaxf(v0[e], 0.f), b = fmaxf(v1[e], 0.f); v0[e] = a * a; v1[e] = b * b; }
                    *(u32x4*)(p + (size_t)(ai * 128 + m * 16) * 4096 + bj * 128) = (u32x4){pg8::cvt_pk_bf16(v0[0], v0[1]), pg8::cvt_pk_bf16(v0[2], v0[3]), pg8::cvt_pk_bf16(v1[0], v1[1]), pg8::cvt_pk_bf16(v1[2], v1[3])}; } }
    }
};
template <bool FINAL> __device__ __forceinline__ void ln_rows(Frame& F, const float* src, const float* gam, const float* bet, float* dstf, bf16_t* dstb) {
    const int gw = F.vcu * NWAVES + F.wave, NGW = F.G * NWAVES, lane = F.lane;
    f32x4 gg[4], bb[4];
#pragma unroll
    for (int j = 0; j < 4; ++j) { gg[j] = *(const f32x4*)(gam + 4 * lane + 256 * j); bb[j] = *(const f32x4*)(bet + 4 * lane + 256 * j); }
    for (int m = gw; m < M; m += NGW) {
        const float* r = src + (size_t)m * 1024; f32x4 v[4]; float s = 0.f;
#pragma unroll
        for (int j = 0; j < 4; ++j) { v[j] = FINAL ? __builtin_nontemporal_load((const f32x4*)(r + 4 * lane + 256 * j)) : *(const f32x4*)(r + 4 * lane + 256 * j); s += (v[j].x + v[j].y) + (v[j].z + v[j].w); }
        const float mean = wave_sum(s) * (1.f / 1024.f); float s2 = 0.f;
#pragma unroll
        for (int j = 0; j < 4; ++j) { v[j] = v[j] - mean; s2 += (v[j].x * v[j].x + v[j].y * v[j].y) + (v[j].z * v[j].z + v[j].w * v[j].w); }
        const float rstd = 1.f / sqrtf(wave_sum(s2) * (1.f / 1024.f) + LN_EPS);
        float* of = FINAL ? ((m < MP) ? F.out + O_YP + (size_t)m * 1024 : F.out + O_YS + (size_t)(m - MP) * 1024) : dstf + (size_t)m * 1024;
#pragma unroll
        for (int j = 0; j < 4; ++j) { const f32x4 o = v[j] * rstd * gg[j] + bb[j]; if (FINAL) __builtin_nontemporal_store(o, (f32x4*)(of + 4 * lane + 256 * j)); else *(f32x4*)(of + 4 * lane + 256 * j) = o;
            if (!FINAL) *(u32x2*)(dstb + (size_t)m * 1024 + 4 * lane + 256 * j) = (u32x2){pk2(o.x, o.y), pk2(o.z, o.w)}; }
    }
}
__device__ __forceinline__ void yz_norm_item(Frame& F, const float* gain, int pm) {
    const int lane = F.lane; unsigned char* ws = F.ws;
    f32x4 g0[4], g1[4];
#pragma unroll
    for (int i = 0; i < 4; ++i) { const int ch = lane * 8 + 512 * i; g0[i] = *(const f32x4*)(gain + ch); g1[i] = *(const f32x4*)(gain + ch + 4); }
#pragma unroll 1
    for (int hb = 0; hb < 4; ++hb) {
        u32x4 v[2][4]; f32x4 q4[2][4];
#pragma unroll
        for (int r = 0; r < 2; ++r) { const size_t row = (size_t)pm * 64 + F.wave * 8 + hb * 2 + r; const bf16_t* p = (const bf16_t*)(ws + WS_YZ) + row * 2048; const float* sq = (const float*)(ws + WS_SSQ) + row * 32;
#pragma unroll
            for (int i = 0; i < 4; ++i) { const int ch = lane * 8 + 512 * i; v[r][i] = *(const u32x4*)(p + ch); q4[r][i] = *(const f32x4*)(sq + 4 * (ch >> 8)); } }
#pragma unroll
        for (int r = 0; r < 2; ++r) { const size_t row = (size_t)pm * 64 + F.wave * 8 + hb * 2 + r; bf16_t* p = (bf16_t*)(ws + WS_YZ) + row * 2048;
#pragma unroll
            for (int i = 0; i < 4; ++i) { const int ch = lane * 8 + 512 * i; const f32x4 q = q4[r][i]; const float rs = 1.0f / sqrtf(((q.x + q.y) + (q.z + q.w)) * (1.0f / 256.0f) + RMS_EPS); const u32x4 x = v[r][i];
                *(u32x4*)(p + ch) = (u32x4){pk2(bflo(x[0]) * rs * g0[i][0], bfhi(x[0]) * rs * g0[i][1]), pk2(bflo(x[1]) * rs * g0[i][2], bfhi(x[1]) * rs * g0[i][3]),
                                            pk2(bflo(x[2]) * rs * g1[i][0], bfhi(x[2]) * rs * g1[i][1]), pk2(bflo(x[3]) * rs * g1[i][2], bfhi(x[3]) * rs * g1[i][3])}; } }
    }
}

__device__ __forceinline__ void sgemm_tile(Frame& F, const bf16_t* a0, int lda, const bf16_t* b0, int ldb, int K, float (&v)[8]) {
    int tid_o = F.tid; asm volatile("" : "+v"(tid_o));
    const int tid = tid_o, lane = tid & 63, w = F.wave, c16 = lane & 15, g = lane >> 4;
    const int kw = K >> 3, nks = kw >> 5;
    const bf16_t* ap = a0 + (size_t)c16 * lda + w * kw + 8 * g;
    const bf16_t* bp = b0 + (size_t)c16 * ldb + w * kw + 8 * g;
    f32x4 acc[4][4];
#pragma unroll
    for (int i = 0; i < 4; ++i)
#pragma unroll
        for (int j = 0; j < 4; ++j) acc[i][j] = (f32x4){0.f, 0.f, 0.f, 0.f};
    bf16x8 af[4], bfr[4], an[4], bn[4];
#pragma unroll
    for (int i = 0; i < 4; ++i) { af[i] = *(const bf16x8*)(ap + (size_t)i * 16 * lda); bfr[i] = *(const bf16x8*)(bp + (size_t)i * 16 * ldb); }
    for (int ks = 0; ks < nks; ++ks) {
        const int kn = (ks + 1 < nks) ? (ks + 1) * 32 : ks * 32;
#pragma unroll
        for (int i = 0; i < 4; ++i) { an[i] = *(const bf16x8*)(ap + (size_t)i * 16 * lda + kn); bn[i] = *(const bf16x8*)(bp + (size_t)i * 16 * ldb + kn); }
#pragma unroll
        for (int i = 0; i < 4; ++i)
#pragma unroll
            for (int j = 0; j < 4; ++j) acc[i][j] = __builtin_amdgcn_mfma_f32_16x16x32_bf16(af[i], bfr[j], acc[i][j], 0, 0, 0);
#pragma unroll
        for (int i = 0; i < 4; ++i) { af[i] = an[i]; bfr[i] = bn[i]; }
    }
    __syncthreads();
    LAS float* slab = (LAS float*)(F.lds + w * 16384);
#pragma unroll
    for (int i = 0; i < 4; ++i)
#pragma unroll
        for (int j = 0; j < 4; ++j)
#pragma unroll
            for (int r = 0; r < 4; ++r) slab[(16 * i + 4 * g + r) * 64 + 16 * j + c16] = acc[i][j][r];
    __syncthreads();
    const int row = tid >> 3, c8 = tid & 7;
    f32x4 s0 = (f32x4){0.f, 0.f, 0.f, 0.f}, s1 = s0;
#pragma unroll
    for (int ww = 0; ww < 8; ++ww) { LAS const float* p = (LAS const float*)(F.lds + ww * 16384) + row * 64 + c8 * 8; s0 = s0 + *(LAS const f32x4*)p; s1 = s1 + *(LAS const f32x4*)(p + 4); }
    v[0] = s0[0]; v[1] = s0[1]; v[2] = s0[2]; v[3] = s0[3]; v[4] = s1[0]; v[5] = s1[1]; v[6] = s1[2]; v[7] = s1[3];
}

constexpr int N_PHASES = 11;
__global__ void __launch_bounds__(NTHREADS, 2) fwd_kernel(Args args) {
    extern __shared__ __attribute__((aligned(16))) unsigned char lds_raw[];
    Frame F;
    F.lds = (LAS unsigned char*)lds_raw;
    F.tid = threadIdx.x; F.lane = F.tid & 63; F.wave = __builtin_amdgcn_readfirstlane(F.tid >> 6);
    F.G = gridDim.x; { const int bx = blockIdx.x; F.vcu = (F.G % 8 == 0) ? (bx % 8) * (F.G / 8) + bx / 8 : bx; }
    F.ws = args.ws; F.out = args.out;
    unsigned* ctl = (unsigned*)(args.ws + WS_CTL);
    volatile LAS unsigned* MISC = (volatile LAS unsigned*)(F.lds + MISC_OFF);
    for (int u = F.tid; u < (LDS_BYTES - LDSCTL_OFF) / 4; u += NTHREADS) ((LAS unsigned*)(F.lds + LDSCTL_OFF))[u] = 0u;
    __syncthreads();
    XcdBarrier bar; bar.bar = ctl + CW_BAR; bar.x = 0; bar.st = nullptr;
#if !MK_PER_PHASE
    bar = xcd_barrier_post(ctl + CW_BAR, MISC + 8);
#define GRID_BAR() xcd_barrier(bar)
#else
#define GRID_BAR() do {} while (0)
#endif
    const int lo = args.ph_lo, hi = args.ph_hi;
#define IN(k) (lo <= (k) && (k) < hi)
#define BOTH(k) (IN(k) && IN((k) + 1))

    if (IN(0)) { for (int rep = 0; rep < NREP(0); ++rep) { p0_prologue(F, args); if (BOTH(0)) GRID_BAR(); } }
    if (IN(1)) {
        unsigned char* ws = args.ws;
        {
            pg8::SegOrder S; S.nseg = 1; S.G = F.G; S.c = (int)blockIdx.x; S.dup = 1;
            S.s[0] = pg8::Seg{(const char*)(ws + WS_XB), (const char*)(ws + WS_WIN), M / 256, NPROJ / 256, 0, (M / 256) * (NPROJ / 256), (size_t)256 * 1024 * 2, (size_t)256 * 1024 * 2};
            S.total = S.s[0].count; S.dup = DIAG_DUP_G1;
            EpiProj E{ws, args.out};
            pg8::gemm_phase<EpiProj, pg8::SegOrder>(F.lds, 1024, 1024, 1024, S, E);
        }
        {
            pg8::WqlOrder S{(const char*)(ws + WS_WUKB), (const char*)(ws + WS_BQL), F.G, (int)blockIdx.x};
            bf16_t* wq = (bf16_t*)(ws + WS_WQL); EpiStore E{wq, wq, wq, wq, 512, 512, 512, 512};
            pg8::gemm_phase<EpiStore, pg8::WqlOrder>(F.lds, 256, 2048, 256, S, E);
        }
        if (BOTH(1)) GRID_BAR();
    }
    if (IN(2)) { p1b_rows(F, args);
        {
            const int gt = F.vcu * NTHREADS + F.tid, NGT = F.G * NTHREADS; const float* part = (const float*)(args.ws + WS_GWP); float* gwv = (float*)(args.ws + WS_GW); float* stz = (float*)(args.ws + WS_ST);
            for (int i = gt; i < 2 * 4096; i += NGT) { const int n = i & 4095, wh = i >> 12; float a = 0.f;
#pragma unroll 8
                for (int ks = 0; ks < 32; ++ks) a += part[(ks * 2 + wh) * 4096 + n];
                gwv[i] = a; }
            for (int i = gt; i < M * 2; i += NGT) stz[i] = 0.f;
        }
        for (int item = F.vcu; item < (M / 64) * 8; item += F.G) conv_item(F, args, item);
        if (BOTH(2)) GRID_BAR(); }
    if (IN(3)) {
        unsigned char* ws = args.ws;
        for (int item = F.vcu; item < 1280 + (DIAG_DUP_SSD == 2 ? 1280 : DIAG_DUP_SSD == 3 ? 256 : DIAG_DUP_SSD == 4 ? 1024 : 0); item += F.G) ssd_item(F, args, item < 1280 ? item : (DIAG_DUP_SSD == 4 ? item - 1024 : item - 1280));
        {
            pg8::SegOrder S; S.nseg = 4; S.G = F.G; S.c = (int)blockIdx.x; S.dup = DIAG_DUP_G2;
            const size_t pt = (size_t)256 * 512 * 2;
            S.s[0] = pg8::Seg{(const char*)(ws + WS_QAN), (const char*)(ws + WS_WQ), M / 256, 12, 0, (M / 256) * 12, pt, pt};
            S.s[1] = pg8::Seg{(const char*)(ws + WS_CKVN), (const char*)(ws + WS_WUK), MP / 256, 8, 816, 512, pt, pt};
            S.s[2] = pg8::Seg{(const char*)(ws + WS_CKVN), (const char*)(ws + WS_WUV), MP / 256, 8, 1328, 512, pt, pt};
            S.s[3] = pg8::Seg{(const char*)(ws + WS_QAN) + (size_t)MP * 512 * 2, (const char*)(ws + WS_WQL), MS / 256, 32, 1840, 128, pt, pt};
            S.total = 1968;
            EpiStore E{(bf16_t*)(ws + WS_Q), (bf16_t*)(ws + WS_KN), (bf16_t*)(ws + WS_V), (bf16_t*)(ws + WS_QLAT), 3072, 2048, 2048, 8192};
            pg8::gemm_phase<EpiStore, pg8::SegOrder>(F.lds, 512, 512, 512, S, E);
        }
        if (BOTH(3)) GRID_BAR();
    }
    if (IN(4)) for (int rep = 0; rep < NREP(4); ++rep) {
        constexpr int NNORM = M / 64;
        const int NITEMS = 128 + NNORM + 1024;
        const bool pin_mode = F.G >= 256;
        bool pinned = pin_mode && (F.vcu & 1) == 0 && (F.vcu >> 1) < 128;
        for (;;) {
            __syncthreads();
            if (F.tid == 0) MISC[0] = pinned ? (unsigned)(F.vcu >> 1) : (pin_mode ? 128u : 0u) + __hip_atomic_fetch_add(ctl + CW_QUEUE + 64 * rep, 1u, __ATOMIC_RELAXED, __HIP_MEMORY_SCOPE_AGENT);
            __syncthreads();
            pinned = false;
            const int item = (int)MISC[0];
            if (item >= NITEMS) break;
            if (item < 128) attn_sample_item<0>(F, item >> 2, item & 3);
            else if (item < 128 + NNORM) yz_norm_item(F, args.in[13], item - 128);
            else { const int j = item - 128 - NNORM, qb = 7 - (j >> 7), bh = j & 127; attn_prompt_unit<0>(F, bh >> 4, bh & 15, qb); }
        }
        if (BOTH(4)) GRID_BAR();
    }
    if (IN(5)) for (int rep = 0; rep < NREP(5); ++rep) {
        unsigned char* ws = args.ws;
        MixOrder S{(const char*)(ws + WS_YZ), (const char*)(ws + WS_WSSM), (const char*)(ws + WS_O), (const char*)(ws + WS_WMLA), F.G, (int)blockIdx.x};
        EpiMix E{(const bf16_t*)(ws + WS_G), args.in[7], (float*)(ws + WS_T1), (bf16_t*)(ws + WS_U)};
        pg8::gemm_phase<EpiMix, MixOrder>(F.lds, 2048, 2048, 2048, S, E);
        for (int tile = F.vcu; tile < 256; tile += F.G) {
            const int rt = tile >> 4, ctile = tile & 15, row = MP + rt * 64 + (F.tid >> 3), col = ctile * 64 + (F.tid & 7) * 8;
            const bf16_t* gp = (const bf16_t*)(ws + WS_G) + (size_t)row * 2048 + col; const float* bg = args.in[7] + col;
            float v[8], r1[8];
            sgemm_tile(F, (const bf16_t*)(ws + WS_YZ) + (size_t)(MP + rt * 64) * 2048, 2048, (const bf16_t*)(ws + WS_WSSM) + (size_t)(ctile * 64) * 2048, 2048, 2048, v);
            { const u32x4 gv = *(const u32x4*)gp;
#pragma unroll
              for (int e = 0; e < 8; ++e) { const float gg = (e & 1) ? bfhi(gv[e >> 1]) : bflo(gv[e >> 1]); r1[e] = sigmoidf_(gg + bg[e]) * v[e]; } }
            sgemm_tile(F, (const bf16_t*)(ws + WS_O) + (size_t)(MP + rt * 64) * 2048, 2048, (const bf16_t*)(ws + WS_WMLA) + (size_t)(ctile * 64) * 2048, 2048, 2048, v);
            { const u32x4 gv = *(const u32x4*)(gp + 1024);
#pragma unroll
              for (int e = 0; e < 8; ++e) { const float gg = (e & 1) ? bfhi(gv[e >> 1]) : bflo(gv[e >> 1]); r1[e] += sigmoidf_(gg + bg[1024 + e]) * v[e]; } }
            *(u32x4*)((bf16_t*)(ws + WS_U) + (size_t)row * 1024 + col) = (u32x4){pk2(r1[0], r1[1]), pk2(r1[2], r1[3]), pk2(r1[4], r1[5]), pk2(r1[6], r1[7])};
        }
        if (BOTH(5)) GRID_BAR();
    }
    if (IN(6)) for (int rep = 0; rep < NREP(6); ++rep) {
        unsigned char* ws = args.ws;
        pg8::SegOrder S; S.nseg = 1; S.G = F.G; S.c = (int)blockIdx.x; S.dup = 1;
        S.s[0] = pg8::Seg{(const char*)(ws + WS_U), (const char*)(ws + WS_WOUT), MP / 256, 4, 0, (MP / 256) * 4, (size_t)256 * 1024 * 2, (size_t)256 * 1024 * 2}; S.total = S.s[0].count;
        EpiV1 E{args.in[0], args.in[22], (float*)(ws + WS_HF), (bf16_t*)(ws + WS_HB), (float*)(ws + WS_ST)};
        pg8::gemm_phase<EpiV1, pg8::SegOrder>(F.lds, 1024, 1024, 1024, S, E);
        for (int tile = F.vcu; tile < 256; tile += F.G) {
            const int rt = tile >> 4, ctile = tile & 15, row = MP + rt * 64 + (F.tid >> 3), col = ctile * 64 + (F.tid & 7) * 8;
            float v[8];
            sgemm_tile(F, (const bf16_t*)(ws + WS_U) + (size_t)(MP + rt * 64) * 1024, 1024, (const bf16_t*)(ws + WS_WOUT) + (size_t)(ctile * 64) * 1024, 1024, 1024, v);
            const float* xr = args.in[1] + (size_t)(row - MP) * 1024 + col; const f32x4 x0 = *(const f32x4*)xr, x1 = *(const f32x4*)(xr + 4);
            const f32x4 g0 = *(const f32x4*)(args.in[22] + col), g1v = *(const f32x4*)(args.in[22] + col + 4);
            const f32x4 a = (f32x4){x0[0] * ALPHA + v[0], x0[1] * ALPHA + v[1], x0[2] * ALPHA + v[2], x0[3] * ALPHA + v[3]}, b = (f32x4){x1[0] * ALPHA + v[4], x1[1] * ALPHA + v[5], x1[2] * ALPHA + v[6], x1[3] * ALPHA + v[7]};
            float* op = (float*)(ws + WS_HF) + (size_t)row * 1024 + col;
            *(f32x4*)op = a; *(f32x4*)(op + 4) = b;
            const f32x4 ga = a * g0, gb = b * g1v;
            *(u32x4*)((bf16_t*)(ws + WS_HB) + (size_t)row * 1024 + col) = (u32x4){pk2(ga[0], ga[1]), pk2(ga[2], ga[3]), pk2(gb[0], gb[1]), pk2(gb[2], gb[3])};
            float s1 = ((a[0] + a[1]) + (a[2] + a[3])) + ((b[0] + b[1]) + (b[2] + b[3]));
            float s2 = ((a[0] * a[0] + a[1] * a[1]) + (a[2] * a[2] + a[3] * a[3])) + ((b[0] * b[0] + b[1] * b[1]) + (b[2] * b[2] + b[3] * b[3]));
            s1 += __shfl_xor(s1, 1); s1 += __shfl_xor(s1, 2); s1 += __shfl_xor(s1, 4); s2 += __shfl_xor(s2, 1); s2 += __shfl_xor(s2, 2); s2 += __shfl_xor(s2, 4);
            if ((F.tid & 7) == 0) { float* stp = (float*)(ws + WS_ST) + 2 * (size_t)row; atomicAdd(stp, s1); atomicAdd(stp + 1, s2); }
        }
        if (BOTH(6)) GRID_BAR();
    }
    if (IN(8)) for (int rep = 0; rep < NREP(8); ++rep) {
        unsigned char* ws = args.ws;
        pg8::SegOrder S; S.nseg = 1; S.G = F.G; S.c = (int)blockIdx.x; S.dup = 1;
        S.s[0] = pg8::Seg{(const char*)(ws + WS_HB), (const char*)(ws + WS_WUP), M / 256, 16, 0, (M / 256) * 16, (size_t)256 * 1024 * 2, (size_t)256 * 1024 * 2}; S.total = S.s[0].count;
        EpiRelu2 E{(bf16_t*)(ws + WS_A1), (const float*)(ws + WS_ST), (const float*)(ws + WS_GW)};
        pg8::gemm_phase<EpiRelu2, pg8::SegOrder>(F.lds, 1024, 1024, 1024, S, E);
        if (BOTH(8)) GRID_BAR();
    }
    if (IN(9)) for (int rep = 0; rep < NREP(9); ++rep) {
        unsigned char* ws = args.ws;
        pg8::SegOrder S; S.nseg = 1; S.G = F.G; S.c = (int)blockIdx.x; S.dup = 1;
        S.s[0] = pg8::Seg{(const char*)(ws + WS_A1), (const char*)(ws + WS_WDOWN), MP / 256, 4, 0, (MP / 256) * 4, (size_t)256 * 4096 * 2, (size_t)256 * 4096 * 2}; S.total = S.s[0].count;
        EpiV2 E{(const float*)(ws + WS_HF), (const float*)(ws + WS_ST), args.in[22], args.in[23], (float*)(ws + WS_V2)};
        pg8::gemm_phase<EpiV2, pg8::SegOrder>(F.lds, 4096, 4096, 4096, S, E);
        for (int tile = F.vcu; tile < 256; tile += F.G) {
            const int rt = tile >> 4, ctile = tile & 15, row = MP + rt * 64 + (F.tid >> 3), col = ctile * 64 + (F.tid & 7) * 8;
            float v[8];
            sgemm_tile(F, (const bf16_t*)(ws + WS_A1) + (size_t)(MP + rt * 64) * 4096, 4096, (const bf16_t*)(ws + WS_WDOWN) + (size_t)(ctile * 64) * 4096, 4096, 4096, v);
            const float* xr = (const float*)(ws + WS_HF) + (size_t)row * 1024 + col; const f32x4 x0 = *(const f32x4*)xr, x1 = *(const f32x4*)(xr + 4);
            const f32x2 ss = *(const f32x2*)((const float*)(ws + WS_ST) + 2 * (size_t)row); const float mu = ss.x * (1.f / 1024.f), rs = 1.0f / sqrtf(ss.y * (1.f / 1024.f) - mu * mu + LN_EPS);
            const f32x4 g0 = *(const f32x4*)(args.in[22] + col), g1v = *(const f32x4*)(args.in[22] + col + 4), b0 = *(const f32x4*)(args.in[23] + col), b1v = *(const f32x4*)(args.in[23] + col + 4);
            const f32x4 h0 = (x0 - mu) * rs * g0 + b0, h1 = (x1 - mu) * rs * g1v + b1v;
            float* op = (float*)(ws + WS_V2) + (size_t)row * 1024 + col;
            *(f32x4*)op = (f32x4){h0[0] * ALPHA + v[0], h0[1] * ALPHA + v[1], h0[2] * ALPHA + v[2], h0[3] * ALPHA + v[3]};
            *(f32x4*)(op + 4) = (f32x4){h1[0] * ALPHA + v[4], h1[1] * ALPHA + v[5], h1[2] * ALPHA + v[6], h1[3] * ALPHA + v[7]};
        }
        if (BOTH(9)) GRID_BAR();
    }
    if (IN(10)) { ln_rows<true>(F, (const float*)(args.ws + WS_V2), args.in[26], args.in[27], nullptr, nullptr); }
#undef IN
#undef BOTH
}

extern "C" void kernel_launch(void* const* d_in, const int* in_sizes, int n_in, void* d_out, int out_size, void* d_ws, size_t ws_size, hipStream_t stream) {
    static int grid = 0;
    if (grid == 0) {
        int dev = 0, cus = 0;
        if (hipGetDevice(&dev) != hipSuccess || hipDeviceGetAttribute(&cus, hipDeviceAttributeMultiprocessorCount, dev) != hipSuccess) { fprintf(stderr, "kernel_launch: device query failed\n"); grid = -1; return; }
        if (hipFuncSetAttribute((const void*)fwd_kernel, hipFuncAttributeMaxDynamicSharedMemorySize, LDS_BYTES) != hipSuccess) { fprintf(stderr, "kernel_launch: hipFuncSetAttribute failed\n"); grid = -1; return; }
        int per_cu = 0;
        (void)hipOccupancyMaxActiveBlocksPerMultiprocessor(&per_cu, (const void*)fwd_kernel, NTHREADS, LDS_BYTES);
        (void)hipGetLastError();
        if (ws_size < WS_END) { fprintf(stderr, "kernel_launch: workspace too small (%zu < %zu)\n", ws_size, (size_t)WS_END); grid = -1; return; }
        grid = cus;
    }
    if (grid < 0) return;
    (void)hipMemsetAsync((char*)d_ws + WS_CTL, 0, CTL_ZERO_BYTES, stream);
    Args a{};
    for (int i = 0; i < 28; ++i) a.in[i] = (const float*)d_in[i];
    a.out = (float*)d_out; a.ws = (unsigned char*)d_ws;
#if MK_PER_PHASE
    for (int p = 0; p < N_PHASES; ++p) { a.ph_lo = p; a.ph_hi = p + 1; hipLaunchKernelGGL(fwd_kernel, dim3(grid), dim3(NTHREADS), LDS_BYTES, stream, a); }
#else
    a.ph_lo = 0; a.ph_hi = N_PHASES; hipLaunchKernelGGL(fwd_kernel, dim3(grid), dim3(NTHREADS), LDS_BYTES, stream, a);
#endif
}
```

```cpp
#include <hip/hip_runtime.h>
#include <cstdio>
#include <cstdint>

#ifndef MK_PER_PHASE
#define MK_PER_PHASE 0
#endif

#ifndef DIAG_REP
#define DIAG_REP 0
#endif
#ifndef DIAG_DUP_G1
#define DIAG_DUP_G1 1
#define DIAG_DUP_G2 1
#define DIAG_DUP_SSD 1
#define DIAG_DUP_ATT 0
#define DIAG_SMODE 0
#define DIAG_PMODE 0
#endif
#define NREP(k) (((DIAG_REP >> (k)) & 1) ? 2 : 1)
#define LAS __attribute__((address_space(3)))
#define GAS __attribute__((address_space(1)))
typedef unsigned short bf16_t;
typedef short bf16x8 __attribute__((ext_vector_type(8)));
typedef float f32x4 __attribute__((ext_vector_type(4)));
typedef float f32x2 __attribute__((ext_vector_type(2)));
typedef unsigned u32x4 __attribute__((ext_vector_type(4)));
typedef unsigned u32x2 __attribute__((ext_vector_type(2)));

constexpr int D_MODEL = 1024, BATCH = 8, SEQ = 2048, DEC_BATCH = 32, DEC_SEQ = 32, PAST = 4096;
constexpr int MP = BATCH * SEQ, MS = DEC_BATCH * DEC_SEQ, M = MP + MS;
constexpr int D_INNER = 2048, NHEADS = 32, HDIM = 64, NGROUPS = 8, NSTATE = 128, CONV_DIM = 4096;
constexpr int MLA_H = 16, QK_NOPE = 128, QK_ROPE = 64, V_HEAD = 128, Q_RANK = 512, KV_RANK = 512, QHD = 192;
constexpr int D_FF = 4096, IN_COLS = 9312, NPROJ = 9472;
constexpr float RMS_EPS = 1e-6f, LN_EPS = 1e-5f;
constexpr float ALPHA = 1.189207115002721f;
constexpr int SMALL_LD = 1280;

constexpr size_t O_YP = 0, O_YS = 16777216, O_CKVP = 17825792, O_KPEP = 26214400, O_SSMP = 27262976, O_CONVP = 29360128,
                 O_CKVS = 29458432, O_KPES = 29982720, O_SSMS = 30048256, O_CONVS = 38436864;

constexpr size_t MiB = 1u << 20;
constexpr size_t WS_CTL = 0, CTL_ZERO_BYTES = 1 * MiB;
constexpr size_t WS_ROPE = 1 * MiB;
constexpr size_t WS_WIN = 2 * MiB, WS_WQ = 21 * MiB, WS_WUK = 24 * MiB, WS_WUV = 26 * MiB, WS_BQL = 28 * MiB, WS_WUKB = 32 * MiB,
                 WS_WQL = 35 * MiB, WS_WSSM = 43 * MiB, WS_WMLA = 47 * MiB, WS_WOUT = 51 * MiB, WS_WUP = 53 * MiB, WS_WDOWN = 61 * MiB;
constexpr size_t WS_XBC = 72 * MiB;
constexpr size_t WS_Z = 208 * MiB;
constexpr size_t WS_G = 276 * MiB;
constexpr size_t WS_SMALL = 344 * MiB;
constexpr size_t WS_KN = 344 * MiB, WS_V = 408 * MiB;
constexpr size_t WS_XB = 472 * MiB;
constexpr size_t WS_QAN = 472 * MiB, WS_CKVN = 489 * MiB;
constexpr size_t WS_Q = 506 * MiB;
constexpr size_t WS_U = 506 * MiB, WS_HB = 540 * MiB;
constexpr size_t WS_QLAT = 608 * MiB;
constexpr size_t WS_YZ = 624 * MiB;
constexpr size_t WS_O = 692 * MiB;
constexpr size_t WS_KPER = 760 * MiB, WS_DT = 763 * MiB, WS_SSQ = 766 * MiB;
constexpr size_t WS_CACHE = 769 * MiB;
constexpr int KVLEN = PAST + DEC_SEQ;
constexpr size_t WS_XACT = 692 * MiB;
constexpr size_t WS_BCACT = 916 * MiB;
constexpr size_t WS_GWP = 984 * MiB;
constexpr size_t WS_GW = 985 * MiB;
constexpr size_t WS_ST = 986 * MiB;
constexpr size_t WS_END = 987 * MiB;
constexpr size_t WS_A1 = WS_XBC, WS_T1 = WS_Z, WS_V2 = WS_Z, WS_HF = WS_G;

constexpr int CW_BAR = 4096;
constexpr int CW_QUEUE = 16384;

constexpr int LDS_BYTES = 147456;
constexpr int LDSCTL_OFF = LDS_BYTES - 512, MISC_OFF = LDSCTL_OFF + 320;
constexpr int NWAVES = 8, NTHREADS = 512;

#define LDS_WAIT() asm volatile("s_waitcnt lgkmcnt(0)" ::: "memory")
#define VM_WAIT() asm volatile("s_waitcnt vmcnt(0)" ::: "memory")
__device__ __forceinline__ unsigned f2bf(float f) { unsigned u = __builtin_bit_cast(unsigned, f); return (u + 0x7fffu + ((u >> 16) & 1u)) >> 16; }
__device__ __forceinline__ unsigned pk2(float lo, float hi) { return f2bf(lo) | (f2bf(hi) << 16); }
__device__ __forceinline__ float bf2f(unsigned short b) { return __builtin_bit_cast(float, (unsigned)b << 16); }
__device__ __forceinline__ float bflo(unsigned w) { return __builtin_bit_cast(float, w << 16); }
__device__ __forceinline__ float bfhi(unsigned w) { return __builtin_bit_cast(float, w & 0xffff0000u); }
__device__ __forceinline__ float wave_sum(float v) {
#pragma unroll
    for (int o = 1; o < 64; o <<= 1) v += __shfl_xor(v, o);
    return v;
}
__device__ __forceinline__ float sigmoidf_(float x) { return __builtin_amdgcn_rcpf(1.f + __builtin_amdgcn_exp2f(-1.4426950408889634f * x)); }
__device__ __forceinline__ float siluf_(float x) { return x * __builtin_amdgcn_rcpf(1.f + __builtin_amdgcn_exp2f(-1.4426950408889634f * x)); }

namespace pg8 {
constexpr int BM = 256, BK = 64, HALF = 128, HTB = HALF * BK * 2, STAGE_BYTES = 8 * HTB;
__host__ __device__ __forceinline__ int lds_byte(int r, int c) { const int st = (r >> 4) * 2 + (c >> 5), rr = r & 15, cc = c & 31, ob = rr * 64 + cc * 2; return st * 1024 + (ob ^ (((ob >> 9) & 1) << 5)); }
__host__ __device__ __forceinline__ void stage_rc(int b, int& R, int& C) { const int st = b / 1024, sb = b % 1024, swz = sb ^ (((sb >> 9) & 1) << 5); R = (st >> 1) * 16 + swz / 64; C = (st & 1) * 32 + (swz % 64) / 2; }
__host__ __device__ __forceinline__ int perm32(int rho) { const int n = rho >> 4, i = rho & 15; return 8 * (i >> 2) + 4 * n + (i & 3); }

struct Unit { const char* a; const char* b; int pm, pn, seg; };

__device__ __forceinline__ unsigned cvt_pk_bf16(float lo, float hi) { unsigned r; asm volatile("v_cvt_pk_bf16_f32 %0, %1, %2" : "=v"(r) : "v"(lo), "v"(hi)); return r; }

template <class Epi, class Sched>
__device__ __forceinline__ void gemm_phase(LAS unsigned char* lds, const int K, const int lda, const int ldb, const Sched& S, const Epi& E) {
    const int tid = threadIdx.x, wid = __builtin_amdgcn_readfirstlane(tid >> 6), lane = tid & 63, wr = wid >> 2, wc = wid & 3, fr = lane & 15, fq = lane >> 4;
    const int nt = K / BK;
    unsigned voffA[2], voffB[2];
#pragma unroll
    for (int i = 0; i < 2; ++i) { int R, C; stage_rc(tid * 16 + i * 8192, R, C); const int Rb = Epi::PERM ? ((R & ~31) + perm32(R & 31)) : R;
        voffA[i] = (unsigned)(R * lda + C) * 2u; voffB[i] = (unsigned)(Rb * ldb + C) * 2u; }
    const size_t kstep = (size_t)(BK * 2);
    const size_t hstepA = (size_t)HALF * lda * 2, hstepB = (size_t)HALF * ldb * 2;
    const unsigned ldsw = (unsigned)wid * 1024u;
    const int aoff = lds_byte(wr * 64 + fr, fq * 8), boff = lds_byte(wc * 32 + fr, fq * 8);
#define PG8_SA(b, h) (((b) * 2 + (h)) * HTB)
#define PG8_SB(b, h) ((4 + (b) * 2 + (h)) * HTB)
#define PG8_STAGE(bufoff, gbase, voff) do { _Pragma("unroll") for (int _i = 0; _i < 2; ++_i) \
        __builtin_amdgcn_global_load_lds((const unsigned*)((const char*)(gbase) + (voff)[_i]), (LAS unsigned*)(lds + (bufoff) + ldsw + _i * 8192), 16, 0, 0); } while (0)
#define PG8_LDA(dst, b, h) do { _Pragma("unroll") for (int m = 0; m < 4; ++m) _Pragma("unroll") for (int k = 0; k < 2; ++k) dst[m][k] = *(const LAS bf16x8*)(lds + PG8_SA(b, h) + aoff + m * 2048 + k * 1024); } while (0)
#define PG8_LDB(dst, b, h) do { _Pragma("unroll") for (int n = 0; n < 2; ++n) _Pragma("unroll") for (int k = 0; k < 2; ++k) dst[n][k] = *(const LAS bf16x8*)(lds + PG8_SB(b, h) + boff + n * 2048 + k * 1024); } while (0)
#define PG8_MMA(ai, bj, At, Bt) do { __builtin_amdgcn_s_setprio(1); _Pragma("unroll") for (int m = 0; m < 4; ++m) _Pragma("unroll") for (int n = 0; n < 2; ++n) _Pragma("unroll") for (int k = 0; k < 2; ++k) \
        acc[ai][bj][m][n] = __builtin_amdgcn_mfma_f32_16x16x32_bf16(Bt[n][k], At[m][k], acc[ai][bj][m][n], 0, 0, 0); __builtin_amdgcn_s_setprio(0); } while (0)
#define PG8_WAIT_V(n) asm volatile("s_waitcnt vmcnt(" #n ")" ::: "memory")
#define PG8_WAIT_L(n) asm volatile("s_waitcnt lgkmcnt(" #n ")" ::: "memory")
#define PG8_BAR __builtin_amdgcn_s_barrier()
#define PG8_SCHED __builtin_amdgcn_sched_barrier(0)
    Unit cur, nxt; int ui = 0;
    if (!S.next(0, cur)) return;
    f32x4 acc[2][2][4][2];
#pragma unroll
    for (int a = 0; a < 2; ++a)
#pragma unroll
        for (int b = 0; b < 2; ++b)
#pragma unroll
            for (int m = 0; m < 4; ++m)
#pragma unroll
                for (int n = 0; n < 2; ++n) acc[a][b][m][n] = (f32x4){0.f, 0.f, 0.f, 0.f};
    bf16x8 At[4][2], B0[2][2], B1[2][2];
    const char* cA = cur.a; const char* cB = cur.b;
    PG8_STAGE(PG8_SB(0, 0), cB, voffB); PG8_STAGE(PG8_SB(0, 1), cB + hstepB, voffB); PG8_STAGE(PG8_SA(0, 0), cA, voffA); PG8_STAGE(PG8_SA(0, 1), cA + hstepA, voffA);
    if (wr == 1) PG8_BAR;
    PG8_WAIT_V(2); PG8_BAR;
    PG8_STAGE(PG8_SB(1, 0), cB + kstep, voffB); PG8_STAGE(PG8_SA(1, 0), cA + kstep, voffA); PG8_STAGE(PG8_SB(1, 1), cB + hstepB + kstep, voffB);
    PG8_WAIT_V(6); PG8_BAR;
    for (;;) {
        const bool has_next = S.next(ui + 1, nxt);
        const char* nA = has_next ? nxt.a : cA; const char* nB = has_next ? nxt.b : cB;
#pragma unroll 1
        for (int t = 0; t < nt; t += 2) {
            const bool last = (t == nt - 2);
            const char* a1 = cA + (size_t)(t + 1) * kstep;
            const char* a2 = last ? nA : cA + (size_t)(t + 2) * kstep; const char* b2 = last ? nB : cB + (size_t)(t + 2) * kstep;
            const char* a3 = a2 + kstep; const char* b3 = b2 + kstep;
            PG8_LDB(B0, 0, 0); PG8_LDB(B1, 0, 1); PG8_SCHED; PG8_LDA(At, 0, 0); PG8_STAGE(PG8_SA(1, 1), a1 + hstepA, voffA);
            PG8_WAIT_V(8); PG8_WAIT_L(0); PG8_BAR; PG8_MMA(0, 0, At, B0); PG8_MMA(0, 1, At, B1); PG8_BAR; PG8_SCHED;
            PG8_LDA(At, 0, 1); PG8_STAGE(PG8_SB(0, 0), b2, voffB); PG8_STAGE(PG8_SB(0, 1), b2 + hstepB, voffB); PG8_STAGE(PG8_SA(0, 0), a2, voffA);
            PG8_WAIT_V(8); PG8_WAIT_L(0); PG8_BAR; PG8_MMA(1, 0, At, B0); PG8_MMA(1, 1, At, B1); PG8_BAR; PG8_SCHED;
            PG8_LDB(B0, 1, 0); PG8_LDB(B1, 1, 1); PG8_SCHED; PG8_LDA(At, 1, 0); PG8_STAGE(PG8_SA(0, 1), a2 + hstepA, voffA);
            PG8_WAIT_V(8); PG8_WAIT_L(0); PG8_BAR; PG8_MMA(0, 0, At, B0); PG8_MMA(0, 1, At, B1); PG8_BAR; PG8_SCHED;
            PG8_LDA(At, 1, 1); PG8_STAGE(PG8_SB(1, 0), b3, voffB); PG8_STAGE(PG8_SB(1, 1), b3 + hstepB, voffB); PG8_STAGE(PG8_SA(1, 0), a3, voffA);
            PG8_WAIT_V(8); PG8_WAIT_L(0); PG8_BAR; PG8_MMA(1, 0, At, B0); PG8_MMA(1, 1, At, B1); PG8_BAR; PG8_SCHED;
        }
        if (wr == 0) PG8_BAR;
        E(acc, cur, wr, wc, fr, fq);
        if (!has_next) break;
#pragma unroll
        for (int a = 0; a < 2; ++a)
#pragma unroll
            for (int b = 0; b < 2; ++b)
#pragma unroll
                for (int m = 0; m < 4; ++m)
#pragma unroll
                    for (int n = 0; n < 2; ++n) acc[a][b][m][n] = (f32x4){0.f, 0.f, 0.f, 0.f};
        cur = nxt; cA = nA; cB = nB; ++ui;
        if (wr == 1) PG8_BAR;
    }
    PG8_WAIT_V(0);
    PG8_BAR;
#undef PG8_SA
#undef PG8_SB
#undef PG8_STAGE
#undef PG8_LDA
#undef PG8_LDB
#undef PG8_MMA
#undef PG8_WAIT_V
#undef PG8_WAIT_L
#undef PG8_BAR
#undef PG8_SCHED
}

struct Seg { const char* A; const char* B; int nM, nN, start, count; size_t a_tile, b_tile; };
struct SegOrder {
    Seg s[4]; int nseg, total, G, c, dup;
    __device__ __forceinline__ bool next(int i, Unit& u) const {
        int L = i * G + c; if (L >= total * dup) return false; if (L >= total) L -= total;
        int k = 0; const char* gA = s[0].A; const char* gB = s[0].B; int gnM = s[0].nM, gnN = s[0].nN, gstart = 0, nwg = s[0].count; size_t gat = s[0].a_tile, gbt = s[0].b_tile;
#pragma unroll
        for (int j = 1; j < 4; ++j) if (j < nseg && L >= s[j].start) { k = j; gA = s[j].A; gB = s[j].B; gnM = s[j].nM; gnN = s[j].nN; gstart = s[j].start; nwg = s[j].count; gat = s[j].a_tile; gbt = s[j].b_tile; }
        int wgid = L - gstart;
        { const int q = nwg / 8, r = nwg % 8, xcd = wgid % 8, off = wgid / 8; wgid = (xcd < r ? xcd * (q + 1) : r * (q + 1) + (xcd - r) * q) + off; }
        const int nig = 8 * gnN, gid = wgid / nig, fm = gid * 8, gsz = (gnM - fm) < 8 ? (gnM - fm) : 8;
        u.pm = fm + ((wgid % nig) % gsz); u.pn = (wgid % nig) / gsz; u.seg = k;
        u.a = gA + (size_t)u.pm * gat; u.b = gB + (size_t)u.pn * gbt; return true;
    }
};
struct WqlOrder {
    const char* A; const char* B; int G, c;
    __device__ __forceinline__ bool next(int i, Unit& u) const {
        const int L = i * G + c; if (L >= 64) return false;
        const int h = L >> 2, pm = (L >> 1) & 1, pn = L & 1;
        u.pm = h * 2 + pm; u.pn = pn; u.seg = 1;
        u.a = A + (size_t)pm * 256 * 2048 * 2 + (size_t)h * 128 * 2; u.b = B + (size_t)h * 512 * 256 * 2 + (size_t)pn * 256 * 256 * 2; return true;
    }
};
}

#define XB_TMO      128
#define XB_XCNT(j)  (256  + 64 * (j))
#define XB_XSUB(j)  (1280 + 64 * (j))
#define XB_XGEN(j)  (2304 + 64 * (j))
#define XB_TOP      3328
#define XB_TOPGEN   3392
#define XCD_BAR_WORDS 3456
#define XB_SPIN_CAP (1u << 18)
__device__ __forceinline__ unsigned xb_ld(unsigned* p)              { return __hip_atomic_load(p, __ATOMIC_RELAXED, __HIP_MEMORY_SCOPE_AGENT); }
__device__ __forceinline__ unsigned xb_add(unsigned* p, unsigned v) { return __hip_atomic_fetch_add(p, v, __ATOMIC_RELAXED, __HIP_MEMORY_SCOPE_AGENT); }
__device__ __forceinline__ unsigned xb_xcc_id() { return (unsigned)__builtin_amdgcn_s_getreg((3 << 11) | 20) & 0xFu; }
#define XB_SPIN(cond, bar) do { unsigned _sp = 0; while (cond) { __builtin_amdgcn_s_sleep(1); \
    if ((++_sp & 255u) == 0u) { if (xb_ld(&(bar)[XB_TMO])) break; if (_sp > XB_SPIN_CAP) { atomicAdd(&(bar)[XB_TMO], 1u); break; } } } } while (0)
struct XcdBarrier { unsigned* bar; unsigned x; volatile LAS unsigned* st; };
__device__ __forceinline__ XcdBarrier xcd_barrier_post(unsigned* bar, volatile LAS unsigned* st) {
    XcdBarrier b; b.bar = bar; b.x = xb_xcc_id(); b.st = st;
    if (threadIdx.x == 0) (void)xb_add(&bar[XB_XCNT(b.x)], 1u);
    return b;
}
__device__ __forceinline__ void xcd_barrier_complete(unsigned* bar, unsigned x, unsigned& nloc, unsigned& nx) {
    const unsigned G = gridDim.x * gridDim.y * gridDim.z;
    unsigned sum, cnt, mine, sp = 0u;
    for (;;) {
        sum = 0u; cnt = 0u; mine = 0u;
#pragma unroll
        for (unsigned j = 0; j < 16; ++j) { const unsigned c = xb_ld(&bar[XB_XCNT(j)]); sum += c; cnt += (c > 0u) ? 1u : 0u; mine = (j == x) ? c : mine; }
        if (sum == G) break;
        __builtin_amdgcn_s_sleep(1);
        if ((++sp & 255u) == 0u) { if (xb_ld(&bar[XB_TMO])) break; if (sp > XB_SPIN_CAP) { atomicAdd(&bar[XB_TMO], 1u); break; } }
    }
    nloc = mine > 0u ? mine : 1u; nx = cnt > 0u ? cnt : 1u;
}
__device__ __forceinline__ void xcd_barrier(const XcdBarrier& b) {
    asm volatile("s_waitcnt vmcnt(0)" ::: "memory");
    __syncthreads();
    if (threadIdx.x == 0) {
        unsigned* bar = b.bar;
        __builtin_amdgcn_s_waitcnt(0);
        unsigned nloc = b.st[0], nx = b.st[1];
        if (nloc == 0u) { xcd_barrier_complete(bar, b.x, nloc, nx); b.st[0] = nloc; b.st[1] = nx; }
        const unsigned old = xb_add(&bar[XB_XSUB(b.x)], 1u);
        const unsigned gen = old / nloc;
        if (old + 1u == (gen + 1u) * nloc) {
            __builtin_amdgcn_fence(__ATOMIC_RELEASE, "agent");
            asm volatile("s_waitcnt vmcnt(0)" ::: "memory");
            const unsigned og = xb_add(&bar[XB_TOP], 1u);
            const unsigned tg = og / nx;
            if (og + 1u == (tg + 1u) * nx) xb_add(&bar[XB_TOPGEN], 1u);
            else XB_SPIN(xb_ld(&bar[XB_TOPGEN]) == tg, bar);
            __builtin_amdgcn_fence(__ATOMIC_ACQUIRE, "agent");
            xb_add(&bar[XB_XGEN(b.x)], 1u);
            asm volatile("s_waitcnt vmcnt(0)" ::: "memory");
        } else {
            XB_SPIN(xb_ld(&bar[XB_XGEN(b.x)]) == gen, bar);
            __builtin_amdgcn_fence(__ATOMIC_ACQUIRE, "agent");
            asm volatile("s_waitcnt vmcnt(0)" ::: "memory");
        }
    }
    __syncthreads();
}

struct Args { const float* in[28]; float* out; unsigned char* ws; int ph_lo, ph_hi; };
struct Frame {
    LAS unsigned char* lds;
    int tid, lane, wave, vcu, G;
    unsigned char* ws; float* out;
};

__device__ __forceinline__ void p0_transpose_item(const float* W, int K, int N, bf16_t* WT, int ldt, int k0, int n0, int drow0, LAS float* scr, int lane, const float* kscale = nullptr) {
    float tv[32];
#pragma unroll
    for (int i = 0; i < 32; ++i) { const int kk = 2 * i + (lane >> 5); tv[i] = __builtin_nontemporal_load(W + (size_t)(k0 + kk) * N + n0 + (lane & 31)); }
#pragma unroll
    for (int i = 0; i < 32; ++i) { const int kk = 2 * i + (lane >> 5); scr[kk * 33 + (lane & 31)] = kscale ? tv[i] * kscale[k0 + kk] : tv[i]; }
    LDS_WAIT(); asm volatile("" ::: "memory");
    const int c = lane & 7;
#pragma unroll
    for (int j = 0; j < 4; ++j) { const int n = (lane >> 3) + 8 * j; const LAS float* s = scr + (8 * c) * 33 + n;
        u32x4 o; o.x = pk2(s[0 * 33], s[1 * 33]); o.y = pk2(s[2 * 33], s[3 * 33]); o.z = pk2(s[4 * 33], s[5 * 33]); o.w = pk2(s[6 * 33], s[7 * 33]);
        *(u32x4*)(WT + (size_t)(drow0 + n) * ldt + k0 + 8 * c) = o; }
    LDS_WAIT(); asm volatile("" ::: "memory");
}
__device__ __forceinline__ int win_dst_col(int n0) {
    if (n0 < 8192) return n0;
    if (n0 < 8224) return 9280 + (n0 - 8192);
    if (n0 < 8736) return 8192 + (n0 - 8224);
    if (n0 < 9248) return 8704 + (n0 - 8736);
    return 9216 + (n0 - 9248);
}
struct TItem { const float* W; int K, N; bf16_t* WT; int kind; };

__device__ __forceinline__ void p0_prologue(Frame& F, const Args& args) {
    LAS float* scr = (LAS float*)(F.lds + F.wave * 16384);
    const int gw = F.vcu * NWAVES + F.wave, NGW = F.G * NWAVES, lane = F.lane;
    unsigned char* ws = F.ws;
    {
        const float* Ws[9] = {args.in[6], args.in[16], args.in[18], args.in[19], args.in[14], args.in[20], args.in[21], args.in[24], args.in[25]};
        const int Ks[9] = {1024, 512, 512, 512, 2048, 2048, 1024, 1024, 4096};
        const int Ns[9] = {IN_COLS, 3072, 2048, 2048, 1024, 1024, 1024, 4096, 1024};
        const size_t Os[9] = {WS_WIN, WS_WQ, WS_WUK, WS_WUV, WS_WSSM, WS_WMLA, WS_WOUT, WS_WUP, WS_WDOWN};
        int base = 0;
#pragma unroll
        for (int w = 0; w < 9; ++w) {
            const int nblk = Ns[w] / 32, nitems = (Ks[w] / 64) * nblk;
            int first = gw - (base % NGW); if (first < 0) first += NGW;
            for (int it = first; it < nitems; it += NGW) {
                const int kb = it / nblk, nb = it % nblk, n0 = 32 * nb;
                const int drow0 = (w == 0) ? win_dst_col(n0) : n0;
                p0_transpose_item(Ws[w], Ks[w], Ns[w], (bf16_t*)(ws + Os[w]), Ks[w], 64 * kb, n0, drow0, scr, lane, (w == 7) ? args.in[22] : nullptr);
            }
            base += nitems;
        }
    }
    const int gt = F.vcu * NTHREADS + F.tid, NGT = F.G * NTHREADS;
    for (int i = gt; i < 20480; i += NGT) ((u32x4*)(ws + WS_WIN + (size_t)9312 * 1024 * 2))[i] = (u32x4){0u, 0u, 0u, 0u};
    {
        const f32x4* xp = (const f32x4*)args.in[0]; const f32x4* xs = (const f32x4*)args.in[1]; u32x4* xb = (u32x4*)(ws + WS_XB);
        const int n8p = MP * D_MODEL / 8, n8 = M * D_MODEL / 8;
        for (int i0 = gt; i0 < n8; i0 += 4 * NGT) {
            f32x4 a[4], b[4];
#pragma unroll
            for (int u = 0; u < 4; ++u) { const int i = i0 + u * NGT; const int ii = (i < n8) ? i : 0; const f32x4* src = (ii < n8p) ? xp + 2 * (size_t)ii : xs + 2 * (size_t)(ii - n8p); a[u] = __builtin_nontemporal_load(src); b[u] = __builtin_nontemporal_load(src + 1); }
#pragma unroll
            for (int u = 0; u < 4; ++u) { const int i = i0 + u * NGT; if (i < n8) xb[i] = (u32x4){pk2(a[u].x, a[u].y), pk2(a[u].z, a[u].w), pk2(b[u].x, b[u].y), pk2(b[u].z, b[u].w)}; }
        }
    }
    {
        const f32x4* src = (const f32x4*)args.in[18]; u32x4* dst = (u32x4*)(ws + WS_WUKB);
        for (int i = gt; i < 512 * 2048 / 8; i += NGT) { const f32x4 a = src[2 * (size_t)i], b = src[2 * (size_t)i + 1]; dst[i] = (u32x4){pk2(a.x, a.y), pk2(a.z, a.w), pk2(b.x, b.y), pk2(b.z, b.w)}; }
        for (int i = gt; i < 64; i += NGT) dst[512 * 2048 / 8 + i] = (u32x4){0u, 0u, 0u, 0u};
    }
    {
        const float* wq = args.in[16]; u32x4* dst = (u32x4*)(ws + WS_BQL);
        for (int i = gt; i < 16 * 512 * 32; i += NGT) {
            const int d8 = i & 31, r = (i >> 5) & 511, h = i >> 14;
            u32x4 o = (u32x4){0u, 0u, 0u, 0u};
            if (d8 < 16) { const f32x4* s = (const f32x4*)(wq + (size_t)r * 3072 + h * 192 + d8 * 8); const f32x4 a = s[0], b = s[1]; o = (u32x4){pk2(a.x, a.y), pk2(a.z, a.w), pk2(b.x, b.y), pk2(b.z, b.w)}; }
            dst[i] = o;
        }
    }
    {
        float* ct = (float*)(ws + WS_ROPE); float* st = ct + 2080 * 32;
        for (int i = gt; i < 2080 * 32; i += NGT) {
            const int p = i >> 5, j = i & 31; const float pos = (float)(p < 2048 ? p : 4096 + (p - 2048));
            const float inv = powf(10000.0f, -(float)(2 * j) / 64.0f); const float ang = pos * inv;
            ct[i] = cosf(ang); st[i] = sinf(ang);
        }
    }
    {
        const float* wup = args.in[24]; const float* g1 = args.in[22]; const float* b1 = args.in[23]; float* part = (float*)(ws + WS_GWP);
        for (int i = gt; i < 32 * 4096; i += NGT) { const int n = i & 4095, ks = i >> 12; float sg = 0.f, sb = 0.f;
#pragma unroll 8
            for (int k = 0; k < 32; ++k) { const float wv_ = wup[(size_t)(ks * 32 + k) * 4096 + n]; sg += bf2f((unsigned short)f2bf(g1[ks * 32 + k] * wv_)); sb += b1[ks * 32 + k] * wv_; }
            part[(ks * 2) * 4096 + n] = sg; part[(ks * 2 + 1) * 4096 + n] = sb; }
    }
}

struct EpiStore {
    static constexpr bool PERM = true;
    bf16_t *b0, *b1, *b2, *b3; int l0, l1, l2, l3;
    __device__ __forceinline__ void operator()(const f32x4 (&acc)[2][2][4][2], const pg8::Unit& u, int wr, int wc, int fr, int fq) const {
        bf16_t* b = (u.seg == 0) ? b0 : (u.seg == 1) ? b1 : (u.seg == 2) ? b2 : b3;
        const int ld = (u.seg == 0) ? l0 : (u.seg == 1) ? l1 : (u.seg == 2) ? l2 : l3;
        bf16_t* p = b + (size_t)(u.pm * 256 + wr * 64 + fr) * ld + u.pn * 256 + wc * 32 + 8 * fq;
#pragma unroll
        for (int ai = 0; ai < 2; ++ai)
#pragma unroll
            for (int m = 0; m < 4; ++m) { bf16_t* rowp = p + (size_t)(ai * 128 + m * 16) * ld;
#pragma unroll
                for (int bj = 0; bj < 2; ++bj) { const f32x4 v0 = acc[ai][bj][m][0], v1 = acc[ai][bj][m][1];
                    *(u32x4*)(rowp + bj * 128) = (u32x4){pg8::cvt_pk_bf16(v0[0], v0[1]), pg8::cvt_pk_bf16(v0[2], v0[3]), pg8::cvt_pk_bf16(v1[0], v1[1]), pg8::cvt_pk_bf16(v1[2], v1[3])}; } }
    }
};

struct EpiProj {
    static constexpr bool PERM = true;
    unsigned char* ws; float* out;
    __device__ __forceinline__ void operator()(const f32x4 (&acc)[2][2][4][2], const pg8::Unit& u, int wr, int wc, int fr, int fq) const {
        const int row0 = u.pm * 256 + wr * 64 + fr, colt = wc * 32 + 8 * fq;
        if (u.pn < 32) {
            bf16_t* base; int ldc, c0;
            if (u.pn < 8) { base = (bf16_t*)(ws + WS_G); ldc = 2048; c0 = u.pn * 256; }
            else if (u.pn < 16) { base = (bf16_t*)(ws + WS_Z); ldc = 2048; c0 = (u.pn - 8) * 256; }
            else { base = (bf16_t*)(ws + WS_XBC); ldc = 4096; c0 = (u.pn - 16) * 256; }
#pragma unroll
            for (int ai = 0; ai < 2; ++ai)
#pragma unroll
                for (int m = 0; m < 4; ++m) { const int row = row0 + ai * 128 + m * 16; bf16_t* rowp = base + (size_t)row * ldc + c0 + colt;
#pragma unroll
                    for (int bj = 0; bj < 2; ++bj) { const f32x4 v0 = acc[ai][bj][m][0], v1 = acc[ai][bj][m][1];
                        *(u32x4*)(rowp + bj * 128) = (u32x4){pg8::cvt_pk_bf16(v0[0], v0[1]), pg8::cvt_pk_bf16(v0[2], v0[3]), pg8::cvt_pk_bf16(v1[0], v1[1]), pg8::cvt_pk_bf16(v1[2], v1[3])}; } }
            if (u.pn >= 16 && ((u.pm & 7) == 7 || u.pm >= MP / 256)) {
#pragma unroll
                for (int ai = 0; ai < 2; ++ai)
#pragma unroll
                    for (int m = 0; m < 4; ++m) { const int row = row0 + ai * 128 + m * 16;
                        long off = -1;
                        if (row < MP) { const int t = row & 2047; if (t >= 2045) off = (long)O_CONVP + ((long)(row >> 11) * 3 + (t - 2045)) * 4096; }
                        else { const int q = (row - MP) & 31; if (q >= 29) off = (long)O_CONVS + ((long)((row - MP) >> 5) * 3 + (q - 29)) * 4096; }
                        if (off >= 0) { float* cp = out + off + c0 + colt;
#pragma unroll
                            for (int bj = 0; bj < 2; ++bj) { *(f32x4*)(cp + bj * 128) = acc[ai][bj][m][0]; *(f32x4*)(cp + bj * 128 + 4) = acc[ai][bj][m][1]; } } }
            }
        } else {
            float* base = (float*)(ws + WS_SMALL); const int c0 = (u.pn - 32) * 256;
#pragma unroll
            for (int ai = 0; ai < 2; ++ai)
#pragma unroll
                for (int m = 0; m < 4; ++m) { float* rowp = base + (size_t)(row0 + ai * 128 + m * 16) * SMALL_LD + c0 + colt;
#pragma unroll
                    for (int bj = 0; bj < 2; ++bj) { *(f32x4*)(rowp + bj * 128) = acc[ai][bj][m][0]; *(f32x4*)(rowp + bj * 128 + 4) = acc[ai][bj][m][1]; } }
        }
    }
};

__device__ __forceinline__ void p1b_rows(Frame& F, const Args& args) {
    const int gw = F.vcu * NWAVES + F.wave, NGW = F.G * NWAVES, lane = F.lane;
    unsigned char* ws = F.ws;
    const float* gq = args.in[15]; const float* gkv = args.in[17]; const float* dtb = args.in[10];
    const float* ct = (const float*)(ws + WS_ROPE); const float* st = ct + 2080 * 32;
    const f32x4 gq0 = *(const f32x4*)(gq + 4 * lane), gq1 = *(const f32x4*)(gq + 256 + 4 * lane);
    const f32x4 gk0 = *(const f32x4*)(gkv + 4 * lane), gk1 = *(const f32x4*)(gkv + 256 + 4 * lane);
    for (int m = gw; m < M; m += NGW) {
        const float* srow = (const float*)(ws + WS_SMALL) + (size_t)m * SMALL_LD;
        const f32x4 q0 = __builtin_nontemporal_load((const f32x4*)(srow + 4 * lane)), q1 = __builtin_nontemporal_load((const f32x4*)(srow + 256 + 4 * lane));
        const f32x4 k0 = __builtin_nontemporal_load((const f32x4*)(srow + 512 + 4 * lane)), k1 = __builtin_nontemporal_load((const f32x4*)(srow + 768 + 4 * lane));
        float sq = (q0.x * q0.x + q0.y * q0.y) + (q0.z * q0.z + q0.w * q0.w) + (q1.x * q1.x + q1.y * q1.y) + (q1.z * q1.z + q1.w * q1.w);
        float sk = (k0.x * k0.x + k0.y * k0.y) + (k0.z * k0.z + k0.w * k0.w) + (k1.x * k1.x + k1.y * k1.y) + (k1.z * k1.z + k1.w * k1.w);
        sq = wave_sum(sq); sk = wave_sum(sk);
        const float rq = 1.0f / sqrtf(sq * (1.0f / 512.0f) + RMS_EPS), rk = 1.0f / sqrtf(sk * (1.0f / 512.0f) + RMS_EPS);
        { bf16_t* o = (bf16_t*)(ws + WS_QAN) + (size_t)m * 512;
          const f32x4 a = q0 * rq * gq0, b = q1 * rq * gq1;
          *(u32x2*)(o + 4 * lane) = (u32x2){pk2(a.x, a.y), pk2(a.z, a.w)}; *(u32x2*)(o + 256 + 4 * lane) = (u32x2){pk2(b.x, b.y), pk2(b.z, b.w)}; }
        { bf16_t* o = (bf16_t*)(ws + WS_CKVN) + (size_t)m * 512;
          const f32x4 a = k0 * rk * gk0, b = k1 * rk * gk1;
          *(u32x2*)(o + 4 * lane) = (u32x2){pk2(a.x, a.y), pk2(a.z, a.w)}; *(u32x2*)(o + 256 + 4 * lane) = (u32x2){pk2(b.x, b.y), pk2(b.z, b.w)};
          float* fo = (m < MP) ? F.out + O_CKVP + (size_t)m * 512 : F.out + O_CKVS + (size_t)(m - MP) * 512;
          __builtin_nontemporal_store(a, (f32x4*)(fo + 4 * lane)); __builtin_nontemporal_store(b, (f32x4*)(fo + 256 + 4 * lane));
          if (m >= MP) { bf16_t* cr = (bf16_t*)(ws + WS_CACHE) + ((size_t)((m - MP) >> 5) * KVLEN + PAST + ((m - MP) & 31)) * 576;
              *(u32x2*)(cr + 4 * lane) = (u32x2){pk2(a.x, a.y), pk2(a.z, a.w)}; *(u32x2*)(cr + 256 + 4 * lane) = (u32x2){pk2(b.x, b.y), pk2(b.z, b.w)}; } }
        const int pidx = (m < MP) ? (m & 2047) : 2048 + ((m - MP) & 31);
        if (lane < 32) {
            const float t1 = srow[1024 + lane], t2 = srow[1056 + lane]; const float c = ct[pidx * 32 + lane], s = st[pidx * 32 + lane];
            const float o1 = t1 * c - t2 * s, o2 = t1 * s + t2 * c;
            float* fo = (m < MP) ? F.out + O_KPEP + (size_t)m * 64 : F.out + O_KPES + (size_t)(m - MP) * 64;
            fo[lane] = o1; fo[32 + lane] = o2;
            bf16_t* o = (bf16_t*)(ws + WS_KPER) + (size_t)m * 64; o[lane] = (bf16_t)f2bf(o1); o[32 + lane] = (bf16_t)f2bf(o2);
            if (m >= MP) { bf16_t* cr = (bf16_t*)(ws + WS_CACHE) + ((size_t)((m - MP) >> 5) * KVLEN + PAST + ((m - MP) & 31)) * 576 + 512; cr[lane] = (bf16_t)f2bf(o1); cr[32 + lane] = (bf16_t)f2bf(o2); }
        } else {
            const int hh = lane - 32; const float x = srow[1088 + hh] + dtb[hh];
            const float sp = (x > 20.f) ? x : log1pf(expf(x));
            ((float*)(ws + WS_DT))[(size_t)m * 32 + hh] = sp;
        }
    }
}


__device__ __forceinline__ void conv_item(Frame& F, const Args& args, int item) {
    int tid_o = F.tid; asm volatile("" : "+v"(tid_o));
    const int tid = tid_o, rb = item >> 3, sl = item & 7, ch = sl * 512 + (tid & 63) * 8, r0 = rb * 64 + (tid >> 6) * 8;
    unsigned char* ws = F.ws; const bf16_t* xbc = (const bf16_t*)(ws + WS_XBC);
    const float* conv_w = args.in[8]; const float* conv_b = args.in[9];
    float wv[4][8], bv[8];
#pragma unroll
    for (int k = 0; k < 4; ++k) { const f32x4 a = *(const f32x4*)(conv_w + k * 4096 + ch), c = *(const f32x4*)(conv_w + k * 4096 + ch + 4);
        wv[k][0] = a[0]; wv[k][1] = a[1]; wv[k][2] = a[2]; wv[k][3] = a[3]; wv[k][4] = c[0]; wv[k][5] = c[1]; wv[k][6] = c[2]; wv[k][7] = c[3]; }
    { const f32x4 a = *(const f32x4*)(conv_b + ch), c = *(const f32x4*)(conv_b + ch + 4); bv[0] = a[0]; bv[1] = a[1]; bv[2] = a[2]; bv[3] = a[3]; bv[4] = c[0]; bv[5] = c[1]; bv[6] = c[2]; bv[7] = c[3]; }
    float h0[8], h1[8], h2[8];
    const bool prompt = r0 < MP; const int t0 = prompt ? (r0 & 2047) : ((r0 - MP) & 31);
    u32x4 hv[3];
    if (t0 == 0) {
        if (prompt) { hv[0] = hv[1] = hv[2] = (u32x4){0u, 0u, 0u, 0u}; }
        else { const float* sc = args.in[5] + (size_t)((r0 - MP) >> 5) * 3 * 4096 + ch;
#pragma unroll
            for (int k = 0; k < 3; ++k) { const f32x4 a = *(const f32x4*)(sc + k * 4096), c = *(const f32x4*)(sc + k * 4096 + 4); hv[k] = (u32x4){pk2(a.x, a.y), pk2(a.z, a.w), pk2(c.x, c.y), pk2(c.z, c.w)}; } }
    } else {
#pragma unroll
        for (int k = 0; k < 3; ++k) hv[k] = *(const u32x4*)(xbc + (size_t)(r0 - 3 + k) * 4096 + ch);
    }
#pragma unroll
    for (int e = 0; e < 4; ++e) { h0[2 * e] = bflo(hv[0][e]); h0[2 * e + 1] = bfhi(hv[0][e]); h1[2 * e] = bflo(hv[1][e]); h1[2 * e + 1] = bfhi(hv[1][e]); h2[2 * e] = bflo(hv[2][e]); h2[2 * e + 1] = bfhi(hv[2][e]); }
    u32x4 rv[8];
#pragma unroll
    for (int i = 0; i < 8; ++i) rv[i] = (i < 5) ? __builtin_nontemporal_load((const u32x4*)(xbc + (size_t)(r0 + i) * 4096 + ch)) : *(const u32x4*)(xbc + (size_t)(r0 + i) * 4096 + ch);
    bf16_t* dst = (ch < 2048) ? (bf16_t*)(ws + WS_XACT) + (size_t)r0 * 2048 + ch : (bf16_t*)(ws + WS_BCACT) + (size_t)r0 * 2048 + (ch - 2048);
#pragma unroll
    for (int i = 0; i < 8; ++i) {
        float x[8], o[8];
#pragma unroll
        for (int e = 0; e < 4; ++e) { x[2 * e] = bflo(rv[i][e]); x[2 * e + 1] = bfhi(rv[i][e]); }
#pragma unroll
        for (int e = 0; e < 8; ++e) { o[e] = siluf_(bv[e] + wv[0][e] * h0[e] + wv[1][e] * h1[e] + wv[2][e] * h2[e] + wv[3][e] * x[e]); h0[e] = h1[e]; h1[e] = h2[e]; h2[e] = x[e]; }
        *(u32x4*)(dst + (size_t)i * 2048) = (u32x4){pk2(o[0], o[1]), pk2(o[2], o[3]), pk2(o[4], o[5]), pk2(o[6], o[7])};
    }
}

namespace ssd {
constexpr int SC = 272, SX = 144;
constexpr int L_CT = 0, L_BN = L_CT + 64 * SC, L_SB = L_BN + 64 * SC, L_XT = L_SB + 64 * SC, L_XS = L_XT + 64 * SX, L_MM = L_XS + 64 * SX, L_YO = L_MM + 64 * SX, L_SCAL = L_YO + 64 * SX, L_END = L_SCAL + 1024;
static_assert(L_END <= LDSCTL_OFF, "ssd LDS map");
typedef short v4i16 __attribute__((ext_vector_type(4)));
__device__ __forceinline__ v4i16 tr16(LAS const unsigned char* p) { return __builtin_amdgcn_ds_read_tr16_b64_v4i16((LAS v4i16*)p); }
}
__device__ __forceinline__ void ssd_item(Frame& F, const Args& args, int item) {
    using namespace ssd;
    LAS unsigned char* lds = F.lds;
    int tid_o = F.tid; asm volatile("" : "+v"(tid_o));
    const int tid = tid_o, lane = tid & 63, w = F.wave, g = lane >> 4, c16 = lane & 15;
    const bool sample = item >= 256;
    const int bb = sample ? (item - 256) >> 5 : item >> 5, h = item & 31, grp = h >> 2;
    const int nchunks = sample ? 1 : 32, nvalid = sample ? 32 : 64;
    const int rowbase = sample ? MP + bb * 32 : bb * 2048;
    unsigned char* ws = F.ws;
    const bf16_t* xact = (const bf16_t*)(ws + WS_XACT); const bf16_t* bcact = (const bf16_t*)(ws + WS_BCACT); const bf16_t* zbuf = (const bf16_t*)(ws + WS_Z); const float* dtbuf = (const float*)(ws + WS_DT);
    const float a_h = -__expf(args.in[11][h]); const float d_h = args.in[12][h];
    const int it = w >> 1, half = w & 1;
    f32x4 st[4];
#pragma unroll
    for (int nt = 0; nt < 4; ++nt) st[nt] = (f32x4){0.f, 0.f, 0.f, 0.f};
    if (sample) {
        const float* s0 = args.in[4] + ((size_t)(bb * 32 + h) * 64) * 128;
#pragma unroll
        for (int nt = 0; nt < 4; ++nt) st[nt] = *(const f32x4*)(s0 + (size_t)(16 * it + c16) * 128 + 16 * (4 * half + nt) + 4 * g);
    }
    __syncthreads();
#pragma unroll
    for (int nt = 0; nt < 4; ++nt) *(LAS u32x2*)(lds + L_SB + (16 * it + c16) * SC + (16 * (4 * half + nt) + 4 * g) * 2) = (u32x2){pk2(st[nt][0], st[nt][1]), pk2(st[nt][2], st[nt][3])};

    struct PF { u32x4 px, pb[2], pc[2]; float pdt; u32x2 pz[2]; };
    PF pfA, pfB;
    const int prow = tid >> 3, ppx = tid & 7, brow = tid >> 4, bpc = tid & 15;
    auto prefetch = [&](PF& P, int c) {
        const size_t r0 = (size_t)(rowbase + c * 64);
        const u32x4 zero4 = (u32x4){0u, 0u, 0u, 0u};
        P.px = (prow < nvalid) ? *(const u32x4*)(xact + (r0 + prow) * 2048 + h * 64 + ppx * 8) : zero4;
#pragma unroll
        for (int q = 0; q < 2; ++q) { const int rr = brow + 32 * q;
            P.pb[q] = (rr < nvalid) ? *(const u32x4*)(bcact + (r0 + rr) * 2048 + grp * 128 + bpc * 8) : zero4;
            P.pc[q] = (rr < nvalid) ? *(const u32x4*)(bcact + (r0 + rr) * 2048 + 1024 + grp * 128 + bpc * 8) : zero4; }
        P.pdt = (lane < nvalid) ? dtbuf[(r0 + lane) * 32 + h] : 0.f;
#pragma unroll
        for (int pt = 0; pt < 2; ++pt) P.pz[pt] = (16 * it + c16 < nvalid) ? *(const u32x2*)(zbuf + (r0 + 16 * it + c16) * 2048 + h * 64 + 16 * (2 * half + pt) + 4 * g) : (u32x2){0u, 0u};
    };
    prefetch(pfA, 0); if (nchunks > 1) prefetch(pfB, 1);
    const float* cache_c = args.in[2]; const float* cache_k = args.in[3]; bf16_t* cache_dst = (bf16_t*)(ws + WS_CACHE);
    constexpr int NPIECES = DEC_BATCH * PAST * 72;
    auto chunk = [&](PF& P, int c) {
        const size_t r0 = (size_t)(rowbase + c * 64);
        f32x4 cva[3], cvc[3]; int cdo[3];
        if (!sample) {
#pragma unroll
            for (int u = 0; u < 3; ++u) { const int i = ((item * 32 + c) * 3 + u) * 512 + tid; const bool ok = i < NPIECES; const int ii = ok ? i : 0;
                const int pc = ii % 72, row = ii / 72;
                const float* src = (pc < 64) ? cache_c + (size_t)row * 512 + pc * 8 : cache_k + (size_t)row * 64 + (pc - 64) * 8;
                cva[u] = __builtin_nontemporal_load((const f32x4*)src); cvc[u] = __builtin_nontemporal_load((const f32x4*)(src + 4)); cdo[u] = ok ? ((row >> 12) * KVLEN + (row & 4095)) * 72 + pc : -1; }
        }
        const float dtl = P.pdt; float acl = dtl * a_h; const u32x4 px = P.px; const u32x4 pb0 = P.pb[0], pb1 = P.pb[1], pc0 = P.pc[0], pc1 = P.pc[1];
#pragma unroll
        for (int o = 1; o < 64; o <<= 1) { const float t = __shfl_up(acl, o); if (lane >= o) acl += t; }
        const float tot = __shfl(acl, 63), dec = __expf(tot);
        const float s4l = dtl * __expf(tot - acl);
        {
            const float s4r = __shfl(s4l, prow);
            *(LAS u32x4*)(lds + L_XT + prow * SX + ppx * 16) = px;
            *(LAS u32x4*)(lds + L_XS + prow * SX + ppx * 16) = (u32x4){pk2(bflo(px[0]) * s4r, bfhi(px[0]) * s4r), pk2(bflo(px[1]) * s4r, bfhi(px[1]) * s4r), pk2(bflo(px[2]) * s4r, bfhi(px[2]) * s4r), pk2(bflo(px[3]) * s4r, bfhi(px[3]) * s4r)};
            *(LAS u32x4*)(lds + L_BN + brow * SC + bpc * 16) = pb0; *(LAS u32x4*)(lds + L_CT + brow * SC + bpc * 16) = pc0;
            *(LAS u32x4*)(lds + L_BN + (brow + 32) * SC + bpc * 16) = pb1; *(LAS u32x4*)(lds + L_CT + (brow + 32) * SC + bpc * 16) = pc1;
        }
        const u32x2 zc0 = P.pz[0], zc1 = P.pz[1];
        const float acum_i = __shfl(acl, 16 * it + c16);
        if (c + 2 < nchunks) prefetch(P, c + 2);
        __syncthreads();
        f32x4 acc3[2];
        {
            bf16x8 cb[4];
#pragma unroll
            for (int ks = 0; ks < 4; ++ks) cb[ks] = *(LAS const bf16x8*)(lds + L_CT + (16 * it + c16) * SC + (32 * ks + 8 * g) * 2);
#pragma unroll
            for (int t2 = 0; t2 < 2; ++t2) { const int jt = 2 * half + t2; f32x4 a1 = (f32x4){0.f, 0.f, 0.f, 0.f}, a3 = (f32x4){0.f, 0.f, 0.f, 0.f};
                bf16x8 bfr[4], sfr[4];
#pragma unroll
                for (int ks = 0; ks < 4; ++ks) { bfr[ks] = *(LAS const bf16x8*)(lds + L_BN + (16 * jt + c16) * SC + (32 * ks + 8 * g) * 2); sfr[ks] = *(LAS const bf16x8*)(lds + L_SB + (16 * jt + c16) * SC + (32 * ks + 8 * g) * 2); }
#pragma unroll
                for (int ks = 0; ks < 4; ++ks) { a1 = __builtin_amdgcn_mfma_f32_16x16x32_bf16(bfr[ks], cb[ks], a1, 0, 0, 0); a3 = __builtin_amdgcn_mfma_f32_16x16x32_bf16(sfr[ks], cb[ks], a3, 0, 0, 0); }
                acc3[t2] = a3;
                const int i = 16 * it + c16; float mv[4];
#pragma unroll
                for (int r = 0; r < 4; ++r) { const int j = 16 * jt + 4 * g + r; const float acj = __shfl(acl, j), dtj = __shfl(dtl, j); mv[r] = (j <= i) ? a1[r] * __expf(acum_i - acj) * dtj : 0.f; }
                *(LAS u32x2*)(lds + L_MM + i * SX + (16 * jt + 4 * g) * 2) = (u32x2){pk2(mv[0], mv[1]), pk2(mv[2], mv[3])};
            }
        }
        {
            bf16x8 xb[2];
#pragma unroll
            for (int ks = 0; ks < 2; ++ks) { LAS const unsigned char* tp = lds + L_XS + (32 * ks + 8 * g + (c16 >> 2)) * SX + (16 * it + 4 * (c16 & 3)) * 2;
                const v4i16 lo = tr16(tp), hi = tr16(tp + 4 * SX); xb[ks] = (bf16x8){lo[0], lo[1], lo[2], lo[3], hi[0], hi[1], hi[2], hi[3]}; }
#pragma unroll
            for (int nt = 0; nt < 4; ++nt) { f32x4 a4 = st[nt] * dec; const int n0 = 16 * (4 * half + nt);
#pragma unroll
                for (int ks = 0; ks < 2; ++ks) {
                    LAS const unsigned char* tp = lds + L_BN + (32 * ks + 8 * g + (c16 >> 2)) * SC + (n0 + 4 * (c16 & 3)) * 2;
                    const v4i16 lo = tr16(tp), hi = tr16(tp + 4 * SC);
                    a4 = __builtin_amdgcn_mfma_f32_16x16x32_bf16((bf16x8){lo[0], lo[1], lo[2], lo[3], hi[0], hi[1], hi[2], hi[3]}, xb[ks], a4, 0, 0, 0);
                }
                st[nt] = a4; }
        }
        __syncthreads();
        {
            bf16x8 mb[2];
#pragma unroll
            for (int ks = 0; ks < 2; ++ks) mb[ks] = *(LAS const bf16x8*)(lds + L_MM + (16 * it + c16) * SX + (32 * ks + 8 * g) * 2);
            const float ea = __expf(acum_i); const int i = 16 * it + c16;
            float ss = 0.f;
#pragma unroll
            for (int t2 = 0; t2 < 2; ++t2) { const int pt = 2 * half + t2;
                f32x4 y = acc3[t2] * ea;
#pragma unroll
                for (int ks = 0; ks < 2; ++ks) { LAS const unsigned char* tp = lds + L_XT + (32 * ks + 8 * g + (c16 >> 2)) * SX + (16 * pt + 4 * (c16 & 3)) * 2;
                    const v4i16 lo = tr16(tp), hi = tr16(tp + 4 * SX);
                    y = __builtin_amdgcn_mfma_f32_16x16x32_bf16((bf16x8){lo[0], lo[1], lo[2], lo[3], hi[0], hi[1], hi[2], hi[3]}, mb[ks], y, 0, 0, 0); }
                const u32x2 xi = *(LAS const u32x2*)(lds + L_XT + i * SX + (16 * pt + 4 * g) * 2); const u32x2 zz = t2 ? zc1 : zc0;
                const float y0 = (y[0] + d_h * bflo(xi.x)) * siluf_(bflo(zz.x)), y1 = (y[1] + d_h * bfhi(xi.x)) * siluf_(bfhi(zz.x)), y2 = (y[2] + d_h * bflo(xi.y)) * siluf_(bflo(zz.y)), y3 = (y[3] + d_h * bfhi(xi.y)) * siluf_(bfhi(zz.y));
                ss += (y0 * y0 + y1 * y1) + (y2 * y2 + y3 * y3);
                *(LAS u32x2*)(lds + L_YO + i * SX + (16 * pt + 4 * g) * 2) = (u32x2){pk2(y0, y1), pk2(y2, y3)};
            }
            ss += __shfl_xor(ss, 16); ss += __shfl_xor(ss, 32);
            if (g == 0) *(LAS float*)(lds + L_SCAL + half * 256 + i * 4) = ss;
#pragma unroll
            for (int nt = 0; nt < 4; ++nt) *(LAS u32x2*)(lds + L_SB + (16 * it + c16) * SC + (16 * (4 * half + nt) + 4 * g) * 2) = (u32x2){pk2(st[nt][0], st[nt][1]), pk2(st[nt][2], st[nt][3])};
        }
        __syncthreads();
        {
            const int row = tid >> 3, pc8 = tid & 7;
            if (row < nvalid) { const u32x4 v = *(LAS const u32x4*)(lds + L_YO + row * SX + pc8 * 16);
                *(u32x4*)((bf16_t*)(ws + WS_YZ) + (r0 + row) * 2048 + h * 64 + pc8 * 8) = v; }
            if (tid < nvalid) { LAS const float* pp = (LAS const float*)(lds + L_SCAL); ((float*)(ws + WS_SSQ))[(r0 + tid) * 32 + h] = pp[tid] + pp[64 + tid]; }
            if (!sample) {
#pragma unroll
                for (int u = 0; u < 3; ++u) if (cdo[u] >= 0) *(u32x4*)(cache_dst + (size_t)cdo[u] * 8) = (u32x4){pk2(cva[u].x, cva[u].y), pk2(cva[u].z, cva[u].w), pk2(cvc[u].x, cvc[u].y), pk2(cvc[u].z, cvc[u].w)};
            }
        }
    };
    for (int c = 0; c < nchunks; c += 2) { chunk(pfA, c); if (c + 1 < nchunks) chunk(pfB, c + 1); }
    {
        float* so = sample ? F.out + O_SSMS + ((size_t)(bb * 32 + h) * 64) * 128 : F.out + O_SSMP + ((size_t)(bb * 32 + h) * 64) * 128;
#pragma unroll
        for (int nt = 0; nt < 4; ++nt) __builtin_nontemporal_store(st[nt], (f32x4*)(so + (size_t)(16 * it + c16) * 128 + 16 * (4 * half + nt) + 4 * g));
    }
    __syncthreads();
}

namespace att {
typedef float f32x16 __attribute__((ext_vector_type(16)));
typedef short v4i16 __attribute__((ext_vector_type(4)));
__device__ __forceinline__ v4i16 tr16(LAS const unsigned char* p) { return __builtin_amdgcn_ds_read_tr16_b64_v4i16((LAS v4i16*)p); }
constexpr float QSCALE = 0.07216878364870322f * 1.4426950408889634f;
constexpr int PK_STR = 400, PV_STR = 320, PK_BYTES = 64 * PK_STR, PV_BYTES = 64 * PV_STR, PBUF = PK_BYTES + PV_BYTES;
static_assert(2 * PBUF <= LDSCTL_OFF, "prompt attention LDS");
constexpr int SK_STR = 1056, SK_MAIN = 32 * SK_STR, SK_TAIL = 32 * 128, SK_BUF = SK_MAIN + SK_TAIL;
constexpr int SQ_STR = 528, SQ_WAVE = 16 * SQ_STR, SQ_OFF = 2 * SK_BUF;
static_assert(SQ_OFF + 8 * SQ_WAVE <= LDSCTL_OFF, "sample attention LDS");
__device__ __forceinline__ unsigned pkbf(float lo, float hi) { return pg8::cvt_pk_bf16(lo, hi); }
__device__ __forceinline__ void glds16(const void* gsrc, unsigned lds_dst) { unsigned keep;
    asm volatile("s_mov_b32 %0, m0\n\ts_mov_b32 m0, %2\n\ts_nop 0\n\tglobal_load_lds_dwordx4 %1, off\n\ts_mov_b32 m0, %0" : "=&s"(keep) : "v"(gsrc), "s"(lds_dst) : "memory"); }
__device__ __forceinline__ void glds16s(const void* sbase, unsigned voff, unsigned lds_dst) { unsigned keep;
    asm volatile("s_mov_b32 %0, m0\n\ts_mov_b32 m0, %2\n\ts_nop 4\n\tglobal_load_lds_dwordx4 %1, %3\n\ts_mov_b32 m0, %0" : "=&s"(keep) : "v"(voff), "s"(lds_dst), "s"(sbase) : "memory"); }
}

template <int MODE> __device__ __forceinline__ void attn_prompt_unit(Frame& F, int b, int h, int qb) {
    using namespace att;
    LAS unsigned char* lds = F.lds; unsigned char* ws = F.ws;
    int tid_o = F.tid; asm volatile("" : "+v"(tid_o));
    const int tid = tid_o, lane = tid & 63, w = F.wave, r32 = lane & 31, hi = lane >> 5, i16 = lane & 15, gi = lane >> 4;
    const bf16_t* qg = (const bf16_t*)(ws + WS_Q); const bf16_t* kn = (const bf16_t*)(ws + WS_KN); const bf16_t* vv = (const bf16_t*)(ws + WS_V); const bf16_t* kpe = (const bf16_t*)(ws + WS_KPER);
    const float* ct = (const float*)(ws + WS_ROPE); const float* st = ct + 2080 * 32;
    const size_t rowb = (size_t)b * SEQ;
    const int NT = 4 * qb + 4, my_last = 4 * qb + (w >> 1);
    bf16x8 qf[12];
    {
        const int pos = 256 * qb + 32 * w + r32; const bf16_t* qrow = qg + (rowb + pos) * 3072 + h * 192 + 8 * hi;
#pragma unroll
        for (int ks = 0; ks < 8; ++ks) { const u32x4 v = *(const u32x4*)(qrow + 16 * ks); u32x4 o;
#pragma unroll
            for (int e = 0; e < 4; ++e) o[e] = pkbf(bflo(v[e]) * QSCALE, bfhi(v[e]) * QSCALE);
            qf[ks] = __builtin_bit_cast(bf16x8, o); }
#pragma unroll
        for (int kp = 0; kp < 2; ++kp) {
            const u32x4 v1 = *(const u32x4*)(qrow + 128 + 16 * kp), v2 = *(const u32x4*)(qrow + 160 + 16 * kp);
            const float* cp = ct + pos * 32 + 16 * kp + 8 * hi; const float* sp = st + pos * 32 + 16 * kp + 8 * hi;
            const f32x4 c0 = *(const f32x4*)cp, c1 = *(const f32x4*)(cp + 4), s0 = *(const f32x4*)sp, s1 = *(const f32x4*)(sp + 4);
            float t1[8], t2[8], o1[8], o2[8];
#pragma unroll
            for (int e = 0; e < 4; ++e) { t1[2 * e] = bflo(v1[e]); t1[2 * e + 1] = bfhi(v1[e]); t2[2 * e] = bflo(v2[e]); t2[2 * e + 1] = bfhi(v2[e]); }
#pragma unroll
            for (int e = 0; e < 8; ++e) { const float c = (e < 4) ? c0[e & 3] : c1[e & 3], sn = (e < 4) ? s0[e & 3] : s1[e & 3];
                o1[e] = (t1[e] * c - t2[e] * sn) * QSCALE; o2[e] = (t1[e] * sn + t2[e] * c) * QSCALE; }
            qf[8 + kp] = __builtin_bit_cast(bf16x8, (u32x4){pkbf(o1[0], o1[1]), pkbf(o1[2], o1[3]), pkbf(o1[4], o1[5]), pkbf(o1[6], o1[7])});
            qf[10 + kp] = __builtin_bit_cast(bf16x8, (u32x4){pkbf(o2[0], o2[1]), pkbf(o2[2], o2[3]), pkbf(o2[4], o2[5]), pkbf(o2[6], o2[7])});
        }
    }
    f32x16 oT[4];
#pragma unroll
    for (int d = 0; d < 4; ++d)
#pragma unroll
        for (int r = 0; r < 16; ++r) oT[d][r] = 0.f;
    float m_run = -INFINITY, l_run = 0.f;
    u32x4 pk[3], pv[2];
    auto gload = [&](int t) {
        const size_t r0 = rowb + (size_t)t * 64;
#pragma unroll
        for (int i = 0; i < 3; ++i) { const int idx = tid + 512 * i, row = idx / 24, pc = idx % 24;
            pk[i] = (pc < 16) ? *(const u32x4*)(kn + (r0 + row) * 2048 + h * 128 + pc * 8) : *(const u32x4*)(kpe + (r0 + row) * 64 + (pc - 16) * 8); }
#pragma unroll
        for (int i = 0; i < 2; ++i) { const int idx = tid + 512 * i, row = idx >> 4, pc = idx & 15; pv[i] = *(const u32x4*)(vv + (r0 + row) * 2048 + h * 128 + pc * 8); }
    };
    auto lstore = [&](int buf) {
        LAS unsigned char* kb = lds + buf * PBUF; LAS unsigned char* vb = kb + PK_BYTES;
#pragma unroll
        for (int i = 0; i < 3; ++i) { const int idx = tid + 512 * i, row = idx / 24, pc = idx % 24; *(LAS u32x4*)(kb + row * PK_STR + pc * 16) = pk[i]; }
#pragma unroll
        for (int i = 0; i < 2; ++i) { const int idx = tid + 512 * i, row = idx >> 4, pc = idx & 15; *(LAS u32x4*)(vb + row * PV_STR + pc * 16) = pv[i]; }
    };
    __syncthreads();
    if (MODE != 1) { gload(0); lstore(0); }
    __syncthreads();
    for (int t = 0; t < NT; ++t) {
        if (MODE != 1 && t + 1 < NT) gload(t + 1);
        if (MODE != 2 && t <= my_last) {
            LAS const unsigned char* kb = lds + (t & 1) * PBUF; LAS const unsigned char* vb = kb + PK_BYTES;
#pragma unroll
            for (int T = 0; T < 2; ++T) {
                f32x16 sT;
#pragma unroll
                for (int r = 0; r < 16; ++r) sT[r] = 0.f;
                {
                    LAS const unsigned char* kp = kb + (32 * T + r32) * PK_STR + 16 * hi;
#define PA_LDK(dst, k0) do { _Pragma("unroll") for (int i_ = 0; i_ < 4; ++i_) dst[i_] = *(LAS const bf16x8*)(kp + ((k0) + i_) * 32); } while (0)
#define PA_MMK(src, k0) do { _Pragma("unroll") for (int i_ = 0; i_ < 4; ++i_) sT = __builtin_amdgcn_mfma_f32_32x32x16_bf16(src[i_], qf[(k0) + i_], sT, 0, 0, 0); } while (0)
                    bf16x8 ka[4], kc[4];
                    PA_LDK(ka, 0); PA_LDK(kc, 4); __builtin_amdgcn_sched_barrier(0);
                    PA_MMK(ka, 0); __builtin_amdgcn_sched_barrier(0);
                    PA_LDK(ka, 8); __builtin_amdgcn_sched_barrier(0);
                    PA_MMK(kc, 4); __builtin_amdgcn_sched_barrier(0);
                    PA_MMK(ka, 8); __builtin_amdgcn_sched_barrier(0);
#undef PA_LDK
#undef PA_MMK
                }
                float mt = sT[0];
#pragma unroll
                for (int r = 1; r < 16; ++r) mt = fmaxf(mt, sT[r]);
                mt = fmaxf(mt, __shfl_xor(mt, 32));
                if (__any(mt > m_run + 8.0f)) {
                    const float m_new = fmaxf(m_run, mt); const float alpha = __builtin_amdgcn_exp2f(m_run - m_new); m_run = m_new; l_run *= alpha;
#pragma unroll
                    for (int d = 0; d < 4; ++d)
#pragma unroll
                        for (int r = 0; r < 16; ++r) oT[d][r] *= alpha;
                }
                float ps = 0.f;
#pragma unroll
                for (int r = 0; r < 16; ++r) { const float p = __builtin_amdgcn_exp2f(sT[r] - m_run); sT[r] = p; ps += p; }
                l_run += ps;
                bf16x8 pf[2];
#pragma unroll
                for (int sp = 0; sp < 2; ++sp) pf[sp] = __builtin_bit_cast(bf16x8, (u32x4){pkbf(sT[8 * sp], sT[8 * sp + 1]), pkbf(sT[8 * sp + 2], sT[8 * sp + 3]), pkbf(sT[8 * sp + 4], sT[8 * sp + 5]), pkbf(sT[8 * sp + 6], sT[8 * sp + 7])});
                __builtin_amdgcn_sched_barrier(0);
                {
                    LAS const unsigned char* tp0 = vb + (32 * T + 4 * hi + (i16 >> 2)) * PV_STR + (16 * (gi & 1) + 4 * (i16 & 3)) * 2;
#define PA_LDV(dst, d_) do { dst[0] = tr16(tp0 + (d_) * 64); dst[1] = tr16(tp0 + (d_) * 64 + 8 * PV_STR); dst[2] = tr16(tp0 + (d_) * 64 + 16 * PV_STR); dst[3] = tr16(tp0 + (d_) * 64 + 24 * PV_STR); } while (0)
#define PA_MMV(src, d_) do { oT[d_] = __builtin_amdgcn_mfma_f32_32x32x16_bf16((bf16x8){src[0][0], src[0][1], src[0][2], src[0][3], src[1][0], src[1][1], src[1][2], src[1][3]}, pf[0], oT[d_], 0, 0, 0); \
                        oT[d_] = __builtin_amdgcn_mfma_f32_32x32x16_bf16((bf16x8){src[2][0], src[2][1], src[2][2], src[2][3], src[3][0], src[3][1], src[3][2], src[3][3]}, pf[1], oT[d_], 0, 0, 0); } while (0)
                    v4i16 va[4], vc[4];
                    PA_LDV(va, 0); PA_LDV(vc, 1); __builtin_amdgcn_sched_barrier(0);
                    PA_MMV(va, 0); __builtin_amdgcn_sched_barrier(0);
                    PA_LDV(va, 2); __builtin_amdgcn_sched_barrier(0);
                    PA_MMV(vc, 1); __builtin_amdgcn_sched_barrier(0);
                    PA_LDV(vc, 3); __builtin_amdgcn_sched_barrier(0);
                    PA_MMV(va, 2); __builtin_amdgcn_sched_barrier(0);
                    PA_MMV(vc, 3); __builtin_amdgcn_sched_barrier(0);
#undef PA_LDV
#undef PA_MMV
                }
            }
        }
        if (MODE != 1 && t + 1 < NT) lstore((t + 1) & 1);
        __syncthreads();
    }
    if (MODE != 0 && l_run != 12345.f) return;
    l_run += __shfl_xor(l_run, 32);
    const float rl = 1.0f / l_run;
    bf16_t* orow = (bf16_t*)(ws + WS_O) + (rowb + 256 * qb + 32 * w + r32) * 2048 + h * 128 + 4 * hi;
#pragma unroll
    for (int d = 0; d < 4; ++d)
#pragma unroll
        for (int u = 0; u < 4; ++u) *(u32x2*)(orow + 32 * d + 8 * u) = (u32x2){pkbf(oT[d][4 * u] * rl, oT[d][4 * u + 1] * rl), pkbf(oT[d][4 * u + 2] * rl, oT[d][4 * u + 3] * rl)};
}

template <int MODE> __device__ __forceinline__ void attn_sample_item(Frame& F, int b, int rg) {
    using namespace att;
    LAS unsigned char* lds = F.lds; unsigned char* ws = F.ws;
    int tid_o = F.tid; asm volatile("" : "+v"(tid_o));
    const int tid = tid_o, lane = tid & 63, w = F.wave, c16 = lane & 15, g = lane >> 4;
    const int hh = 4 * rg + (w >> 1), q0 = 16 * (w & 1);
    const bf16_t* cache = (const bf16_t*)(ws + WS_CACHE) + (size_t)b * KVLEN * 576;
    const float* ct = (const float*)(ws + WS_ROPE); const float* st = ct + 2080 * 32;
    __syncthreads();
    bf16x8 qf[10];
    {
        const int qrow = b * 32 + q0 + c16; const bf16_t* ql = (const bf16_t*)(ws + WS_QLAT) + (size_t)qrow * 8192 + hh * 512 + 8 * g;
        LAS unsigned char* qd = lds + SQ_OFF + w * SQ_WAVE + c16 * SQ_STR + 16 * g;
#pragma unroll
        for (int ks = 0; ks < 16; ++ks) { const u32x4 v = *(const u32x4*)(ql + 32 * ks); u32x4 o;
#pragma unroll
            for (int e = 0; e < 4; ++e) o[e] = pkbf(bflo(v[e]) * QSCALE, bfhi(v[e]) * QSCALE);
            if (ks < 10) qf[ks] = __builtin_bit_cast(bf16x8, o); else *(LAS u32x4*)(qd + (ks - 10) * 64) = o; }
        const bf16_t* qp = (const bf16_t*)(ws + WS_Q) + (size_t)(MP + qrow) * 3072 + hh * 192 + 128 + 8 * g;
        const u32x4 v1 = *(const u32x4*)qp, v2 = *(const u32x4*)(qp + 32);
        const int pidx = 2048 + q0 + c16; const float* cp = ct + pidx * 32 + 8 * g; const float* sp = st + pidx * 32 + 8 * g;
        const f32x4 c0 = *(const f32x4*)cp, c1 = *(const f32x4*)(cp + 4), s0 = *(const f32x4*)sp, s1 = *(const f32x4*)(sp + 4);
        float t1[8], t2[8], o1[8], o2[8];
#pragma unroll
        for (int e = 0; e < 4; ++e) { t1[2 * e] = bflo(v1[e]); t1[2 * e + 1] = bfhi(v1[e]); t2[2 * e] = bflo(v2[e]); t2[2 * e + 1] = bfhi(v2[e]); }
#pragma unroll
        for (int e = 0; e < 8; ++e) { const float c = (e < 4) ? c0[e & 3] : c1[e & 3], sn = (e < 4) ? s0[e & 3] : s1[e & 3];
            o1[e] = (t1[e] * c - t2[e] * sn) * QSCALE; o2[e] = (t1[e] * sn + t2[e] * c) * QSCALE; }
        *(LAS u32x4*)(qd + 6 * 64) = (u32x4){pkbf(o1[0], o1[1]), pkbf(o1[2], o1[3]), pkbf(o1[4], o1[5]), pkbf(o1[6], o1[7])};
        *(LAS u32x4*)(qd + 7 * 64) = (u32x4){pkbf(o2[0], o2[1]), pkbf(o2[2], o2[3]), pkbf(o2[4], o2[5]), pkbf(o2[6], o2[7])};
    }
    f32x4 oT[32];
#pragma unroll
    for (int c = 0; c < 32; ++c) oT[c] = (f32x4){0.f, 0.f, 0.f, 0.f};
    float m_run = -INFINITY, l_run = 0.f;
    const unsigned lds0 = (unsigned)(uintptr_t)lds;
    const unsigned voff_main = (unsigned)lane * 16u, voff_tail = (unsigned)(((lane & 31) * 576 + 512 + (lane >> 5) * 8) * 2);
    auto dma = [&](int t, int buf) {
        const unsigned long long src = (unsigned long long)(uintptr_t)(cache + (size_t)t * 32 * 576);
#pragma unroll
        for (int i = 0; i < 5; ++i) { const int p = w + 8 * i;
            if (p < 32) { const unsigned long long sb = src + (unsigned long long)p * 1152ull;
                glds16s((const void*)(uintptr_t)(((unsigned long long)(unsigned)__builtin_amdgcn_readfirstlane((unsigned)(sb >> 32)) << 32) | (unsigned)__builtin_amdgcn_readfirstlane((unsigned)sb)), voff_main, (unsigned)__builtin_amdgcn_readfirstlane(lds0 + buf * SK_BUF + p * SK_STR)); }
            else if (p < 36) { const unsigned long long sb = src + (unsigned long long)(p - 32) * 32ull;
                glds16s((const void*)(uintptr_t)(((unsigned long long)(unsigned)__builtin_amdgcn_readfirstlane((unsigned)(sb >> 32)) << 32) | (unsigned)__builtin_amdgcn_readfirstlane((unsigned)sb)), voff_tail, (unsigned)__builtin_amdgcn_readfirstlane(lds0 + buf * SK_BUF + SK_MAIN + (p - 32) * 1024)); } }
    };
    constexpr int NT = KVLEN / 32;
    dma(0, 0);
    asm volatile("s_waitcnt vmcnt(0)" ::: "memory");
    __syncthreads();
    for (int t = 0; t < NT; ++t) {
        if (t + 1 < NT) dma(t + 1, (t + 1) & 1);
        LAS const unsigned char* kb = lds + (t & 1) * SK_BUF;
        f32x4 sT[2];
        sT[0] = (f32x4){0.f, 0.f, 0.f, 0.f}; sT[1] = sT[0];
        {
            LAS const unsigned char* qlp = lds + SQ_OFF + w * SQ_WAVE + c16 * SQ_STR + 16 * g;
#define SB_KLD(ks, T) (((ks) < 16) ? *(LAS const bf16x8*)(kb + (16 * (T) + c16) * SK_STR + (32 * (ks) + 8 * g) * 2) : *(LAS const bf16x8*)(kb + SK_MAIN + (4 * ((ks) - 16) + g) * 512 + (16 * (T) + c16) * 16))
#define SB_LDB(dst, k0) do { dst[0] = SB_KLD((k0), 0); dst[1] = SB_KLD((k0), 1); dst[2] = SB_KLD((k0) + 1, 0); dst[3] = SB_KLD((k0) + 1, 1); } while (0)
#define SB_QF(ks) (((ks) < 10) ? qf[(ks) < 10 ? (ks) : 0] : *(LAS const bf16x8*)(qlp + ((ks) - 10) * 64))
#define SB_MMB(src, k0) do { const bf16x8 q0_ = SB_QF(k0), q1_ = SB_QF((k0) + 1); \
            sT[0] = __builtin_amdgcn_mfma_f32_16x16x32_bf16(src[0], q0_, sT[0], 0, 0, 0); sT[1] = __builtin_amdgcn_mfma_f32_16x16x32_bf16(src[1], q0_, sT[1], 0, 0, 0); \
            sT[0] = __builtin_amdgcn_mfma_f32_16x16x32_bf16(src[2], q1_, sT[0], 0, 0, 0); sT[1] = __builtin_amdgcn_mfma_f32_16x16x32_bf16(src[3], q1_, sT[1], 0, 0, 0); } while (0)
            bf16x8 ka[4], kc[4];
            SB_LDB(ka, 0);
#pragma unroll
            for (int bi = 0; bi < 9; bi += 2) {
                if (bi + 1 < 9) { SB_LDB(kc, 2 * (bi + 1)); } __builtin_amdgcn_sched_barrier(0);
                SB_MMB(ka, 2 * bi); __builtin_amdgcn_sched_barrier(0);
                if (bi + 2 < 9) { SB_LDB(ka, 2 * (bi + 2)); } __builtin_amdgcn_sched_barrier(0);
                if (bi + 1 < 9) { SB_MMB(kc, 2 * (bi + 1)); } __builtin_amdgcn_sched_barrier(0);
            }
#undef SB_KLD
#undef SB_LDB
#undef SB_QF
#undef SB_MMB
        }
        float mt = fmaxf(fmaxf(fmaxf(sT[0][0], sT[0][1]), fmaxf(sT[0][2], sT[0][3])), fmaxf(fmaxf(sT[1][0], sT[1][1]), fmaxf(sT[1][2], sT[1][3])));
        mt = fmaxf(mt, __shfl_xor(mt, 16)); mt = fmaxf(mt, __shfl_xor(mt, 32));
        if (__any(mt > m_run + 8.0f)) {
            const float m_new = fmaxf(m_run, mt); const float alpha = __builtin_amdgcn_exp2f(m_run - m_new); m_run = m_new; l_run *= alpha;
#pragma unroll
            for (int c = 0; c < 32; ++c) oT[c] = oT[c] * alpha;
        }
        float p[8];
#pragma unroll
        for (int T = 0; T < 2; ++T)
#pragma unroll
            for (int r = 0; r < 4; ++r) { p[4 * T + r] = __builtin_amdgcn_exp2f(sT[T][r] - m_run); l_run += p[4 * T + r]; }
        const bf16x8 pf = __builtin_bit_cast(bf16x8, (u32x4){pkbf(p[0], p[1]), pkbf(p[2], p[3]), pkbf(p[4], p[5]), pkbf(p[6], p[7])});
        {
            LAS const unsigned char* tp0 = kb + (4 * g + (c16 >> 2)) * SK_STR + (4 * (c16 & 3)) * 2;
#define SB_VLD(dst, c0) do { dst[0] = tr16(tp0 + (c0) * 32); dst[1] = tr16(tp0 + (c0) * 32 + 16 * SK_STR); dst[2] = tr16(tp0 + ((c0) + 1) * 32); dst[3] = tr16(tp0 + ((c0) + 1) * 32 + 16 * SK_STR); } while (0)
#define SB_VMM(src, c0) do { oT[(c0)] = __builtin_amdgcn_mfma_f32_16x16x32_bf16((bf16x8){src[0][0], src[0][1], src[0][2], src[0][3], src[1][0], src[1][1], src[1][2], src[1][3]}, pf, oT[(c0)], 0, 0, 0); \
                oT[(c0) + 1] = __builtin_amdgcn_mfma_f32_16x16x32_bf16((bf16x8){src[2][0], src[2][1], src[2][2], src[2][3], src[3][0], src[3][1], src[3][2], src[3][3]}, pf, oT[(c0) + 1], 0, 0, 0); } while (0)
            v4i16 va[4], vc[4];
            SB_VLD(va, 0);
#pragma unroll
            for (int cb = 0; cb < 16; cb += 2) {
                SB_VLD(vc, 2 * (cb + 1)); __builtin_amdgcn_sched_barrier(0);
                SB_VMM(va, 2 * cb); __builtin_amdgcn_sched_barrier(0);
                if (cb + 2 < 16) { SB_VLD(va, 2 * (cb + 2)); } __builtin_amdgcn_sched_barrier(0);
                SB_VMM(vc, 2 * (cb + 1)); __builtin_amdgcn_sched_barrier(0);
            }
#undef SB_VLD
#undef SB_VMM
        }
        asm volatile("s_waitcnt vmcnt(0)" ::: "memory");
        __syncthreads();
    }
    l_run += __shfl_xor(l_run, 16); l_run += __shfl_xor(l_run, 32);
    const float rl = 1.0f / l_run;
    bf16x8 of[16];
#pragma unroll
    for (int kb2 = 0; kb2 < 16; ++kb2) { const f32x4 a = oT[2 * kb2] * rl, c2 = oT[2 * kb2 + 1] * rl;
        of[kb2] = __builtin_bit_cast(bf16x8, (u32x4){pkbf(a[0], a[1]), pkbf(a[2], a[3]), pkbf(c2[0], c2[1]), pkbf(c2[2], c2[3])}); }
    const bf16_t* wuv = (const bf16_t*)(ws + WS_WUV) + (size_t)(hh * 128 + c16) * 512 + 4 * g;
    bf16_t* orow = (bf16_t*)(ws + WS_O) + (size_t)(MP + b * 32 + q0 + c16) * 2048 + hh * 128 + 4 * g;
#pragma unroll 2
    for (int vt = 0; vt < 8; ++vt) { f32x4 a = (f32x4){0.f, 0.f, 0.f, 0.f};
#pragma unroll
        for (int kb2 = 0; kb2 < 16; ++kb2) { const u32x2 w0 = *(const u32x2*)(wuv + (size_t)vt * 16 * 512 + 32 * kb2), w1 = *(const u32x2*)(wuv + (size_t)vt * 16 * 512 + 32 * kb2 + 16);
            a = __builtin_amdgcn_mfma_f32_16x16x32_bf16(__builtin_bit_cast(bf16x8, (u32x4){w0.x, w0.y, w1.x, w1.y}), of[kb2], a, 0, 0, 0); }
        *(u32x2*)(orow + 16 * vt) = (u32x2){pkbf(a[0], a[1]), pkbf(a[2], a[3])}; }
}


struct MixOrder {
    const char *A0, *B0, *A1, *B1; int G, c;
    __device__ __forceinline__ bool next(int i, pg8::Unit& u) const {
        const int idx = (i >> 1) * G + c; if (idx >= (MP / 256) * 4) return false;
        u.pm = idx >> 2; u.pn = idx & 3; u.seg = i & 1;
        u.a = ((i & 1) ? A1 : A0) + (size_t)u.pm * 256 * 2048 * 2; u.b = ((i & 1) ? B1 : B0) + (size_t)u.pn * 256 * 2048 * 2; return true;
    }
};
struct EpiMix {
    static constexpr bool PERM = true;
    const bf16_t* gates; const float* bgate; float* t1; bf16_t* uo;
    __device__ __forceinline__ void operator()(const f32x4 (&acc)[2][2][4][2], const pg8::Unit& u, int wr, int wc, int fr, int fq) const {
        const int row0 = u.pm * 256 + wr * 64 + fr, col0 = u.pn * 256 + wc * 32 + 8 * fq, gofs = u.seg ? 1024 : 0;
#pragma unroll
        for (int bj = 0; bj < 2; ++bj) { const int col = col0 + bj * 128;
            const f32x4 bg0 = *(const f32x4*)(bgate + gofs + col), bg1 = *(const f32x4*)(bgate + gofs + col + 4);
#pragma unroll
            for (int ai = 0; ai < 2; ++ai)
#pragma unroll
                for (int m = 0; m < 4; ++m) { const size_t row = (size_t)(row0 + ai * 128 + m * 16);
                    const u32x4 gv = *(const u32x4*)(gates + row * 2048 + gofs + col);
                    const f32x4 a0 = acc[ai][bj][m][0], a1 = acc[ai][bj][m][1];
                    f32x4 r0, r1;
                    r0[0] = sigmoidf_(bflo(gv[0]) + bg0[0]) * a0[0]; r0[1] = sigmoidf_(bfhi(gv[0]) + bg0[1]) * a0[1]; r0[2] = sigmoidf_(bflo(gv[1]) + bg0[2]) * a0[2]; r0[3] = sigmoidf_(bfhi(gv[1]) + bg0[3]) * a0[3];
                    r1[0] = sigmoidf_(bflo(gv[2]) + bg1[0]) * a1[0]; r1[1] = sigmoidf_(bfhi(gv[2]) + bg1[1]) * a1[1]; r1[2] = sigmoidf_(bflo(gv[3]) + bg1[2]) * a1[2]; r1[3] = sigmoidf_(bfhi(gv[3]) + bg1[3]) * a1[3];
                    float* tp = t1 + row * 1024 + col;
                    if (u.seg == 0) { *(f32x4*)tp = r0; *(f32x4*)(tp + 4) = r1; }
                    else { const f32x4 p0 = *(const f32x4*)tp, p1 = *(const f32x4*)(tp + 4); r0 = r0 + p0; r1 = r1 + p1;
                        *(u32x4*)(uo + row * 1024 + col) = (u32x4){pg8::cvt_pk_bf16(r0[0], r0[1]), pg8::cvt_pk_bf16(r0[2], r0[3]), pg8::cvt_pk_bf16(r1[0], r1[1]), pg8::cvt_pk_bf16(r1[2], r1[3])}; } } }
    }
};
struct EpiV1 {
    static constexpr bool PERM = true;
    const float* xin; bf16_t* ao; float* st;
    __device__ __forceinline__ void operator()(const f32x4 (&acc)[2][2][4][2], const pg8::Unit& u, int wr, int wc, int fr, int fq) const {
        const int row0 = u.pm * 256 + wr * 64 + fr, col0 = u.pn * 256 + wc * 32 + 8 * fq;
#pragma unroll
        for (int ai = 0; ai < 2; ++ai)
#pragma unroll
            for (int m = 0; m < 4; ++m) { const int row = row0 + ai * 128 + m * 16; const float* rp = xin + (size_t)row * 1024; float s1 = 0.f, s2 = 0.f;
#pragma unroll
                for (int bj = 0; bj < 2; ++bj) { const int col = col0 + bj * 128;
                    const f32x4 x0 = *(const f32x4*)(rp + col), x1 = *(const f32x4*)(rp + col + 4);
                    const f32x4 a = x0 * ALPHA + acc[ai][bj][m][0], b = x1 * ALPHA + acc[ai][bj][m][1];
                    s1 += ((a[0] + a[1]) + (a[2] + a[3])) + ((b[0] + b[1]) + (b[2] + b[3]));
                    s2 += ((a[0] * a[0] + a[1] * a[1]) + (a[2] * a[2] + a[3] * a[3])) + ((b[0] * b[0] + b[1] * b[1]) + (b[2] * b[2] + b[3] * b[3]));
                    *(u32x4*)(ao + (size_t)row * 1024 + col) = (u32x4){pg8::cvt_pk_bf16(a[0], a[1]), pg8::cvt_pk_bf16(a[2], a[3]), pg8::cvt_pk_bf16(b[0], b[1]), pg8::cvt_pk_bf16(b[2], b[3])}; }
                s1 += __shfl_xor(s1, 16); s1 += __shfl_xor(s1, 32); s2 += __shfl_xor(s2, 16); s2 += __shfl_xor(s2, 32);
                if (fq == 0) { atomicAdd(st + 2 * (size_t)row, s1); atomicAdd(st + 2 * (size_t)row + 1, s2); } }
    }
};
struct EpiV2 {
    static constexpr bool PERM = true;
    const bf16_t* v1i; const float* st; const float* g1; const float* b1; bf16_t* out;
    __device__ __forceinline__ void operator()(const f32x4 (&acc)[2][2][4][2], const pg8::Unit& u, int wr, int wc, int fr, int fq) const {
        const int row0 = u.pm * 256 + wr * 64 + fr, col0 = u.pn * 256 + wc * 32 + 8 * fq;
        f32x4 gA[2][2], bA[2][2];
#pragma unroll
        for (int bj = 0; bj < 2; ++bj) { gA[bj][0] = *(const f32x4*)(g1 + col0 + bj * 128) * ALPHA; gA[bj][1] = *(const f32x4*)(g1 + col0 + bj * 128 + 4) * ALPHA; bA[bj][0] = *(const f32x4*)(b1 + col0 + bj * 128) * ALPHA; bA[bj][1] = *(const f32x4*)(b1 + col0 + bj * 128 + 4) * ALPHA; }
#pragma unroll
        for (int ai = 0; ai < 2; ++ai)
#pragma unroll
            for (int m = 0; m < 4; ++m) { const int row = row0 + ai * 128 + m * 16; const bf16_t* rp = v1i + (size_t)row * 1024;
                const f32x2 ss = *(const f32x2*)(st + 2 * (size_t)row); const float mu = ss.x * (1.f / 1024.f), rs = 1.0f / sqrtf(ss.y * (1.f / 1024.f) - mu * mu + LN_EPS);
#pragma unroll
                for (int bj = 0; bj < 2; ++bj) { const int col = col0 + bj * 128;
                    const u32x4 xv = *(const u32x4*)(rp + col);
                    const f32x4 x0 = ((f32x4){bflo(xv[0]), bfhi(xv[0]), bflo(xv[1]), bfhi(xv[1])} - mu) * rs, x1 = ((f32x4){bflo(xv[2]), bfhi(xv[2]), bflo(xv[3]), bfhi(xv[3])} - mu) * rs;
                    const f32x4 o0 = x0 * gA[bj][0] + bA[bj][0] + acc[ai][bj][m][0], o1 = x1 * gA[bj][1] + bA[bj][1] + acc[ai][bj][m][1];
                    *(u32x4*)(out + (size_t)row * 1024 + col) = (u32x4){pg8::cvt_pk_bf16(o0[0], o0[1]), pg8::cvt_pk_bf16(o0[2], o0[3]), pg8::cvt_pk_bf16(o1[0], o1[1]), pg8::cvt_pk_bf16(o1[2], o1[3])}; } }
    }
};
struct EpiRelu2 {
    static constexpr bool PERM = true;
    bf16_t* out; const float* st; const float* gw;
    __device__ __forceinline__ void operator()(const f32x4 (&acc)[2][2][4][2], const pg8::Unit& u, int wr, int wc, int fr, int fq) const {
        const int row0 = u.pm * 256 + wr * 64 + fr, col0 = u.pn * 256 + wc * 32 + 8 * fq;
        bf16_t* p = out + (size_t)row0 * 4096 + col0;
        f32x4 gA[2][2], bA[2][2];
#pragma unroll
        for (int bj = 0; bj < 2; ++bj) { gA[bj][0] = *(const f32x4*)(gw + col0 + bj * 128); gA[bj][1] = *(const f32x4*)(gw + col0 + bj * 128 + 4); bA[bj][0] = *(const f32x4*)(gw + 4096 + col0 + bj * 128); bA[bj][1] = *(const f32x4*)(gw + 4096 + col0 + bj * 128 + 4); }
#pragma unroll
        for (int ai = 0; ai < 2; ++ai)
#pragma unroll
            for (int m = 0; m < 4; ++m) { const int row = row0 + ai * 128 + m * 16;
                const f32x2 ss = *(const f32x2*)(st + 2 * (size_t)row); const float mu = ss.x * (1.f / 1024.f), rs = 1.0f / sqrtf(ss.y * (1.f / 1024.f) - mu * mu + LN_EPS), rm = rs * mu;
#pragma unroll
                for (int bj = 0; bj < 2; ++bj) { f32x4 v0 = acc[ai][bj][m][0] * rs - gA[bj][0] * rm + bA[bj][0], v1 = acc[ai][bj][m][1] * rs - gA[bj][1] * rm + bA[bj][1];
#pragma unroll
                    for (int e = 0; e < 4; ++e) { const float a = fmaxf(v0[e], 0.f), b = fmaxf(v1[e], 0.f); v0[e] = a * a; v1[e] = b * b; }
                    *(u32x4*)(p + (size_t)(ai * 128 + m * 16) * 4096 + bj * 128) = (u32x4){pg8::cvt_pk_bf16(v0[0], v0[1]), pg8::cvt_pk_bf16(v0[2], v0[3]), pg8::cvt_pk_bf16(v1[0], v1[1]), pg8::cvt_pk_bf16(v1[2], v1[3])}; } }
    }
};
template <bool FINAL> __device__ __forceinline__ void ln_rows(Frame& F, const void* srcv, const float* gam, const float* bet, float* dstf, bf16_t* dstb) {
    const int gw = F.vcu * NWAVES + F.wave, NGW = F.G * NWAVES, lane = F.lane;
    f32x4 gg[4], bb[4];
#pragma unroll
    for (int j = 0; j < 4; ++j) { gg[j] = *(const f32x4*)(gam + 4 * lane + 256 * j); bb[j] = *(const f32x4*)(bet + 4 * lane + 256 * j); }
    for (int m = gw; m < M; m += NGW) {
        f32x4 v[4]; float s = 0.f;
#pragma unroll
        for (int j = 0; j < 4; ++j) {
            if (FINAL) { const u32x2 t = __builtin_nontemporal_load((const u32x2*)((const bf16_t*)srcv + (size_t)m * 1024 + 4 * lane + 256 * j)); v[j] = (f32x4){bflo(t[0]), bfhi(t[0]), bflo(t[1]), bfhi(t[1])}; }
            else v[j] = *(const f32x4*)((const float*)srcv + (size_t)m * 1024 + 4 * lane + 256 * j);
            s += (v[j].x + v[j].y) + (v[j].z + v[j].w); }
        const float mean = wave_sum(s) * (1.f / 1024.f); float s2 = 0.f;
#pragma unroll
        for (int j = 0; j < 4; ++j) { v[j] = v[j] - mean; s2 += (v[j].x * v[j].x + v[j].y * v[j].y) + (v[j].z * v[j].z + v[j].w * v[j].w); }
        const float rstd = 1.f / sqrtf(wave_sum(s2) * (1.f / 1024.f) + LN_EPS);
        float* of = FINAL ? ((m < MP) ? F.out + O_YP + (size_t)m * 1024 : F.out + O_YS + (size_t)(m - MP) * 1024) : dstf + (size_t)m * 1024;
#pragma unroll
        for (int j = 0; j < 4; ++j) { const f32x4 o = v[j] * rstd * gg[j] + bb[j]; if (FINAL) __builtin_nontemporal_store(o, (f32x4*)(of + 4 * lane + 256 * j)); else *(f32x4*)(of + 4 * lane + 256 * j) = o;
            if (!FINAL) *(u32x2*)(dstb + (size_t)m * 1024 + 4 * lane + 256 * j) = (u32x2){pk2(o.x, o.y), pk2(o.z, o.w)}; }
    }
}
__device__ __forceinline__ void yz_norm_item(Frame& F, const float* gain, int pm) {
    const int lane = F.lane; unsigned char* ws = F.ws;
    f32x4 g0[4], g1[4];
#pragma unroll
    for (int i = 0; i < 4; ++i) { const int ch = lane * 8 + 512 * i; g0[i] = *(const f32x4*)(gain + ch); g1[i] = *(const f32x4*)(gain + ch + 4); }
#pragma unroll 1
    for (int hb = 0; hb < 4; ++hb) {
        u32x4 v[2][4]; f32x4 q4[2][4];
#pragma unroll
        for (int r = 0; r < 2; ++r) { const size_t row = (size_t)pm * 64 + F.wave * 8 + hb * 2 + r; const bf16_t* p = (const bf16_t*)(ws + WS_YZ) + row * 2048; const float* sq = (const float*)(ws + WS_SSQ) + row * 32;
#pragma unroll
            for (int i = 0; i < 4; ++i) { const int ch = lane * 8 + 512 * i; v[r][i] = *(const u32x4*)(p + ch); q4[r][i] = *(const f32x4*)(sq + 4 * (ch >> 8)); } }
#pragma unroll
        for (int r = 0; r < 2; ++r) { const size_t row = (size_t)pm * 64 + F.wave * 8 + hb * 2 + r; bf16_t* p = (bf16_t*)(ws + WS_YZ) + row * 2048;
#pragma unroll
            for (int i = 0; i < 4; ++i) { const int ch = lane * 8 + 512 * i; const f32x4 q = q4[r][i]; const float rs = 1.0f / sqrtf(((q.x + q.y) + (q.z + q.w)) * (1.0f / 256.0f) + RMS_EPS); const u32x4 x = v[r][i];
                *(u32x4*)(p + ch) = (u32x4){pk2(bflo(x[0]) * rs * g0[i][0], bfhi(x[0]) * rs * g0[i][1]), pk2(bflo(x[1]) * rs * g0[i][2], bfhi(x[1]) * rs * g0[i][3]),
                                            pk2(bflo(x[2]) * rs * g1[i][0], bfhi(x[2]) * rs * g1[i][1]), pk2(bflo(x[3]) * rs * g1[i][2], bfhi(x[3]) * rs * g1[i][3])}; } }
    }
}

__device__ __forceinline__ void sgemm_tile(Frame& F, const bf16_t* a0, int lda, const bf16_t* b0, int ldb, int K, float (&v)[8]) {
    int tid_o = F.tid; asm volatile("" : "+v"(tid_o));
    const int tid = tid_o, lane = tid & 63, w = F.wave, c16 = lane & 15, g = lane >> 4;
    const int kw = K >> 3, nks = kw >> 5;
    const bf16_t* ap = a0 + (size_t)c16 * lda + w * kw + 8 * g;
    const bf16_t* bp = b0 + (size_t)c16 * ldb + w * kw + 8 * g;
    f32x4 acc[4][4];
#pragma unroll
    for (int i = 0; i < 4; ++i)
#pragma unroll
        for (int j = 0; j < 4; ++j) acc[i][j] = (f32x4){0.f, 0.f, 0.f, 0.f};
    bf16x8 af[4], bfr[4], an[4], bn[4];
#pragma unroll
    for (int i = 0; i < 4; ++i) { af[i] = *(const bf16x8*)(ap + (size_t)i * 16 * lda); bfr[i] = *(const bf16x8*)(bp + (size_t)i * 16 * ldb); }
    for (int ks = 0; ks < nks; ++ks) {
        const int kn = (ks + 1 < nks) ? (ks + 1) * 32 : ks * 32;
#pragma unroll
        for (int i = 0; i < 4; ++i) { an[i] = *(const bf16x8*)(ap + (size_t)i * 16 * lda + kn); bn[i] = *(const bf16x8*)(bp + (size_t)i * 16 * ldb + kn); }
#pragma unroll
        for (int i = 0; i < 4; ++i)
#pragma unroll
            for (int j = 0; j < 4; ++j) acc[i][j] = __builtin_amdgcn_mfma_f32_16x16x32_bf16(af[i], bfr[j], acc[i][j], 0, 0, 0);
#pragma unroll
        for (int i = 0; i < 4; ++i) { af[i] = an[i]; bfr[i] = bn[i]; }
    }
    __syncthreads();
    LAS float* slab = (LAS float*)(F.lds + w * 16384);
#pragma unroll
    for (int i = 0; i < 4; ++i)
#pragma unroll
        for (int j = 0; j < 4; ++j)
#pragma unroll
            for (int r = 0; r < 4; ++r) slab[(16 * i + 4 * g + r) * 64 + 16 * j + c16] = acc[i][j][r];
    __syncthreads();
    const int row = tid >> 3, c8 = tid & 7;
    f32x4 s0 = (f32x4){0.f, 0.f, 0.f, 0.f}, s1 = s0;
#pragma unroll
    for (int ww = 0; ww < 8; ++ww) { LAS const float* p = (LAS const float*)(F.lds + ww * 16384) + row * 64 + c8 * 8; s0 = s0 + *(LAS const f32x4*)p; s1 = s1 + *(LAS const f32x4*)(p + 4); }
    v[0] = s0[0]; v[1] = s0[1]; v[2] = s0[2]; v[3] = s0[3]; v[4] = s1[0]; v[5] = s1[1]; v[6] = s1[2]; v[7] = s1[3];
}

constexpr int N_PHASES = 11;
__global__ void __launch_bounds__(NTHREADS, 2) fwd_kernel(Args args) {
    extern __shared__ __attribute__((aligned(16))) unsigned char lds_raw[];
    Frame F;
    F.lds = (LAS unsigned char*)lds_raw;
    F.tid = threadIdx.x; F.lane = F.tid & 63; F.wave = __builtin_amdgcn_readfirstlane(F.tid >> 6);
    F.G = gridDim.x; { const int bx = blockIdx.x; F.vcu = (F.G % 8 == 0) ? (bx % 8) * (F.G / 8) + bx / 8 : bx; }
    F.ws = args.ws; F.out = args.out;
    unsigned* ctl = (unsigned*)(args.ws + WS_CTL);
    volatile LAS unsigned* MISC = (volatile LAS unsigned*)(F.lds + MISC_OFF);
    for (int u = F.tid; u < (LDS_BYTES - LDSCTL_OFF) / 4; u += NTHREADS) ((LAS unsigned*)(F.lds + LDSCTL_OFF))[u] = 0u;
    __syncthreads();
    XcdBarrier bar; bar.bar = ctl + CW_BAR; bar.x = 0; bar.st = nullptr;
#if !MK_PER_PHASE
    bar = xcd_barrier_post(ctl + CW_BAR, MISC + 8);
#define GRID_BAR() xcd_barrier(bar)
#else
#define GRID_BAR() do {} while (0)
#endif
    const int lo = args.ph_lo, hi = args.ph_hi;
#define IN(k) (lo <= (k) && (k) < hi)
#define BOTH(k) (IN(k) && IN((k) + 1))

    if (IN(0)) { for (int rep = 0; rep < NREP(0); ++rep) { p0_prologue(F, args); if (BOTH(0)) GRID_BAR(); } }
    if (IN(1)) {
        unsigned char* ws = args.ws;
        {
            pg8::SegOrder S; S.nseg = 1; S.G = F.G; S.c = (int)blockIdx.x; S.dup = 1;
            S.s[0] = pg8::Seg{(const char*)(ws + WS_XB), (const char*)(ws + WS_WIN), M / 256, NPROJ / 256, 0, (M / 256) * (NPROJ / 256), (size_t)256 * 1024 * 2, (size_t)256 * 1024 * 2};
            S.total = S.s[0].count; S.dup = DIAG_DUP_G1;
            EpiProj E{ws, args.out};
            pg8::gemm_phase<EpiProj, pg8::SegOrder>(F.lds, 1024, 1024, 1024, S, E);
        }
        {
            pg8::WqlOrder S{(const char*)(ws + WS_WUKB), (const char*)(ws + WS_BQL), F.G, (int)blockIdx.x};
            bf16_t* wq = (bf16_t*)(ws + WS_WQL); EpiStore E{wq, wq, wq, wq, 512, 512, 512, 512};
            pg8::gemm_phase<EpiStore, pg8::WqlOrder>(F.lds, 256, 2048, 256, S, E);
        }
        if (BOTH(1)) GRID_BAR();
    }
    if (IN(2)) { p1b_rows(F, args);
        {
            const int gt = F.vcu * NTHREADS + F.tid, NGT = F.G * NTHREADS; const float* part = (const float*)(args.ws + WS_GWP); float* gwv = (float*)(args.ws + WS_GW); float* stz = (float*)(args.ws + WS_ST);
            for (int i = gt; i < 2 * 4096; i += NGT) { const int n = i & 4095, wh = i >> 12; float a = 0.f;
#pragma unroll 8
                for (int ks = 0; ks < 32; ++ks) a += part[(ks * 2 + wh) * 4096 + n];
                gwv[i] = a; }
            for (int i = gt; i < M * 2; i += NGT) stz[i] = 0.f;
        }
        for (int item = F.vcu; item < (M / 64) * 8; item += F.G) conv_item(F, args, item);
        if (BOTH(2)) GRID_BAR(); }
    if (IN(3)) {
        unsigned char* ws = args.ws;
        for (int item = F.vcu; item < 1280 + (DIAG_DUP_SSD == 2 ? 1280 : DIAG_DUP_SSD == 3 ? 256 : DIAG_DUP_SSD == 4 ? 1024 : 0); item += F.G) ssd_item(F, args, item < 1280 ? item : (DIAG_DUP_SSD == 4 ? item - 1024 : item - 1280));
        {
            pg8::SegOrder S; S.nseg = 4; S.G = F.G; S.c = (int)blockIdx.x; S.dup = DIAG_DUP_G2;
            const size_t pt = (size_t)256 * 512 * 2;
            S.s[0] = pg8::Seg{(const char*)(ws + WS_QAN), (const char*)(ws + WS_WQ), M / 256, 12, 0, (M / 256) * 12, pt, pt};
            S.s[1] = pg8::Seg{(const char*)(ws + WS_CKVN), (const char*)(ws + WS_WUK), MP / 256, 8, 816, 512, pt, pt};
            S.s[2] = pg8::Seg{(const char*)(ws + WS_CKVN), (const char*)(ws + WS_WUV), MP / 256, 8, 1328, 512, pt, pt};
            S.s[3] = pg8::Seg{(const char*)(ws + WS_QAN) + (size_t)MP * 512 * 2, (const char*)(ws + WS_WQL), MS / 256, 32, 1840, 128, pt, pt};
            S.total = 1968;
            EpiStore E{(bf16_t*)(ws + WS_Q), (bf16_t*)(ws + WS_KN), (bf16_t*)(ws + WS_V), (bf16_t*)(ws + WS_QLAT), 3072, 2048, 2048, 8192};
            pg8::gemm_phase<EpiStore, pg8::SegOrder>(F.lds, 512, 512, 512, S, E);
        }
        if (BOTH(3)) GRID_BAR();
    }
    if (IN(4)) for (int rep = 0; rep < NREP(4); ++rep) {
        constexpr int NNORM = M / 64;
        const int NITEMS = 128 + NNORM + 1024;
        const bool pin_mode = F.G >= 256;
        bool pinned = pin_mode && (F.vcu & 1) == 0 && (F.vcu >> 1) < 128;
        for (;;) {
            __syncthreads();
            if (F.tid == 0) MISC[0] = pinned ? (unsigned)(F.vcu >> 1) : (pin_mode ? 128u : 0u) + __hip_atomic_fetch_add(ctl + CW_QUEUE + 64 * rep, 1u, __ATOMIC_RELAXED, __HIP_MEMORY_SCOPE_AGENT);
            __syncthreads();
            pinned = false;
            const int item = (int)MISC[0];
            if (item >= NITEMS) break;
            if (item < 128) attn_sample_item<0>(F, item >> 2, item & 3);
            else if (item < 128 + NNORM) yz_norm_item(F, args.in[13], item - 128);
            else { const int j = item - 128 - NNORM, qb = 7 - (j >> 7), bh = j & 127; attn_prompt_unit<0>(F, bh >> 4, bh & 15, qb); }
        }
        if (BOTH(4)) GRID_BAR();
    }
    if (IN(5)) for (int rep = 0; rep < NREP(5); ++rep) {
        unsigned char* ws = args.ws;
        MixOrder S{(const char*)(ws + WS_YZ), (const char*)(ws + WS_WSSM), (const char*)(ws + WS_O), (const char*)(ws + WS_WMLA), F.G, (int)blockIdx.x};
        EpiMix E{(const bf16_t*)(ws + WS_G), args.in[7], (float*)(ws + WS_T1), (bf16_t*)(ws + WS_U)};
        pg8::gemm_phase<EpiMix, MixOrder>(F.lds, 2048, 2048, 2048, S, E);
        for (int tile = F.vcu; tile < 256; tile += F.G) {
            const int rt = tile >> 4, ctile = tile & 15, row = MP + rt * 64 + (F.tid >> 3), col = ctile * 64 + (F.tid & 7) * 8;
            const bf16_t* gp = (const bf16_t*)(ws + WS_G) + (size_t)row * 2048 + col; const float* bg = args.in[7] + col;
            float v[8], r1[8];
            sgemm_tile(F, (const bf16_t*)(ws + WS_YZ) + (size_t)(MP + rt * 64) * 2048, 2048, (const bf16_t*)(ws + WS_WSSM) + (size_t)(ctile * 64) * 2048, 2048, 2048, v);
            { const u32x4 gv = *(const u32x4*)gp;
#pragma unroll
              for (int e = 0; e < 8; ++e) { const float gg = (e & 1) ? bfhi(gv[e >> 1]) : bflo(gv[e >> 1]); r1[e] = sigmoidf_(gg + bg[e]) * v[e]; } }
            sgemm_tile(F, (const bf16_t*)(ws + WS_O) + (size_t)(MP + rt * 64) * 2048, 2048, (const bf16_t*)(ws + WS_WMLA) + (size_t)(ctile * 64) * 2048, 2048, 2048, v);
            { const u32x4 gv = *(const u32x4*)(gp + 1024);
#pragma unroll
              for (int e = 0; e < 8; ++e) { const float gg = (e & 1) ? bfhi(gv[e >> 1]) : bflo(gv[e >> 1]); r1[e] += sigmoidf_(gg + bg[1024 + e]) * v[e]; } }
            *(u32x4*)((bf16_t*)(ws + WS_U) + (size_t)row * 1024 + col) = (u32x4){pk2(r1[0], r1[1]), pk2(r1[2], r1[3]), pk2(r1[4], r1[5]), pk2(r1[6], r1[7])};
        }
        if (BOTH(5)) GRID_BAR();
    }
    if (IN(6)) for (int rep = 0; rep < NREP(6); ++rep) {
        unsigned char* ws = args.ws;
        pg8::SegOrder S; S.nseg = 1; S.G = F.G; S.c = (int)blockIdx.x; S.dup = 1;
        S.s[0] = pg8::Seg{(const char*)(ws + WS_U), (const char*)(ws + WS_WOUT), MP / 256, 4, 0, (MP / 256) * 4, (size_t)256 * 1024 * 2, (size_t)256 * 1024 * 2}; S.total = S.s[0].count;
        EpiV1 E{args.in[0], (bf16_t*)(ws + WS_HB), (float*)(ws + WS_ST)};
        pg8::gemm_phase<EpiV1, pg8::SegOrder>(F.lds, 1024, 1024, 1024, S, E);
        for (int tile = F.vcu; tile < 256; tile += F.G) {
            const int rt = tile >> 4, ctile = tile & 15, row = MP + rt * 64 + (F.tid >> 3), col = ctile * 64 + (F.tid & 7) * 8;
            float v[8];
            sgemm_tile(F, (const bf16_t*)(ws + WS_U) + (size_t)(MP + rt * 64) * 1024, 1024, (const bf16_t*)(ws + WS_WOUT) + (size_t)(ctile * 64) * 1024, 1024, 1024, v);
            const float* xr = args.in[1] + (size_t)(row - MP) * 1024 + col; const f32x4 x0 = *(const f32x4*)xr, x1 = *(const f32x4*)(xr + 4);
            const f32x4 a = (f32x4){x0[0] * ALPHA + v[0], x0[1] * ALPHA + v[1], x0[2] * ALPHA + v[2], x0[3] * ALPHA + v[3]}, b = (f32x4){x1[0] * ALPHA + v[4], x1[1] * ALPHA + v[5], x1[2] * ALPHA + v[6], x1[3] * ALPHA + v[7]};
            *(u32x4*)((bf16_t*)(ws + WS_HB) + (size_t)row * 1024 + col) = (u32x4){pk2(a[0], a[1]), pk2(a[2], a[3]), pk2(b[0], b[1]), pk2(b[2], b[3])};
            float s1 = ((a[0] + a[1]) + (a[2] + a[3])) + ((b[0] + b[1]) + (b[2] + b[3]));
            float s2 = ((a[0] * a[0] + a[1] * a[1]) + (a[2] * a[2] + a[3] * a[3])) + ((b[0] * b[0] + b[1] * b[1]) + (b[2] * b[2] + b[3] * b[3]));
            s1 += __shfl_xor(s1, 1); s1 += __shfl_xor(s1, 2); s1 += __shfl_xor(s1, 4); s2 += __shfl_xor(s2, 1); s2 += __shfl_xor(s2, 2); s2 += __shfl_xor(s2, 4);
            if ((F.tid & 7) == 0) { float* stp = (float*)(ws + WS_ST) + 2 * (size_t)row; atomicAdd(stp, s1); atomicAdd(stp + 1, s2); }
        }
        if (BOTH(6)) GRID_BAR();
    }
    if (IN(8)) for (int rep = 0; rep < NREP(8); ++rep) {
        unsigned char* ws = args.ws;
        pg8::SegOrder S; S.nseg = 1; S.G = F.G; S.c = (int)blockIdx.x; S.dup = 1;
        S.s[0] = pg8::Seg{(const char*)(ws + WS_HB), (const char*)(ws + WS_WUP), M / 256, 16, 0, (M / 256) * 16, (size_t)256 * 1024 * 2, (size_t)256 * 1024 * 2}; S.total = S.s[0].count;
        EpiRelu2 E{(bf16_t*)(ws + WS_A1), (const float*)(ws + WS_ST), (const float*)(ws + WS_GW)};
        pg8::gemm_phase<EpiRelu2, pg8::SegOrder>(F.lds, 1024, 1024, 1024, S, E);
        if (BOTH(8)) GRID_BAR();
    }
    if (IN(9)) for (int rep = 0; rep < NREP(9); ++rep) {
        unsigned char* ws = args.ws;
        pg8::SegOrder S; S.nseg = 1; S.G = F.G; S.c = (int)blockIdx.x; S.dup = 1;
        S.s[0] = pg8::Seg{(const char*)(ws + WS_A1), (const char*)(ws + WS_WDOWN), MP / 256, 4, 0, (MP / 256) * 4, (size_t)256 * 4096 * 2, (size_t)256 * 4096 * 2}; S.total = S.s[0].count;
        EpiV2 E{(const bf16_t*)(ws + WS_HB), (const float*)(ws + WS_ST), args.in[22], args.in[23], (bf16_t*)(ws + WS_V2)};
        pg8::gemm_phase<EpiV2, pg8::SegOrder>(F.lds, 4096, 4096, 4096, S, E);
        for (int tile = F.vcu; tile < 256; tile += F.G) {
            const int rt = tile >> 4, ctile = tile & 15, row = MP + rt * 64 + (F.tid >> 3), col = ctile * 64 + (F.tid & 7) * 8;
            float v[8];
            sgemm_tile(F, (const bf16_t*)(ws + WS_A1) + (size_t)(MP + rt * 64) * 4096, 4096, (const bf16_t*)(ws + WS_WDOWN) + (size_t)(ctile * 64) * 4096, 4096, 4096, v);
            const u32x4 xv = *(const u32x4*)((const bf16_t*)(ws + WS_HB) + (size_t)row * 1024 + col); const f32x4 x0 = (f32x4){bflo(xv[0]), bfhi(xv[0]), bflo(xv[1]), bfhi(xv[1])}, x1 = (f32x4){bflo(xv[2]), bfhi(xv[2]), bflo(xv[3]), bfhi(xv[3])};
            const f32x2 ss = *(const f32x2*)((const float*)(ws + WS_ST) + 2 * (size_t)row); const float mu = ss.x * (1.f / 1024.f), rs = 1.0f / sqrtf(ss.y * (1.f / 1024.f) - mu * mu + LN_EPS);
            const f32x4 g0 = *(const f32x4*)(args.in[22] + col), g1v = *(const f32x4*)(args.in[22] + col + 4), b0 = *(const f32x4*)(args.in[23] + col), b1v = *(const f32x4*)(args.in[23] + col + 4);
            const f32x4 h0 = (x0 - mu) * rs * g0 + b0, h1 = (x1 - mu) * rs * g1v + b1v;
            *(u32x4*)((bf16_t*)(ws + WS_V2) + (size_t)row * 1024 + col) = (u32x4){pk2(h0[0] * ALPHA + v[0], h0[1] * ALPHA + v[1]), pk2(h0[2] * ALPHA + v[2], h0[3] * ALPHA + v[3]), pk2(h1[0] * ALPHA + v[4], h1[1] * ALPHA + v[5]), pk2(h1[2] * ALPHA + v[6], h1[3] * ALPHA + v[7])};
        }
        if (BOTH(9)) GRID_BAR();
    }
    if (IN(10)) { ln_rows<true>(F, (const void*)(args.ws + WS_V2), args.in[26], args.in[27], nullptr, nullptr); }
#undef IN
#undef BOTH
}

extern "C" void kernel_launch(void* const* d_in, const int* in_sizes, int n_in, void* d_out, int out_size, void* d_ws, size_t ws_size, hipStream_t stream) {
    static int grid = 0;
    if (grid == 0) {
        int dev = 0, cus = 0;
        if (hipGetDevice(&dev) != hipSuccess || hipDeviceGetAttribute(&cus, hipDeviceAttributeMultiprocessorCount, dev) != hipSuccess) { fprintf(stderr, "kernel_launch: device query failed\n"); grid = -1; return; }
        if (hipFuncSetAttribute((const void*)fwd_kernel, hipFuncAttributeMaxDynamicSharedMemorySize, LDS_BYTES) != hipSuccess) { fprintf(stderr, "kernel_launch: hipFuncSetAttribute failed\n"); grid = -1; return; }
        int per_cu = 0;
        (void)hipOccupancyMaxActiveBlocksPerMultiprocessor(&per_cu, (const void*)fwd_kernel, NTHREADS, LDS_BYTES);
        (void)hipGetLastError();
        if (ws_size < WS_END) { fprintf(stderr, "kernel_launch: workspace too small (%zu < %zu)\n", ws_size, (size_t)WS_END); grid = -1; return; }
        grid = cus;
    }
    if (grid < 0) return;
    (void)hipMemsetAsync((char*)d_ws + WS_CTL, 0, CTL_ZERO_BYTES, stream);
    Args a{};
    for (int i = 0; i < 28; ++i) a.in[i] = (const float*)d_in[i];
    a.out = (float*)d_out; a.ws = (unsigned char*)d_ws;
#if MK_PER_PHASE
    for (int p = 0; p < N_PHASES; ++p) { a.ph_lo = p; a.ph_hi = p + 1; hipLaunchKernelGGL(fwd_kernel, dim3(grid), dim3(NTHREADS), LDS_BYTES, stream, a); }
#else
    a.ph_lo = 0; a.ph_hi = N_PHASES; hipLaunchKernelGGL(fwd_kernel, dim3(grid), dim3(NTHREADS), LDS_BYTES, stream, a);
#endif
}
```

```cpp
#include <hip/hip_runtime.h>
#include <cstdio>
#include <cstdint>

#ifndef MK_PER_PHASE
#define MK_PER_PHASE 0
#endif

#ifndef DIAG_REP
#define DIAG_REP 0
#endif
#ifndef DIAG_DUP_G1
#define DIAG_DUP_G1 1
#define DIAG_DUP_G2 1
#define DIAG_DUP_SSD 1
#define DIAG_DUP_ATT 0
#define DIAG_SMODE 0
#define DIAG_PMODE 0
#endif
#define NREP(k) (((DIAG_REP >> (k)) & 1) ? 2 : 1)
#define LAS __attribute__((address_space(3)))
#define GAS __attribute__((address_space(1)))
typedef unsigned short bf16_t;
typedef short bf16x8 __attribute__((ext_vector_type(8)));
typedef float f32x4 __attribute__((ext_vector_type(4)));
typedef float f32x2 __attribute__((ext_vector_type(2)));
typedef unsigned u32x4 __attribute__((ext_vector_type(4)));
typedef unsigned u32x2 __attribute__((ext_vector_type(2)));

constexpr int D_MODEL = 1024, BATCH = 8, SEQ = 2048, DEC_BATCH = 32, DEC_SEQ = 32, PAST = 4096;
constexpr int MP = BATCH * SEQ, MS = DEC_BATCH * DEC_SEQ, M = MP + MS;
constexpr int D_INNER = 2048, NHEADS = 32, HDIM = 64, NGROUPS = 8, NSTATE = 128, CONV_DIM = 4096;
constexpr int MLA_H = 16, QK_NOPE = 128, QK_ROPE = 64, V_HEAD = 128, Q_RANK = 512, KV_RANK = 512, QHD = 192;
constexpr int D_FF = 4096, IN_COLS = 9312, NPROJ = 9472;
constexpr float RMS_EPS = 1e-6f, LN_EPS = 1e-5f;
constexpr float ALPHA = 1.189207115002721f;
constexpr int SMALL_LD = 1280;

constexpr size_t O_YP = 0, O_YS = 16777216, O_CKVP = 17825792, O_KPEP = 26214400, O_SSMP = 27262976, O_CONVP = 29360128,
                 O_CKVS = 29458432, O_KPES = 29982720, O_SSMS = 30048256, O_CONVS = 38436864;

constexpr size_t MiB = 1u << 20;
constexpr size_t WS_CTL = 0, CTL_ZERO_BYTES = 1 * MiB;
constexpr size_t WS_ROPE = 1 * MiB;
constexpr size_t WS_WIN = 2 * MiB, WS_WQ = 21 * MiB, WS_WUK = 24 * MiB, WS_WUV = 26 * MiB, WS_BQL = 28 * MiB, WS_WUKB = 32 * MiB,
                 WS_WQL = 35 * MiB, WS_WSSM = 43 * MiB, WS_WMLA = 47 * MiB, WS_WOUT = 51 * MiB, WS_WUP = 53 * MiB, WS_WDOWN = 61 * MiB;
constexpr size_t WS_XBC = 72 * MiB;
constexpr size_t WS_Z = 208 * MiB;
constexpr size_t WS_G = 276 * MiB;
constexpr size_t WS_SMALL = 344 * MiB;
constexpr size_t WS_KN = 344 * MiB, WS_V = 408 * MiB;
constexpr size_t WS_XB = 472 * MiB;
constexpr size_t WS_QAN = 987 * MiB, WS_CKVN = 1004 * MiB;
constexpr size_t WS_Q = 506 * MiB;
constexpr size_t WS_U = 506 * MiB, WS_HB = 540 * MiB;
constexpr size_t WS_QLAT = 608 * MiB;
constexpr size_t WS_YZ = 624 * MiB;
constexpr size_t WS_O = 692 * MiB;
constexpr size_t WS_KPER = 760 * MiB, WS_DT = 763 * MiB, WS_SSQ = 766 * MiB;
constexpr size_t WS_CACHE = 769 * MiB;
constexpr int KVLEN = PAST + DEC_SEQ;
constexpr size_t WS_XACT = 692 * MiB;
constexpr size_t WS_BCACT = 916 * MiB;
constexpr size_t WS_GWP = 984 * MiB;
constexpr size_t WS_GW = 985 * MiB;
constexpr size_t WS_ST = 986 * MiB;
constexpr size_t WS_END = 1021 * MiB;
constexpr size_t WS_A1 = WS_XBC, WS_T1 = WS_Z, WS_V2 = WS_Z, WS_HF = WS_G;

constexpr int CW_BAR = 4096;
constexpr int CW_QUEUE = 16384;

constexpr int LDS_BYTES = 147456;
constexpr int LDSCTL_OFF = LDS_BYTES - 512, MISC_OFF = LDSCTL_OFF + 320;
constexpr int NWAVES = 8, NTHREADS = 512;

#define LDS_WAIT() asm volatile("s_waitcnt lgkmcnt(0)" ::: "memory")
#define VM_WAIT() asm volatile("s_waitcnt vmcnt(0)" ::: "memory")
__device__ __forceinline__ unsigned f2bf(float f) { unsigned u = __builtin_bit_cast(unsigned, f); return (u + 0x7fffu + ((u >> 16) & 1u)) >> 16; }
__device__ __forceinline__ unsigned pk2(float lo, float hi) { return f2bf(lo) | (f2bf(hi) << 16); }
__device__ __forceinline__ float bf2f(unsigned short b) { return __builtin_bit_cast(float, (unsigned)b << 16); }
__device__ __forceinline__ float bflo(unsigned w) { return __builtin_bit_cast(float, w << 16); }
__device__ __forceinline__ float bfhi(unsigned w) { return __builtin_bit_cast(float, w & 0xffff0000u); }
__device__ __forceinline__ float wave_sum(float v) {
#pragma unroll
    for (int o = 1; o < 64; o <<= 1) v += __shfl_xor(v, o);
    return v;
}
__device__ __forceinline__ float sigmoidf_(float x) { return __builtin_amdgcn_rcpf(1.f + __builtin_amdgcn_exp2f(-1.4426950408889634f * x)); }
__device__ __forceinline__ float siluf_(float x) { return x * __builtin_amdgcn_rcpf(1.f + __builtin_amdgcn_exp2f(-1.4426950408889634f * x)); }

namespace pg8 {
constexpr int BM = 256, BK = 64, HALF = 128, HTB = HALF * BK * 2, STAGE_BYTES = 8 * HTB;
__host__ __device__ __forceinline__ int lds_byte(int r, int c) { const int st = (r >> 4) * 2 + (c >> 5), rr = r & 15, cc = c & 31, ob = rr * 64 + cc * 2; return st * 1024 + (ob ^ (((ob >> 9) & 1) << 5)); }
__host__ __device__ __forceinline__ void stage_rc(int b, int& R, int& C) { const int st = b / 1024, sb = b % 1024, swz = sb ^ (((sb >> 9) & 1) << 5); R = (st >> 1) * 16 + swz / 64; C = (st & 1) * 32 + (swz % 64) / 2; }
__host__ __device__ __forceinline__ int perm32(int rho) { const int n = rho >> 4, i = rho & 15; return 8 * (i >> 2) + 4 * n + (i & 3); }

struct Unit { const char* a; const char* b; int pm, pn, seg; };

__device__ __forceinline__ unsigned cvt_pk_bf16(float lo, float hi) { unsigned r; asm volatile("v_cvt_pk_bf16_f32 %0, %1, %2" : "=v"(r) : "v"(lo), "v"(hi)); return r; }

template <class Epi, class Sched>
__device__ __forceinline__ void gemm_phase(LAS unsigned char* lds, const int K, const int lda, const int ldb, const Sched& S, const Epi& E) {
    const int tid = threadIdx.x, wid = __builtin_amdgcn_readfirstlane(tid >> 6), lane = tid & 63, wr = wid >> 2, wc = wid & 3, fr = lane & 15, fq = lane >> 4;
    const int nt = K / BK;
    unsigned voffA[2], voffB[2];
#pragma unroll
    for (int i = 0; i < 2; ++i) { int R, C; stage_rc(tid * 16 + i * 8192, R, C); const int Rb = Epi::PERM ? ((R & ~31) + perm32(R & 31)) : R;
        voffA[i] = (unsigned)(R * lda + C) * 2u; voffB[i] = (unsigned)(Rb * ldb + C) * 2u; }
    const size_t kstep = (size_t)(BK * 2);
    const size_t hstepA = (size_t)HALF * lda * 2, hstepB = (size_t)HALF * ldb * 2;
    const unsigned ldsw = (unsigned)wid * 1024u;
    const int aoff = lds_byte(wr * 64 + fr, fq * 8), boff = lds_byte(wc * 32 + fr, fq * 8);
#define PG8_SA(b, h) (((b) * 2 + (h)) * HTB)
#define PG8_SB(b, h) ((4 + (b) * 2 + (h)) * HTB)
#define PG8_STAGE(bufoff, gbase, voff) do { _Pragma("unroll") for (int _i = 0; _i < 2; ++_i) \
        __builtin_amdgcn_global_load_lds((const unsigned*)((const char*)(gbase) + (voff)[_i]), (LAS unsigned*)(lds + (bufoff) + ldsw + _i * 8192), 16, 0, 0); } while (0)
#define PG8_LDA(dst, b, h) do { _Pragma("unroll") for (int m = 0; m < 4; ++m) _Pragma("unroll") for (int k = 0; k < 2; ++k) dst[m][k] = *(const LAS bf16x8*)(lds + PG8_SA(b, h) + aoff + m * 2048 + k * 1024); } while (0)
#define PG8_LDB(dst, b, h) do { _Pragma("unroll") for (int n = 0; n < 2; ++n) _Pragma("unroll") for (int k = 0; k < 2; ++k) dst[n][k] = *(const LAS bf16x8*)(lds + PG8_SB(b, h) + boff + n * 2048 + k * 1024); } while (0)
#define PG8_MMA(ai, bj, At, Bt) do { __builtin_amdgcn_s_setprio(1); _Pragma("unroll") for (int m = 0; m < 4; ++m) _Pragma("unroll") for (int n = 0; n < 2; ++n) _Pragma("unroll") for (int k = 0; k < 2; ++k) \
        acc[ai][bj][m][n] = __builtin_amdgcn_mfma_f32_16x16x32_bf16(Bt[n][k], At[m][k], acc[ai][bj][m][n], 0, 0, 0); __builtin_amdgcn_s_setprio(0); } while (0)
#define PG8_WAIT_V(n) asm volatile("s_waitcnt vmcnt(" #n ")" ::: "memory")
#define PG8_WAIT_L(n) asm volatile("s_waitcnt lgkmcnt(" #n ")" ::: "memory")
#define PG8_BAR __builtin_amdgcn_s_barrier()
#define PG8_SCHED __builtin_amdgcn_sched_barrier(0)
    Unit cur, nxt; int ui = 0;
    if (!S.next(0, cur)) return;
    f32x4 acc[2][2][4][2];
#pragma unroll
    for (int a = 0; a < 2; ++a)
#pragma unroll
        for (int b = 0; b < 2; ++b)
#pragma unroll
            for (int m = 0; m < 4; ++m)
#pragma unroll
                for (int n = 0; n < 2; ++n) acc[a][b][m][n] = (f32x4){0.f, 0.f, 0.f, 0.f};
    bf16x8 At[4][2], B0[2][2], B1[2][2];
    const char* cA = cur.a; const char* cB = cur.b;
    PG8_STAGE(PG8_SB(0, 0), cB, voffB); PG8_STAGE(PG8_SB(0, 1), cB + hstepB, voffB); PG8_STAGE(PG8_SA(0, 0), cA, voffA); PG8_STAGE(PG8_SA(0, 1), cA + hstepA, voffA);
    if (wr == 1) PG8_BAR;
    PG8_WAIT_V(2); PG8_BAR;
    PG8_STAGE(PG8_SB(1, 0), cB + kstep, voffB); PG8_STAGE(PG8_SA(1, 0), cA + kstep, voffA); PG8_STAGE(PG8_SB(1, 1), cB + hstepB + kstep, voffB);
    PG8_WAIT_V(6); PG8_BAR;
    for (;;) {
        const bool has_next = S.next(ui + 1, nxt);
        const char* nA = has_next ? nxt.a : cA; const char* nB = has_next ? nxt.b : cB;
#pragma unroll 1
        for (int t = 0; t < nt; t += 2) {
            const bool last = (t == nt - 2);
            const char* a1 = cA + (size_t)(t + 1) * kstep;
            const char* a2 = last ? nA : cA + (size_t)(t + 2) * kstep; const char* b2 = last ? nB : cB + (size_t)(t + 2) * kstep;
            const char* a3 = a2 + kstep; const char* b3 = b2 + kstep;
            PG8_LDB(B0, 0, 0); PG8_LDB(B1, 0, 1); PG8_SCHED; PG8_LDA(At, 0, 0); PG8_STAGE(PG8_SA(1, 1), a1 + hstepA, voffA);
            PG8_WAIT_V(8); PG8_WAIT_L(0); PG8_BAR; PG8_MMA(0, 0, At, B0); PG8_MMA(0, 1, At, B1); PG8_BAR; PG8_SCHED;
            PG8_LDA(At, 0, 1); PG8_STAGE(PG8_SB(0, 0), b2, voffB); PG8_STAGE(PG8_SB(0, 1), b2 + hstepB, voffB); PG8_STAGE(PG8_SA(0, 0), a2, voffA);
            PG8_WAIT_V(8); PG8_WAIT_L(0); PG8_BAR; PG8_MMA(1, 0, At, B0); PG8_MMA(1, 1, At, B1); PG8_BAR; PG8_SCHED;
            PG8_LDB(B0, 1, 0); PG8_LDB(B1, 1, 1); PG8_SCHED; PG8_LDA(At, 1, 0); PG8_STAGE(PG8_SA(0, 1), a2 + hstepA, voffA);
            PG8_WAIT_V(8); PG8_WAIT_L(0); PG8_BAR; PG8_MMA(0, 0, At, B0); PG8_MMA(0, 1, At, B1); PG8_BAR; PG8_SCHED;
            PG8_LDA(At, 1, 1); PG8_STAGE(PG8_SB(1, 0), b3, voffB); PG8_STAGE(PG8_SB(1, 1), b3 + hstepB, voffB); PG8_STAGE(PG8_SA(1, 0), a3, voffA);
            PG8_WAIT_V(8); PG8_WAIT_L(0); PG8_BAR; PG8_MMA(1, 0, At, B0); PG8_MMA(1, 1, At, B1); PG8_BAR; PG8_SCHED;
        }
        if (wr == 0) PG8_BAR;
        E(acc, cur, wr, wc, fr, fq);
        if (!has_next) break;
#pragma unroll
        for (int a = 0; a < 2; ++a)
#pragma unroll
            for (int b = 0; b < 2; ++b)
#pragma unroll
                for (int m = 0; m < 4; ++m)
#pragma unroll
                    for (int n = 0; n < 2; ++n) acc[a][b][m][n] = (f32x4){0.f, 0.f, 0.f, 0.f};
        cur = nxt; cA = nA; cB = nB; ++ui;
        if (wr == 1) PG8_BAR;
    }
    PG8_WAIT_V(0);
    PG8_BAR;
#undef PG8_SA
#undef PG8_SB
#undef PG8_STAGE
#undef PG8_LDA
#undef PG8_LDB
#undef PG8_MMA
#undef PG8_WAIT_V
#undef PG8_WAIT_L
#undef PG8_BAR
#undef PG8_SCHED
}

struct Seg { const char* A; const char* B; int nM, nN, start, count; size_t a_tile, b_tile; };
struct SegOrder {
    Seg s[4]; int nseg, total, G, c, dup;
    __device__ __forceinline__ bool next(int i, Unit& u) const {
        int L = i * G + c; if (L >= total * dup) return false; if (L >= total) L -= total;
        int k = 0; const char* gA = s[0].A; const char* gB = s[0].B; int gnM = s[0].nM, gnN = s[0].nN, gstart = 0, nwg = s[0].count; size_t gat = s[0].a_tile, gbt = s[0].b_tile;
#pragma unroll
        for (int j = 1; j < 4; ++j) if (j < nseg && L >= s[j].start) { k = j; gA = s[j].A; gB = s[j].B; gnM = s[j].nM; gnN = s[j].nN; gstart = s[j].start; nwg = s[j].count; gat = s[j].a_tile; gbt = s[j].b_tile; }
        int wgid = L - gstart;
        { const int q = nwg / 8, r = nwg % 8, xcd = wgid % 8, off = wgid / 8; wgid = (xcd < r ? xcd * (q + 1) : r * (q + 1) + (xcd - r) * q) + off; }
        const int nig = 8 * gnN, gid = wgid / nig, fm = gid * 8, gsz = (gnM - fm) < 8 ? (gnM - fm) : 8;
        u.pm = fm + ((wgid % nig) % gsz); u.pn = (wgid % nig) / gsz; u.seg = k;
        u.a = gA + (size_t)u.pm * gat; u.b = gB + (size_t)u.pn * gbt; return true;
    }
};
struct WqlOrder {
    const char* A; const char* B; int G, c;
    __device__ __forceinline__ bool next(int i, Unit& u) const {
        const int L = i * G + c; if (L >= 64) return false;
        const int h = L >> 2, pm = (L >> 1) & 1, pn = L & 1;
        u.pm = h * 2 + pm; u.pn = pn; u.seg = 1;
        u.a = A + (size_t)pm * 256 * 2048 * 2 + (size_t)h * 128 * 2; u.b = B + (size_t)h * 512 * 256 * 2 + (size_t)pn * 256 * 256 * 2; return true;
    }
};
}

#define XB_TMO      128
#define XB_XCNT(j)  (256  + 64 * (j))
#define XB_XSUB(j)  (1280 + 64 * (j))
#define XB_XGEN(j)  (2304 + 64 * (j))
#define XB_TOP      3328
#define XB_TOPGEN   3392
#define XCD_BAR_WORDS 3456
#define XB_SPIN_CAP (1u << 18)
__device__ __forceinline__ unsigned xb_ld(unsigned* p)              { return __hip_atomic_load(p, __ATOMIC_RELAXED, __HIP_MEMORY_SCOPE_AGENT); }
__device__ __forceinline__ unsigned xb_add(unsigned* p, unsigned v) { return __hip_atomic_fetch_add(p, v, __ATOMIC_RELAXED, __HIP_MEMORY_SCOPE_AGENT); }
__device__ __forceinline__ unsigned xb_xcc_id() { return (unsigned)__builtin_amdgcn_s_getreg((3 << 11) | 20) & 0xFu; }
#define XB_SPIN(cond, bar) do { unsigned _sp = 0; while (cond) { __builtin_amdgcn_s_sleep(1); \
    if ((++_sp & 255u) == 0u) { if (xb_ld(&(bar)[XB_TMO])) break; if (_sp > XB_SPIN_CAP) { atomicAdd(&(bar)[XB_TMO], 1u); break; } } } } while (0)
struct XcdBarrier { unsigned* bar; unsigned x; volatile LAS unsigned* st; };
__device__ __forceinline__ XcdBarrier xcd_barrier_post(unsigned* bar, volatile LAS unsigned* st) {
    XcdBarrier b; b.bar = bar; b.x = xb_xcc_id(); b.st = st;
    if (threadIdx.x == 0) (void)xb_add(&bar[XB_XCNT(b.x)], 1u);
    return b;
}
__device__ __forceinline__ void xcd_barrier_complete(unsigned* bar, unsigned x, unsigned& nloc, unsigned& nx) {
    const unsigned G = gridDim.x * gridDim.y * gridDim.z;
    unsigned sum, cnt, mine, sp = 0u;
    for (;;) {
        sum = 0u; cnt = 0u; mine = 0u;
#pragma unroll
        for (unsigned j = 0; j < 16; ++j) { const unsigned c = xb_ld(&bar[XB_XCNT(j)]); sum += c; cnt += (c > 0u) ? 1u : 0u; mine = (j == x) ? c : mine; }
        if (sum == G) break;
        __builtin_amdgcn_s_sleep(1);
        if ((++sp & 255u) == 0u) { if (xb_ld(&bar[XB_TMO])) break; if (sp > XB_SPIN_CAP) { atomicAdd(&bar[XB_TMO], 1u); break; } }
    }
    nloc = mine > 0u ? mine : 1u; nx = cnt > 0u ? cnt : 1u;
}
__device__ __forceinline__ void xcd_barrier(const XcdBarrier& b) {
    asm volatile("s_waitcnt vmcnt(0)" ::: "memory");
    __syncthreads();
    if (threadIdx.x == 0) {
        unsigned* bar = b.bar;
        __builtin_amdgcn_s_waitcnt(0);
        unsigned nloc = b.st[0], nx = b.st[1];
        if (nloc == 0u) { xcd_barrier_complete(bar, b.x, nloc, nx); b.st[0] = nloc; b.st[1] = nx; }
        const unsigned old = xb_add(&bar[XB_XSUB(b.x)], 1u);
        const unsigned gen = old / nloc;
        if (old + 1u == (gen + 1u) * nloc) {
            __builtin_amdgcn_fence(__ATOMIC_RELEASE, "agent");
            asm volatile("s_waitcnt vmcnt(0)" ::: "memory");
            const unsigned og = xb_add(&bar[XB_TOP], 1u);
            const unsigned tg = og / nx;
            if (og + 1u == (tg + 1u) * nx) xb_add(&bar[XB_TOPGEN], 1u);
            else XB_SPIN(xb_ld(&bar[XB_TOPGEN]) == tg, bar);
            __builtin_amdgcn_fence(__ATOMIC_ACQUIRE, "agent");
            xb_add(&bar[XB_XGEN(b.x)], 1u);
            asm volatile("s_waitcnt vmcnt(0)" ::: "memory");
        } else {
            XB_SPIN(xb_ld(&bar[XB_XGEN(b.x)]) == gen, bar);
            __builtin_amdgcn_fence(__ATOMIC_ACQUIRE, "agent");
            asm volatile("s_waitcnt vmcnt(0)" ::: "memory");
        }
    }
    __syncthreads();
}

struct Args { const float* in[28]; float* out; unsigned char* ws; int ph_lo, ph_hi; };
struct Frame {
    LAS unsigned char* lds;
    int tid, lane, wave, vcu, G;
    unsigned char* ws; float* out;
};

__device__ __forceinline__ void p0_transpose_item(const float* W, int K, int N, bf16_t* WT, int ldt, int k0, int n0, int drow0, LAS float* scr, int lane, const float* kscale = nullptr) {
    float tv[32];
#pragma unroll
    for (int i = 0; i < 32; ++i) { const int kk = 2 * i + (lane >> 5); tv[i] = __builtin_nontemporal_load(W + (size_t)(k0 + kk) * N + n0 + (lane & 31)); }
#pragma unroll
    for (int i = 0; i < 32; ++i) { const int kk = 2 * i + (lane >> 5); scr[kk * 33 + (lane & 31)] = kscale ? tv[i] * kscale[k0 + kk] : tv[i]; }
    LDS_WAIT(); asm volatile("" ::: "memory");
    const int c = lane & 7;
#pragma unroll
    for (int j = 0; j < 4; ++j) { const int n = (lane >> 3) + 8 * j; const LAS float* s = scr + (8 * c) * 33 + n;
        u32x4 o; o.x = pk2(s[0 * 33], s[1 * 33]); o.y = pk2(s[2 * 33], s[3 * 33]); o.z = pk2(s[4 * 33], s[5 * 33]); o.w = pk2(s[6 * 33], s[7 * 33]);
        *(u32x4*)(WT + (size_t)(drow0 + n) * ldt + k0 + 8 * c) = o; }
    LDS_WAIT(); asm volatile("" ::: "memory");
}
__device__ __forceinline__ int win_dst_col(int n0) {
    if (n0 < 8192) return n0;
    if (n0 < 8224) return 9280 + (n0 - 8192);
    if (n0 < 8736) return 8192 + (n0 - 8224);
    if (n0 < 9248) return 8704 + (n0 - 8736);
    return 9216 + (n0 - 9248);
}
struct TItem { const float* W; int K, N; bf16_t* WT; int kind; };

__device__ __forceinline__ void p0_prologue(Frame& F, const Args& args) {
    LAS float* scr = (LAS float*)(F.lds + F.wave * 16384);
    const int gw = F.vcu * NWAVES + F.wave, NGW = F.G * NWAVES, lane = F.lane;
    unsigned char* ws = F.ws;
    {
        const float* Ws[9] = {args.in[6], args.in[16], args.in[18], args.in[19], args.in[14], args.in[20], args.in[21], args.in[24], args.in[25]};
        const int Ks[9] = {1024, 512, 512, 512, 2048, 2048, 1024, 1024, 4096};
        const int Ns[9] = {IN_COLS, 3072, 2048, 2048, 1024, 1024, 1024, 4096, 1024};
        const size_t Os[9] = {WS_WIN, WS_WQ, WS_WUK, WS_WUV, WS_WSSM, WS_WMLA, WS_WOUT, WS_WUP, WS_WDOWN};
        int base = 0;
#pragma unroll
        for (int w = 0; w < 9; ++w) {
            const int nblk = Ns[w] / 32, nitems = (Ks[w] / 64) * nblk;
            int first = gw - (base % NGW); if (first < 0) first += NGW;
            for (int it = first; it < nitems; it += NGW) {
                const int kb = it / nblk, nb = it % nblk, n0 = 32 * nb;
                const int drow0 = (w == 0) ? win_dst_col(n0) : n0;
                p0_transpose_item(Ws[w], Ks[w], Ns[w], (bf16_t*)(ws + Os[w]), Ks[w], 64 * kb, n0, drow0, scr, lane, (w == 7) ? args.in[22] : nullptr);
            }
            base += nitems;
        }
    }
    const int gt = F.vcu * NTHREADS + F.tid, NGT = F.G * NTHREADS;
    for (int i = gt; i < 20480; i += NGT) ((u32x4*)(ws + WS_WIN + (size_t)9312 * 1024 * 2))[i] = (u32x4){0u, 0u, 0u, 0u};
    {
        const f32x4* xp = (const f32x4*)args.in[0]; const f32x4* xs = (const f32x4*)args.in[1]; u32x4* xb = (u32x4*)(ws + WS_XB);
        const int n8p = MP * D_MODEL / 8, n8 = M * D_MODEL / 8;
        for (int i0 = gt; i0 < n8; i0 += 4 * NGT) {
            f32x4 a[4], b[4];
#pragma unroll
            for (int u = 0; u < 4; ++u) { const int i = i0 + u * NGT; const int ii = (i < n8) ? i : 0; const f32x4* src = (ii < n8p) ? xp + 2 * (size_t)ii : xs + 2 * (size_t)(ii - n8p); a[u] = __builtin_nontemporal_load(src); b[u] = __builtin_nontemporal_load(src + 1); }
#pragma unroll
            for (int u = 0; u < 4; ++u) { const int i = i0 + u * NGT; if (i < n8) xb[i] = (u32x4){pk2(a[u].x, a[u].y), pk2(a[u].z, a[u].w), pk2(b[u].x, b[u].y), pk2(b[u].z, b[u].w)}; }
        }
    }
    {
        const f32x4* src = (const f32x4*)args.in[18]; u32x4* dst = (u32x4*)(ws + WS_WUKB);
        for (int i = gt; i < 512 * 2048 / 8; i += NGT) { const f32x4 a = src[2 * (size_t)i], b = src[2 * (size_t)i + 1]; dst[i] = (u32x4){pk2(a.x, a.y), pk2(a.z, a.w), pk2(b.x, b.y), pk2(b.z, b.w)}; }
        for (int i = gt; i < 64; i += NGT) dst[512 * 2048 / 8 + i] = (u32x4){0u, 0u, 0u, 0u};
    }
    {
        const float* wq = args.in[16]; u32x4* dst = (u32x4*)(ws + WS_BQL);
        for (int i = gt; i < 16 * 512 * 32; i += NGT) {
            const int d8 = i & 31, r = (i >> 5) & 511, h = i >> 14;
            u32x4 o = (u32x4){0u, 0u, 0u, 0u};
            if (d8 < 16) { const f32x4* s = (const f32x4*)(wq + (size_t)r * 3072 + h * 192 + d8 * 8); const f32x4 a = s[0], b = s[1]; o = (u32x4){pk2(a.x, a.y), pk2(a.z, a.w), pk2(b.x, b.y), pk2(b.z, b.w)}; }
            dst[i] = o;
        }
    }
    {
        float* ct = (float*)(ws + WS_ROPE); float* st = ct + 2080 * 32;
        for (int i = gt; i < 2080 * 32; i += NGT) {
            const int p = i >> 5, j = i & 31; const float pos = (float)(p < 2048 ? p : 4096 + (p - 2048));
            const float inv = powf(10000.0f, -(float)(2 * j) / 64.0f); const float ang = pos * inv;
            ct[i] = cosf(ang); st[i] = sinf(ang);
        }
    }
    {
        const float* wup = args.in[24]; const float* g1 = args.in[22]; const float* b1 = args.in[23]; float* part = (float*)(ws + WS_GWP);
        for (int i = gt; i < 32 * 4096; i += NGT) { const int n = i & 4095, ks = i >> 12; float sg = 0.f, sb = 0.f;
#pragma unroll 8
            for (int k = 0; k < 32; ++k) { const float wv_ = wup[(size_t)(ks * 32 + k) * 4096 + n]; sg += bf2f((unsigned short)f2bf(g1[ks * 32 + k] * wv_)); sb += b1[ks * 32 + k] * wv_; }
            part[(ks * 2) * 4096 + n] = sg; part[(ks * 2 + 1) * 4096 + n] = sb; }
    }
}

struct EpiStore {
    static constexpr bool PERM = true;
    bf16_t *b0, *b1, *b2, *b3; int l0, l1, l2, l3;
    __device__ __forceinline__ void operator()(const f32x4 (&acc)[2][2][4][2], const pg8::Unit& u, int wr, int wc, int fr, int fq) const {
        bf16_t* b = (u.seg == 0) ? b0 : (u.seg == 1) ? b1 : (u.seg == 2) ? b2 : b3;
        const int ld = (u.seg == 0) ? l0 : (u.seg == 1) ? l1 : (u.seg == 2) ? l2 : l3;
        bf16_t* p = b + (size_t)(u.pm * 256 + wr * 64 + fr) * ld + u.pn * 256 + wc * 32 + 8 * fq;
#pragma unroll
        for (int ai = 0; ai < 2; ++ai)
#pragma unroll
            for (int m = 0; m < 4; ++m) { bf16_t* rowp = p + (size_t)(ai * 128 + m * 16) * ld;
#pragma unroll
                for (int bj = 0; bj < 2; ++bj) { const f32x4 v0 = acc[ai][bj][m][0], v1 = acc[ai][bj][m][1];
                    *(u32x4*)(rowp + bj * 128) = (u32x4){pg8::cvt_pk_bf16(v0[0], v0[1]), pg8::cvt_pk_bf16(v0[2], v0[3]), pg8::cvt_pk_bf16(v1[0], v1[1]), pg8::cvt_pk_bf16(v1[2], v1[3])}; } }
    }
};

struct EpiProj {
    static constexpr bool PERM = true;
    unsigned char* ws; float* out;
    __device__ __forceinline__ void operator()(const f32x4 (&acc)[2][2][4][2], const pg8::Unit& u, int wr, int wc, int fr, int fq) const {
        const int row0 = u.pm * 256 + wr * 64 + fr, colt = wc * 32 + 8 * fq;
        if (u.pn < 32) {
            bf16_t* base; int ldc, c0;
            if (u.pn < 8) { base = (bf16_t*)(ws + WS_G); ldc = 2048; c0 = u.pn * 256; }
            else if (u.pn < 16) { base = (bf16_t*)(ws + WS_Z); ldc = 2048; c0 = (u.pn - 8) * 256; }
            else { base = (bf16_t*)(ws + WS_XBC); ldc = 4096; c0 = (u.pn - 16) * 256; }
#pragma unroll
            for (int ai = 0; ai < 2; ++ai)
#pragma unroll
                for (int m = 0; m < 4; ++m) { const int row = row0 + ai * 128 + m * 16; bf16_t* rowp = base + (size_t)row * ldc + c0 + colt;
#pragma unroll
                    for (int bj = 0; bj < 2; ++bj) { const f32x4 v0 = acc[ai][bj][m][0], v1 = acc[ai][bj][m][1];
                        *(u32x4*)(rowp + bj * 128) = (u32x4){pg8::cvt_pk_bf16(v0[0], v0[1]), pg8::cvt_pk_bf16(v0[2], v0[3]), pg8::cvt_pk_bf16(v1[0], v1[1]), pg8::cvt_pk_bf16(v1[2], v1[3])}; } }
            if (u.pn >= 16 && ((u.pm & 7) == 7 || u.pm >= MP / 256)) {
#pragma unroll
                for (int ai = 0; ai < 2; ++ai)
#pragma unroll
                    for (int m = 0; m < 4; ++m) { const int row = row0 + ai * 128 + m * 16;
                        long off = -1;
                        if (row < MP) { const int t = row & 2047; if (t >= 2045) off = (long)O_CONVP + ((long)(row >> 11) * 3 + (t - 2045)) * 4096; }
                        else { const int q = (row - MP) & 31; if (q >= 29) off = (long)O_CONVS + ((long)((row - MP) >> 5) * 3 + (q - 29)) * 4096; }
                        if (off >= 0) { float* cp = out + off + c0 + colt;
#pragma unroll
                            for (int bj = 0; bj < 2; ++bj) { *(f32x4*)(cp + bj * 128) = acc[ai][bj][m][0]; *(f32x4*)(cp + bj * 128 + 4) = acc[ai][bj][m][1]; } } }
            }
        } else {
            bf16_t* base = (bf16_t*)(ws + WS_SMALL); const int c0 = (u.pn - 32) * 256;
#pragma unroll
            for (int ai = 0; ai < 2; ++ai)
#pragma unroll
                for (int m = 0; m < 4; ++m) { bf16_t* rowp = base + (size_t)(row0 + ai * 128 + m * 16) * SMALL_LD + c0 + colt;
#pragma unroll
                    for (int bj = 0; bj < 2; ++bj) { const f32x4 v0 = acc[ai][bj][m][0], v1 = acc[ai][bj][m][1];
                        *(u32x4*)(rowp + bj * 128) = (u32x4){pg8::cvt_pk_bf16(v0[0], v0[1]), pg8::cvt_pk_bf16(v0[2], v0[3]), pg8::cvt_pk_bf16(v1[0], v1[1]), pg8::cvt_pk_bf16(v1[2], v1[3])}; } }
        }
    }
};

__device__ __forceinline__ void p1b_rows(Frame& F, const Args& args) {
    const int gw = F.vcu * NWAVES + F.wave, NGW = F.G * NWAVES, lane = F.lane;
    unsigned char* ws = F.ws;
    const float* gq = args.in[15]; const float* gkv = args.in[17]; const float* dtb = args.in[10];
    const float* ct = (const float*)(ws + WS_ROPE); const float* st = ct + 2080 * 32;
    const f32x4 gq0 = *(const f32x4*)(gq + 4 * lane), gq1 = *(const f32x4*)(gq + 256 + 4 * lane);
    const f32x4 gk0 = *(const f32x4*)(gkv + 4 * lane), gk1 = *(const f32x4*)(gkv + 256 + 4 * lane);
    for (int m = gw; m < M; m += NGW) {
        const bf16_t* srow = (const bf16_t*)(ws + WS_SMALL) + (size_t)m * SMALL_LD;
        const u32x2 tq0 = __builtin_nontemporal_load((const u32x2*)(srow + 4 * lane)), tq1 = __builtin_nontemporal_load((const u32x2*)(srow + 256 + 4 * lane));
        const u32x2 tk0 = __builtin_nontemporal_load((const u32x2*)(srow + 512 + 4 * lane)), tk1 = __builtin_nontemporal_load((const u32x2*)(srow + 768 + 4 * lane));
        const f32x4 q0 = (f32x4){bflo(tq0[0]), bfhi(tq0[0]), bflo(tq0[1]), bfhi(tq0[1])}, q1 = (f32x4){bflo(tq1[0]), bfhi(tq1[0]), bflo(tq1[1]), bfhi(tq1[1])};
        const f32x4 k0 = (f32x4){bflo(tk0[0]), bfhi(tk0[0]), bflo(tk0[1]), bfhi(tk0[1])}, k1 = (f32x4){bflo(tk1[0]), bfhi(tk1[0]), bflo(tk1[1]), bfhi(tk1[1])};
        float sq = (q0.x * q0.x + q0.y * q0.y) + (q0.z * q0.z + q0.w * q0.w) + (q1.x * q1.x + q1.y * q1.y) + (q1.z * q1.z + q1.w * q1.w);
        float sk = (k0.x * k0.x + k0.y * k0.y) + (k0.z * k0.z + k0.w * k0.w) + (k1.x * k1.x + k1.y * k1.y) + (k1.z * k1.z + k1.w * k1.w);
        sq = wave_sum(sq); sk = wave_sum(sk);
        const float rq = 1.0f / sqrtf(sq * (1.0f / 512.0f) + RMS_EPS), rk = 1.0f / sqrtf(sk * (1.0f / 512.0f) + RMS_EPS);
        { bf16_t* o = (bf16_t*)(ws + WS_QAN) + (size_t)m * 512;
          const f32x4 a = q0 * rq * gq0, b = q1 * rq * gq1;
          *(u32x2*)(o + 4 * lane) = (u32x2){pk2(a.x, a.y), pk2(a.z, a.w)}; *(u32x2*)(o + 256 + 4 * lane) = (u32x2){pk2(b.x, b.y), pk2(b.z, b.w)}; }
        { bf16_t* o = (bf16_t*)(ws + WS_CKVN) + (size_t)m * 512;
          const f32x4 a = k0 * rk * gk0, b = k1 * rk * gk1;
          *(u32x2*)(o + 4 * lane) = (u32x2){pk2(a.x, a.y), pk2(a.z, a.w)}; *(u32x2*)(o + 256 + 4 * lane) = (u32x2){pk2(b.x, b.y), pk2(b.z, b.w)};
          float* fo = (m < MP) ? F.out + O_CKVP + (size_t)m * 512 : F.out + O_CKVS + (size_t)(m - MP) * 512;
          __builtin_nontemporal_store(a, (f32x4*)(fo + 4 * lane)); __builtin_nontemporal_store(b, (f32x4*)(fo + 256 + 4 * lane));
          if (m >= MP) { bf16_t* cr = (bf16_t*)(ws + WS_CACHE) + ((size_t)((m - MP) >> 5) * KVLEN + PAST + ((m - MP) & 31)) * 576;
              *(u32x2*)(cr + 4 * lane) = (u32x2){pk2(a.x, a.y), pk2(a.z, a.w)}; *(u32x2*)(cr + 256 + 4 * lane) = (u32x2){pk2(b.x, b.y), pk2(b.z, b.w)}; } }
        const int pidx = (m < MP) ? (m & 2047) : 2048 + ((m - MP) & 31);
        if (lane < 32) {
            const float t1 = bf2f(srow[1024 + lane]), t2 = bf2f(srow[1056 + lane]); const float c = ct[pidx * 32 + lane], s = st[pidx * 32 + lane];
            const float o1 = t1 * c - t2 * s, o2 = t1 * s + t2 * c;
            float* fo = (m < MP) ? F.out + O_KPEP + (size_t)m * 64 : F.out + O_KPES + (size_t)(m - MP) * 64;
            fo[lane] = o1; fo[32 + lane] = o2;
            bf16_t* o = (bf16_t*)(ws + WS_KPER) + (size_t)m * 64; o[lane] = (bf16_t)f2bf(o1); o[32 + lane] = (bf16_t)f2bf(o2);
            if (m >= MP) { bf16_t* cr = (bf16_t*)(ws + WS_CACHE) + ((size_t)((m - MP) >> 5) * KVLEN + PAST + ((m - MP) & 31)) * 576 + 512; cr[lane] = (bf16_t)f2bf(o1); cr[32 + lane] = (bf16_t)f2bf(o2); }
        } else {
            const int hh = lane - 32; const float x = bf2f(srow[1088 + hh]) + dtb[hh];
            const float sp = (x > 20.f) ? x : log1pf(expf(x));
            ((float*)(ws + WS_DT))[(size_t)m * 32 + hh] = sp;
        }
    }
}


__device__ __forceinline__ void conv_item(Frame& F, const Args& args, int item) {
    int tid_o = F.tid; asm volatile("" : "+v"(tid_o));
    const int tid = tid_o, rb = item >> 3, sl = item & 7, ch = sl * 512 + (tid & 63) * 8, r0 = rb * 64 + (tid >> 6) * 8;
    unsigned char* ws = F.ws; const bf16_t* xbc = (const bf16_t*)(ws + WS_XBC);
    const float* conv_w = args.in[8]; const float* conv_b = args.in[9];
    float wv[4][8], bv[8];
#pragma unroll
    for (int k = 0; k < 4; ++k) { const f32x4 a = *(const f32x4*)(conv_w + k * 4096 + ch), c = *(const f32x4*)(conv_w + k * 4096 + ch + 4);
        wv[k][0] = a[0]; wv[k][1] = a[1]; wv[k][2] = a[2]; wv[k][3] = a[3]; wv[k][4] = c[0]; wv[k][5] = c[1]; wv[k][6] = c[2]; wv[k][7] = c[3]; }
    { const f32x4 a = *(const f32x4*)(conv_b + ch), c = *(const f32x4*)(conv_b + ch + 4); bv[0] = a[0]; bv[1] = a[1]; bv[2] = a[2]; bv[3] = a[3]; bv[4] = c[0]; bv[5] = c[1]; bv[6] = c[2]; bv[7] = c[3]; }
    float h0[8], h1[8], h2[8];
    const bool prompt = r0 < MP; const int t0 = prompt ? (r0 & 2047) : ((r0 - MP) & 31);
    u32x4 hv[3];
    if (t0 == 0) {
        if (prompt) { hv[0] = hv[1] = hv[2] = (u32x4){0u, 0u, 0u, 0u}; }
        else { const float* sc = args.in[5] + (size_t)((r0 - MP) >> 5) * 3 * 4096 + ch;
#pragma unroll
            for (int k = 0; k < 3; ++k) { const f32x4 a = *(const f32x4*)(sc + k * 4096), c = *(const f32x4*)(sc + k * 4096 + 4); hv[k] = (u32x4){pk2(a.x, a.y), pk2(a.z, a.w), pk2(c.x, c.y), pk2(c.z, c.w)}; } }
    } else {
#pragma unroll
        for (int k = 0; k < 3; ++k) hv[k] = *(const u32x4*)(xbc + (size_t)(r0 - 3 + k) * 4096 + ch);
    }
#pragma unroll
    for (int e = 0; e < 4; ++e) { h0[2 * e] = bflo(hv[0][e]); h0[2 * e + 1] = bfhi(hv[0][e]); h1[2 * e] = bflo(hv[1][e]); h1[2 * e + 1] = bfhi(hv[1][e]); h2[2 * e] = bflo(hv[2][e]); h2[2 * e + 1] = bfhi(hv[2][e]); }
    u32x4 rv[8];
#pragma unroll
    for (int i = 0; i < 8; ++i) rv[i] = (i < 5) ? __builtin_nontemporal_load((const u32x4*)(xbc + (size_t)(r0 + i) * 4096 + ch)) : *(const u32x4*)(xbc + (size_t)(r0 + i) * 4096 + ch);
    bf16_t* dst = (ch < 2048) ? (bf16_t*)(ws + WS_XACT) + (size_t)r0 * 2048 + ch : (bf16_t*)(ws + WS_BCACT) + (size_t)r0 * 2048 + (ch - 2048);
#pragma unroll
    for (int i = 0; i < 8; ++i) {
        float x[8], o[8];
#pragma unroll
        for (int e = 0; e < 4; ++e) { x[2 * e] = bflo(rv[i][e]); x[2 * e + 1] = bfhi(rv[i][e]); }
#pragma unroll
        for (int e = 0; e < 8; ++e) { o[e] = siluf_(bv[e] + wv[0][e] * h0[e] + wv[1][e] * h1[e] + wv[2][e] * h2[e] + wv[3][e] * x[e]); h0[e] = h1[e]; h1[e] = h2[e]; h2[e] = x[e]; }
        *(u32x4*)(dst + (size_t)i * 2048) = (u32x4){pk2(o[0], o[1]), pk2(o[2], o[3]), pk2(o[4], o[5]), pk2(o[6], o[7])};
    }
}

namespace ssd {
constexpr int SC = 272, SX = 144;
constexpr int L_CT = 0, L_BN = L_CT + 64 * SC, L_SB = L_BN + 64 * SC, L_XT = L_SB + 64 * SC, L_XS = L_XT + 64 * SX, L_MM = L_XS + 64 * SX, L_YO = L_MM + 64 * SX, L_SCAL = L_YO + 64 * SX, L_END = L_SCAL + 1024;
static_assert(L_END <= LDSCTL_OFF, "ssd LDS map");
typedef short v4i16 __attribute__((ext_vector_type(4)));
__device__ __forceinline__ v4i16 tr16(LAS const unsigned char* p) { return __builtin_amdgcn_ds_read_tr16_b64_v4i16((LAS v4i16*)p); }
}
__device__ __forceinline__ void ssd_item(Frame& F, const Args& args, int item) {
    using namespace ssd;
    LAS unsigned char* lds = F.lds;
    int tid_o = F.tid; asm volatile("" : "+v"(tid_o));
    const int tid = tid_o, lane = tid & 63, w = F.wave, g = lane >> 4, c16 = lane & 15;
    const bool sample = item >= 256;
    const int bb = sample ? (item - 256) >> 5 : item >> 5, h = item & 31, grp = h >> 2;
    const int nchunks = sample ? 1 : 32, nvalid = sample ? 32 : 64;
    const int rowbase = sample ? MP + bb * 32 : bb * 2048;
    unsigned char* ws = F.ws;
    const bf16_t* xact = (const bf16_t*)(ws + WS_XACT); const bf16_t* bcact = (const bf16_t*)(ws + WS_BCACT); const bf16_t* zbuf = (const bf16_t*)(ws + WS_Z); const float* dtbuf = (const float*)(ws + WS_DT);
    const float a_h = -__expf(args.in[11][h]); const float d_h = args.in[12][h];
    const int it = w >> 1, half = w & 1;
    f32x4 st[4];
#pragma unroll
    for (int nt = 0; nt < 4; ++nt) st[nt] = (f32x4){0.f, 0.f, 0.f, 0.f};
    if (sample) {
        const float* s0 = args.in[4] + ((size_t)(bb * 32 + h) * 64) * 128;
#pragma unroll
        for (int nt = 0; nt < 4; ++nt) st[nt] = *(const f32x4*)(s0 + (size_t)(16 * it + c16) * 128 + 16 * (4 * half + nt) + 4 * g);
    }
    __syncthreads();
#pragma unroll
    for (int nt = 0; nt < 4; ++nt) *(LAS u32x2*)(lds + L_SB + (16 * it + c16) * SC + (16 * (4 * half + nt) + 4 * g) * 2) = (u32x2){pk2(st[nt][0], st[nt][1]), pk2(st[nt][2], st[nt][3])};

    struct PF { u32x4 px, pb[2], pc[2]; float pdt; u32x2 pz[2]; };
    PF pfA, pfB;
    const int prow = tid >> 3, ppx = tid & 7, brow = tid >> 4, bpc = tid & 15;
    auto prefetch = [&](PF& P, int c) {
        const size_t r0 = (size_t)(rowbase + c * 64);
        const u32x4 zero4 = (u32x4){0u, 0u, 0u, 0u};
        P.px = (prow < nvalid) ? *(const u32x4*)(xact + (r0 + prow) * 2048 + h * 64 + ppx * 8) : zero4;
#pragma unroll
        for (int q = 0; q < 2; ++q) { const int rr = brow + 32 * q;
            P.pb[q] = (rr < nvalid) ? *(const u32x4*)(bcact + (r0 + rr) * 2048 + grp * 128 + bpc * 8) : zero4;
            P.pc[q] = (rr < nvalid) ? *(const u32x4*)(bcact + (r0 + rr) * 2048 + 1024 + grp * 128 + bpc * 8) : zero4; }
        P.pdt = (lane < nvalid) ? dtbuf[(r0 + lane) * 32 + h] : 0.f;
#pragma unroll
        for (int pt = 0; pt < 2; ++pt) P.pz[pt] = (16 * it + c16 < nvalid) ? *(const u32x2*)(zbuf + (r0 + 16 * it + c16) * 2048 + h * 64 + 16 * (2 * half + pt) + 4 * g) : (u32x2){0u, 0u};
    };
    prefetch(pfA, 0); if (nchunks > 1) prefetch(pfB, 1);
    const float* cache_c = args.in[2]; const float* cache_k = args.in[3]; bf16_t* cache_dst = (bf16_t*)(ws + WS_CACHE);
    constexpr int NPIECES = DEC_BATCH * PAST * 72;
    auto chunk = [&](PF& P, int c) {
        const size_t r0 = (size_t)(rowbase + c * 64);
        f32x4 cva[3], cvc[3]; int cdo[3];
        if (!sample) {
#pragma unroll
            for (int u = 0; u < 3; ++u) { const int i = ((item * 32 + c) * 3 + u) * 512 + tid; const bool ok = i < NPIECES; const int ii = ok ? i : 0;
                const int pc = ii % 72, row = ii / 72;
                const float* src = (pc < 64) ? cache_c + (size_t)row * 512 + pc * 8 : cache_k + (size_t)row * 64 + (pc - 64) * 8;
                cva[u] = __builtin_nontemporal_load((const f32x4*)src); cvc[u] = __builtin_nontemporal_load((const f32x4*)(src + 4)); cdo[u] = ok ? ((row >> 12) * KVLEN + (row & 4095)) * 72 + pc : -1; }
        }
        const float dtl = P.pdt; float acl = dtl * a_h; const u32x4 px = P.px; const u32x4 pb0 = P.pb[0], pb1 = P.pb[1], pc0 = P.pc[0], pc1 = P.pc[1];
#pragma unroll
        for (int o = 1; o < 64; o <<= 1) { const float t = __shfl_up(acl, o); if (lane >= o) acl += t; }
        const float tot = __shfl(acl, 63), dec = __expf(tot);
        const float s4l = dtl * __expf(tot - acl);
        {
            const float s4r = __shfl(s4l, prow);
            *(LAS u32x4*)(lds + L_XT + prow * SX + ppx * 16) = px;
            *(LAS u32x4*)(lds + L_XS + prow * SX + ppx * 16) = (u32x4){pk2(bflo(px[0]) * s4r, bfhi(px[0]) * s4r), pk2(bflo(px[1]) * s4r, bfhi(px[1]) * s4r), pk2(bflo(px[2]) * s4r, bfhi(px[2]) * s4r), pk2(bflo(px[3]) * s4r, bfhi(px[3]) * s4r)};
            *(LAS u32x4*)(lds + L_BN + brow * SC + bpc * 16) = pb0; *(LAS u32x4*)(lds + L_CT + brow * SC + bpc * 16) = pc0;
            *(LAS u32x4*)(lds + L_BN + (brow + 32) * SC + bpc * 16) = pb1; *(LAS u32x4*)(lds + L_CT + (brow + 32) * SC + bpc * 16) = pc1;
        }
        const u32x2 zc0 = P.pz[0], zc1 = P.pz[1];
        const float acum_i = __shfl(acl, 16 * it + c16);
        if (c + 2 < nchunks) prefetch(P, c + 2);
        __syncthreads();
        f32x4 acc3[2];
        {
            bf16x8 cb[4];
#pragma unroll
            for (int ks = 0; ks < 4; ++ks) cb[ks] = *(LAS const bf16x8*)(lds + L_CT + (16 * it + c16) * SC + (32 * ks + 8 * g) * 2);
#pragma unroll
            for (int t2 = 0; t2 < 2; ++t2) { const int jt = 2 * half + t2; f32x4 a1 = (f32x4){0.f, 0.f, 0.f, 0.f}, a3 = (f32x4){0.f, 0.f, 0.f, 0.f};
                bf16x8 bfr[4], sfr[4];
#pragma unroll
                for (int ks = 0; ks < 4; ++ks) { bfr[ks] = *(LAS const bf16x8*)(lds + L_BN + (16 * jt + c16) * SC + (32 * ks + 8 * g) * 2); sfr[ks] = *(LAS const bf16x8*)(lds + L_SB + (16 * jt + c16) * SC + (32 * ks + 8 * g) * 2); }
#pragma unroll
                for (int ks = 0; ks < 4; ++ks) { a1 = __builtin_amdgcn_mfma_f32_16x16x32_bf16(bfr[ks], cb[ks], a1, 0, 0, 0); a3 = __builtin_amdgcn_mfma_f32_16x16x32_bf16(sfr[ks], cb[ks], a3, 0, 0, 0); }
                acc3[t2] = a3;
                const int i = 16 * it + c16; float mv[4];
#pragma unroll
                for (int r = 0; r < 4; ++r) { const int j = 16 * jt + 4 * g + r; const float acj = __shfl(acl, j), dtj = __shfl(dtl, j); mv[r] = (j <= i) ? a1[r] * __expf(acum_i - acj) * dtj : 0.f; }
                *(LAS u32x2*)(lds + L_MM + i * SX + (16 * jt + 4 * g) * 2) = (u32x2){pk2(mv[0], mv[1]), pk2(mv[2], mv[3])};
            }
        }
        {
            bf16x8 xb[2];
#pragma unroll
            for (int ks = 0; ks < 2; ++ks) { LAS const unsigned char* tp = lds + L_XS + (32 * ks + 8 * g + (c16 >> 2)) * SX + (16 * it + 4 * (c16 & 3)) * 2;
                const v4i16 lo = tr16(tp), hi = tr16(tp + 4 * SX); xb[ks] = (bf16x8){lo[0], lo[1], lo[2], lo[3], hi[0], hi[1], hi[2], hi[3]}; }
#pragma unroll
            for (int nt = 0; nt < 4; ++nt) { f32x4 a4 = st[nt] * dec; const int n0 = 16 * (4 * half + nt);
#pragma unroll
                for (int ks = 0; ks < 2; ++ks) {
                    LAS const unsigned char* tp = lds + L_BN + (32 * ks + 8 * g + (c16 >> 2)) * SC + (n0 + 4 * (c16 & 3)) * 2;
                    const v4i16 lo = tr16(tp), hi = tr16(tp + 4 * SC);
                    a4 = __builtin_amdgcn_mfma_f32_16x16x32_bf16((bf16x8){lo[0], lo[1], lo[2], lo[3], hi[0], hi[1], hi[2], hi[3]}, xb[ks], a4, 0, 0, 0);
                }
                st[nt] = a4; }
        }
        __syncthreads();
        {
            bf16x8 mb[2];
#pragma unroll
            for (int ks = 0; ks < 2; ++ks) mb[ks] = *(LAS const bf16x8*)(lds + L_MM + (16 * it + c16) * SX + (32 * ks + 8 * g) * 2);
            const float ea = __expf(acum_i); const int i = 16 * it + c16;
            float ss = 0.f;
#pragma unroll
            for (int t2 = 0; t2 < 2; ++t2) { const int pt = 2 * half + t2;
                f32x4 y = acc3[t2] * ea;
#pragma unroll
                for (int ks = 0; ks < 2; ++ks) { LAS const unsigned char* tp = lds + L_XT + (32 * ks + 8 * g + (c16 >> 2)) * SX + (16 * pt + 4 * (c16 & 3)) * 2;
                    const v4i16 lo = tr16(tp), hi = tr16(tp + 4 * SX);
                    y = __builtin_amdgcn_mfma_f32_16x16x32_bf16((bf16x8){lo[0], lo[1], lo[2], lo[3], hi[0], hi[1], hi[2], hi[3]}, mb[ks], y, 0, 0, 0); }
                const u32x2 xi = *(LAS const u32x2*)(lds + L_XT + i * SX + (16 * pt + 4 * g) * 2); const u32x2 zz = t2 ? zc1 : zc0;
                const float y0 = (y[0] + d_h * bflo(xi.x)) * siluf_(bflo(zz.x)), y1 = (y[1] + d_h * bfhi(xi.x)) * siluf_(bfhi(zz.x)), y2 = (y[2] + d_h * bflo(xi.y)) * siluf_(bflo(zz.y)), y3 = (y[3] + d_h * bfhi(xi.y)) * siluf_(bfhi(zz.y));
                ss += (y0 * y0 + y1 * y1) + (y2 * y2 + y3 * y3);
                *(LAS u32x2*)(lds + L_YO + i * SX + (16 * pt + 4 * g) * 2) = (u32x2){pk2(y0, y1), pk2(y2, y3)};
            }
            ss += __shfl_xor(ss, 16); ss += __shfl_xor(ss, 32);
            if (g == 0) *(LAS float*)(lds + L_SCAL + half * 256 + i * 4) = ss;
#pragma unroll
            for (int nt = 0; nt < 4; ++nt) *(LAS u32x2*)(lds + L_SB + (16 * it + c16) * SC + (16 * (4 * half + nt) + 4 * g) * 2) = (u32x2){pk2(st[nt][0], st[nt][1]), pk2(st[nt][2], st[nt][3])};
        }
        __syncthreads();
        {
            const int row = tid >> 3, pc8 = tid & 7;
            if (row < nvalid) { const u32x4 v = *(LAS const u32x4*)(lds + L_YO + row * SX + pc8 * 16);
                *(u32x4*)((bf16_t*)(ws + WS_YZ) + (r0 + row) * 2048 + h * 64 + pc8 * 8) = v; }
            if (tid < nvalid) { LAS const float* pp = (LAS const float*)(lds + L_SCAL); ((float*)(ws + WS_SSQ))[(r0 + tid) * 32 + h] = pp[tid] + pp[64 + tid]; }
            if (!sample) {
#pragma unroll
                for (int u = 0; u < 3; ++u) if (cdo[u] >= 0) *(u32x4*)(cache_dst + (size_t)cdo[u] * 8) = (u32x4){pk2(cva[u].x, cva[u].y), pk2(cva[u].z, cva[u].w), pk2(cvc[u].x, cvc[u].y), pk2(cvc[u].z, cvc[u].w)};
            }
        }
    };
    for (int c = 0; c < nchunks; c += 2) { chunk(pfA, c); if (c + 1 < nchunks) chunk(pfB, c + 1); }
    {
        float* so = sample ? F.out + O_SSMS + ((size_t)(bb * 32 + h) * 64) * 128 : F.out + O_SSMP + ((size_t)(bb * 32 + h) * 64) * 128;
#pragma unroll
        for (int nt = 0; nt < 4; ++nt) __builtin_nontemporal_store(st[nt], (f32x4*)(so + (size_t)(16 * it + c16) * 128 + 16 * (4 * half + nt) + 4 * g));
    }
    __syncthreads();
}

namespace att {
typedef float f32x16 __attribute__((ext_vector_type(16)));
typedef short v4i16 __attribute__((ext_vector_type(4)));
__device__ __forceinline__ v4i16 tr16(LAS const unsigned char* p) { return __builtin_amdgcn_ds_read_tr16_b64_v4i16((LAS v4i16*)p); }
constexpr float QSCALE = 0.07216878364870322f * 1.4426950408889634f;
constexpr int PK_STR = 400, PV_STR = 320, PK_BYTES = 64 * PK_STR, PV_BYTES = 64 * PV_STR, PBUF = PK_BYTES + PV_BYTES;
static_assert(2 * PBUF <= LDSCTL_OFF, "prompt attention LDS");
constexpr int SK_STR = 1056, SK_MAIN = 32 * SK_STR, SK_TAIL = 32 * 128, SK_BUF = SK_MAIN + SK_TAIL;
constexpr int SQ_STR = 528, SQ_WAVE = 16 * SQ_STR, SQ_OFF = 2 * SK_BUF;
static_assert(SQ_OFF + 8 * SQ_WAVE <= LDSCTL_OFF, "sample attention LDS");
__device__ __forceinline__ unsigned pkbf(float lo, float hi) { return pg8::cvt_pk_bf16(lo, hi); }
__device__ __forceinline__ void glds16(const void* gsrc, unsigned lds_dst) { unsigned keep;
    asm volatile("s_mov_b32 %0, m0\n\ts_mov_b32 m0, %2\n\ts_nop 0\n\tglobal_load_lds_dwordx4 %1, off\n\ts_mov_b32 m0, %0" : "=&s"(keep) : "v"(gsrc), "s"(lds_dst) : "memory"); }
__device__ __forceinline__ void glds16s(const void* sbase, unsigned voff, unsigned lds_dst) { unsigned keep;
    asm volatile("s_mov_b32 %0, m0\n\ts_mov_b32 m0, %2\n\ts_nop 4\n\tglobal_load_lds_dwordx4 %1, %3\n\ts_mov_b32 m0, %0" : "=&s"(keep) : "v"(voff), "s"(lds_dst), "s"(sbase) : "memory"); }
}

template <int MODE> __device__ __forceinline__ void attn_prompt_unit(Frame& F, int b, int h, int qb) {
    using namespace att;
    LAS unsigned char* lds = F.lds; unsigned char* ws = F.ws;
    int tid_o = F.tid; asm volatile("" : "+v"(tid_o));
    const int tid = tid_o, lane = tid & 63, w = F.wave, r32 = lane & 31, hi = lane >> 5, i16 = lane & 15, gi = lane >> 4;
    const bf16_t* qg = (const bf16_t*)(ws + WS_Q); const bf16_t* kn = (const bf16_t*)(ws + WS_KN); const bf16_t* vv = (const bf16_t*)(ws + WS_V); const bf16_t* kpe = (const bf16_t*)(ws + WS_KPER);
    const float* ct = (const float*)(ws + WS_ROPE); const float* st = ct + 2080 * 32;
    const size_t rowb = (size_t)b * SEQ;
    const int NT = 4 * qb + 4, my_last = 4 * qb + (w >> 1);
    bf16x8 qf[12];
    {
        const int pos = 256 * qb + 32 * w + r32; const bf16_t* qrow = qg + (rowb + pos) * 3072 + h * 192 + 8 * hi;
#pragma unroll
        for (int ks = 0; ks < 8; ++ks) { const u32x4 v = *(const u32x4*)(qrow + 16 * ks); u32x4 o;
#pragma unroll
            for (int e = 0; e < 4; ++e) o[e] = pkbf(bflo(v[e]) * QSCALE, bfhi(v[e]) * QSCALE);
            qf[ks] = __builtin_bit_cast(bf16x8, o); }
#pragma unroll
        for (int kp = 0; kp < 2; ++kp) {
            const u32x4 v1 = *(const u32x4*)(qrow + 128 + 16 * kp), v2 = *(const u32x4*)(qrow + 160 + 16 * kp);
            const float* cp = ct + pos * 32 + 16 * kp + 8 * hi; const float* sp = st + pos * 32 + 16 * kp + 8 * hi;
            const f32x4 c0 = *(const f32x4*)cp, c1 = *(const f32x4*)(cp + 4), s0 = *(const f32x4*)sp, s1 = *(const f32x4*)(sp + 4);
            float t1[8], t2[8], o1[8], o2[8];
#pragma unroll
            for (int e = 0; e < 4; ++e) { t1[2 * e] = bflo(v1[e]); t1[2 * e + 1] = bfhi(v1[e]); t2[2 * e] = bflo(v2[e]); t2[2 * e + 1] = bfhi(v2[e]); }
#pragma unroll
            for (int e = 0; e < 8; ++e) { const float c = (e < 4) ? c0[e & 3] : c1[e & 3], sn = (e < 4) ? s0[e & 3] : s1[e & 3];
                o1[e] = (t1[e] * c - t2[e] * sn) * QSCALE; o2[e] = (t1[e] * sn + t2[e] * c) * QSCALE; }
            qf[8 + kp] = __builtin_bit_cast(bf16x8, (u32x4){pkbf(o1[0], o1[1]), pkbf(o1[2], o1[3]), pkbf(o1[4], o1[5]), pkbf(o1[6], o1[7])});
            qf[10 + kp] = __builtin_bit_cast(bf16x8, (u32x4){pkbf(o2[0], o2[1]), pkbf(o2[2], o2[3]), pkbf(o2[4], o2[5]), pkbf(o2[6], o2[7])});
        }
    }
    f32x16 oT[4];
#pragma unroll
    for (int d = 0; d < 4; ++d)
#pragma unroll
        for (int r = 0; r < 16; ++r) oT[d][r] = 0.f;
    float m_run = -INFINITY, l_run = 0.f;
    u32x4 pk[3], pv[2];
    auto gload = [&](int t) {
        const size_t r0 = rowb + (size_t)t * 64;
#pragma unroll
        for (int i = 0; i < 3; ++i) { const int idx = tid + 512 * i, row = idx / 24, pc = idx % 24;
            pk[i] = (pc < 16) ? *(const u32x4*)(kn + (r0 + row) * 2048 + h * 128 + pc * 8) : *(const u32x4*)(kpe + (r0 + row) * 64 + (pc - 16) * 8); }
#pragma unroll
        for (int i = 0; i < 2; ++i) { const int idx = tid + 512 * i, row = idx >> 4, pc = idx & 15; pv[i] = *(const u32x4*)(vv + (r0 + row) * 2048 + h * 128 + pc * 8); }
    };
    auto lstore = [&](int buf) {
        LAS unsigned char* kb = lds + buf * PBUF; LAS unsigned char* vb = kb + PK_BYTES;
#pragma unroll
        for (int i = 0; i < 3; ++i) { const int idx = tid + 512 * i, row = idx / 24, pc = idx % 24; *(LAS u32x4*)(kb + row * PK_STR + pc * 16) = pk[i]; }
#pragma unroll
        for (int i = 0; i < 2; ++i) { const int idx = tid + 512 * i, row = idx >> 4, pc = idx & 15; *(LAS u32x4*)(vb + row * PV_STR + pc * 16) = pv[i]; }
    };
    __syncthreads();
    if (MODE != 1) { gload(0); lstore(0); }
    __syncthreads();
    for (int t = 0; t < NT; ++t) {
        if (MODE != 1 && t + 1 < NT) gload(t + 1);
        if (MODE != 2 && t <= my_last) {
            LAS const unsigned char* kb = lds + (t & 1) * PBUF; LAS const unsigned char* vb = kb + PK_BYTES;
#pragma unroll
            for (int T = 0; T < 2; ++T) {
                f32x16 sT;
#pragma unroll
                for (int r = 0; r < 16; ++r) sT[r] = 0.f;
                {
                    LAS const unsigned char* kp = kb + (32 * T + r32) * PK_STR + 16 * hi;
#define PA_LDK(dst, k0) do { _Pragma("unroll") for (int i_ = 0; i_ < 4; ++i_) dst[i_] = *(LAS const bf16x8*)(kp + ((k0) + i_) * 32); } while (0)
#define PA_MMK(src, k0) do { _Pragma("unroll") for (int i_ = 0; i_ < 4; ++i_) sT = __builtin_amdgcn_mfma_f32_32x32x16_bf16(src[i_], qf[(k0) + i_], sT, 0, 0, 0); } while (0)
                    bf16x8 ka[4], kc[4];
                    PA_LDK(ka, 0); PA_LDK(kc, 4); __builtin_amdgcn_sched_barrier(0);
                    PA_MMK(ka, 0); __builtin_amdgcn_sched_barrier(0);
                    PA_LDK(ka, 8); __builtin_amdgcn_sched_barrier(0);
                    PA_MMK(kc, 4); __builtin_amdgcn_sched_barrier(0);
                    PA_MMK(ka, 8); __builtin_amdgcn_sched_barrier(0);
#undef PA_LDK
#undef PA_MMK
                }
                float mt = sT[0];
#pragma unroll
                for (int r = 1; r < 16; ++r) mt = fmaxf(mt, sT[r]);
                mt = fmaxf(mt, __shfl_xor(mt, 32));
                if (__any(mt > m_run + 8.0f)) {
                    const float m_new = fmaxf(m_run, mt); const float alpha = __builtin_amdgcn_exp2f(m_run - m_new); m_run = m_new; l_run *= alpha;
#pragma unroll
                    for (int d = 0; d < 4; ++d)
#pragma unroll
                        for (int r = 0; r < 16; ++r) oT[d][r] *= alpha;
                }
                float ps = 0.f;
#pragma unroll
                for (int r = 0; r < 16; ++r) { const float p = __builtin_amdgcn_exp2f(sT[r] - m_run); sT[r] = p; ps += p; }
                l_run += ps;
                bf16x8 pf[2];
#pragma unroll
                for (int sp = 0; sp < 2; ++sp) pf[sp] = __builtin_bit_cast(bf16x8, (u32x4){pkbf(sT[8 * sp], sT[8 * sp + 1]), pkbf(sT[8 * sp + 2], sT[8 * sp + 3]), pkbf(sT[8 * sp + 4], sT[8 * sp + 5]), pkbf(sT[8 * sp + 6], sT[8 * sp + 7])});
                __builtin_amdgcn_sched_barrier(0);
                {
                    LAS const unsigned char* tp0 = vb + (32 * T + 4 * hi + (i16 >> 2)) * PV_STR + (16 * (gi & 1) + 4 * (i16 & 3)) * 2;
#define PA_LDV(dst, d_) do { dst[0] = tr16(tp0 + (d_) * 64); dst[1] = tr16(tp0 + (d_) * 64 + 8 * PV_STR); dst[2] = tr16(tp0 + (d_) * 64 + 16 * PV_STR); dst[3] = tr16(tp0 + (d_) * 64 + 24 * PV_STR); } while (0)
#define PA_MMV(src, d_) do { oT[d_] = __builtin_amdgcn_mfma_f32_32x32x16_bf16((bf16x8){src[0][0], src[0][1], src[0][2], src[0][3], src[1][0], src[1][1], src[1][2], src[1][3]}, pf[0], oT[d_], 0, 0, 0); \
                        oT[d_] = __builtin_amdgcn_mfma_f32_32x32x16_bf16((bf16x8){src[2][0], src[2][1], src[2][2], src[2][3], src[3][0], src[3][1], src[3][2], src[3][3]}, pf[1], oT[d_], 0, 0, 0); } while (0)
                    v4i16 va[4], vc[4];
                    PA_LDV(va, 0); PA_LDV(vc, 1); __builtin_amdgcn_sched_barrier(0);
                    PA_MMV(va, 0); __builtin_amdgcn_sched_barrier(0);
                    PA_LDV(va, 2); __builtin_amdgcn_sched_barrier(0);
                    PA_MMV(vc, 1); __builtin_amdgcn_sched_barrier(0);
                    PA_LDV(vc, 3); __builtin_amdgcn_sched_barrier(0);
                    PA_MMV(va, 2); __builtin_amdgcn_sched_barrier(0);
                    PA_MMV(vc, 3); __builtin_amdgcn_sched_barrier(0);
#undef PA_LDV
#undef PA_MMV
                }
            }
        }
        if (MODE != 1 && t + 1 < NT) lstore((t + 1) & 1);
        __syncthreads();
    }
    if (MODE != 0 && l_run != 12345.f) return;
    l_run += __shfl_xor(l_run, 32);
    const float rl = 1.0f / l_run;
    bf16_t* orow = (bf16_t*)(ws + WS_O) + (rowb + 256 * qb + 32 * w + r32) * 2048 + h * 128 + 4 * hi;
#pragma unroll
    for (int d = 0; d < 4; ++d)
#pragma unroll
        for (int u = 0; u < 4; ++u) *(u32x2*)(orow + 32 * d + 8 * u) = (u32x2){pkbf(oT[d][4 * u] * rl, oT[d][4 * u + 1] * rl), pkbf(oT[d][4 * u + 2] * rl, oT[d][4 * u + 3] * rl)};
}

template <int MODE> __device__ __forceinline__ void attn_sample_item(Frame& F, int b, int rg) {
    using namespace att;
    LAS unsigned char* lds = F.lds; unsigned char* ws = F.ws;
    int tid_o = F.tid; asm volatile("" : "+v"(tid_o));
    const int tid = tid_o, lane = tid & 63, w = F.wave, c16 = lane & 15, g = lane >> 4;
    const int hh = 4 * rg + (w >> 1), q0 = 16 * (w & 1);
    const bf16_t* cache = (const bf16_t*)(ws + WS_CACHE) + (size_t)b * KVLEN * 576;
    const float* ct = (const float*)(ws + WS_ROPE); const float* st = ct + 2080 * 32;
    __syncthreads();
    bf16x8 qf[10];
    {
        const int qrow = b * 32 + q0 + c16; const bf16_t* ql = (const bf16_t*)(ws + WS_QLAT) + (size_t)qrow * 8192 + hh * 512 + 8 * g;
        LAS unsigned char* qd = lds + SQ_OFF + w * SQ_WAVE + c16 * SQ_STR + 16 * g;
#pragma unroll
        for (int ks = 0; ks < 16; ++ks) { const u32x4 v = *(const u32x4*)(ql + 32 * ks); u32x4 o;
#pragma unroll
            for (int e = 0; e < 4; ++e) o[e] = pkbf(bflo(v[e]) * QSCALE, bfhi(v[e]) * QSCALE);
            if (ks < 10) qf[ks] = __builtin_bit_cast(bf16x8, o); else *(LAS u32x4*)(qd + (ks - 10) * 64) = o; }
        const bf16_t* qp = (const bf16_t*)(ws + WS_Q) + (size_t)(MP + qrow) * 3072 + hh * 192 + 128 + 8 * g;
        const u32x4 v1 = *(const u32x4*)qp, v2 = *(const u32x4*)(qp + 32);
        const int pidx = 2048 + q0 + c16; const float* cp = ct + pidx * 32 + 8 * g; const float* sp = st + pidx * 32 + 8 * g;
        const f32x4 c0 = *(const f32x4*)cp, c1 = *(const f32x4*)(cp + 4), s0 = *(const f32x4*)sp, s1 = *(const f32x4*)(sp + 4);
        float t1[8], t2[8], o1[8], o2[8];
#pragma unroll
        for (int e = 0; e < 4; ++e) { t1[2 * e] = bflo(v1[e]); t1[2 * e + 1] = bfhi(v1[e]); t2[2 * e] = bflo(v2[e]); t2[2 * e + 1] = bfhi(v2[e]); }
#pragma unroll
        for (int e = 0; e < 8; ++e) { const float c = (e < 4) ? c0[e & 3] : c1[e & 3], sn = (e < 4) ? s0[e & 3] : s1[e & 3];
            o1[e] = (t1[e] * c - t2[e] * sn) * QSCALE; o2[e] = (t1[e] * sn + t2[e] * c) * QSCALE; }
        *(LAS u32x4*)(qd + 6 * 64) = (u32x4){pkbf(o1[0], o1[1]), pkbf(o1[2], o1[3]), pkbf(o1[4], o1[5]), pkbf(o1[6], o1[7])};
        *(LAS u32x4*)(qd + 7 * 64) = (u32x4){pkbf(o2[0], o2[1]), pkbf(o2[2], o2[3]), pkbf(o2[4], o2[5]), pkbf(o2[6], o2[7])};
    }
    f32x4 oT[32];
#pragma unroll
    for (int c = 0; c < 32; ++c) oT[c] = (f32x4){0.f, 0.f, 0.f, 0.f};
    float m_run = -INFINITY, l_run = 0.f;
    const unsigned lds0 = (unsigned)(uintptr_t)lds;
    const unsigned voff_main = (unsigned)lane * 16u, voff_tail = (unsigned)(((lane & 31) * 576 + 512 + (lane >> 5) * 8) * 2);
    auto dma = [&](int t, int buf) {
        const unsigned long long src = (unsigned long long)(uintptr_t)(cache + (size_t)t * 32 * 576);
#pragma unroll
        for (int i = 0; i < 5; ++i) { const int p = w + 8 * i;
            if (p < 32) { const unsigned long long sb = src + (unsigned long long)p * 1152ull;
                glds16s((const void*)(uintptr_t)(((unsigned long long)(unsigned)__builtin_amdgcn_readfirstlane((unsigned)(sb >> 32)) << 32) | (unsigned)__builtin_amdgcn_readfirstlane((unsigned)sb)), voff_main, (unsigned)__builtin_amdgcn_readfirstlane(lds0 + buf * SK_BUF + p * SK_STR)); }
            else if (p < 36) { const unsigned long long sb = src + (unsigned long long)(p - 32) * 32ull;
                glds16s((const void*)(uintptr_t)(((unsigned long long)(unsigned)__builtin_amdgcn_readfirstlane((unsigned)(sb >> 32)) << 32) | (unsigned)__builtin_amdgcn_readfirstlane((unsigned)sb)), voff_tail, (unsigned)__builtin_amdgcn_readfirstlane(lds0 + buf * SK_BUF + SK_MAIN + (p - 32) * 1024)); } }
    };
    constexpr int NT = KVLEN / 32;
    dma(0, 0);
    asm volatile("s_waitcnt vmcnt(0)" ::: "memory");
    __syncthreads();
    for (int t = 0; t < NT; ++t) {
        if (t + 1 < NT) dma(t + 1, (t + 1) & 1);
        LAS const unsigned char* kb = lds + (t & 1) * SK_BUF;
        f32x4 sT[2];
        sT[0] = (f32x4){0.f, 0.f, 0.f, 0.f}; sT[1] = sT[0];
        {
            LAS const unsigned char* qlp = lds + SQ_OFF + w * SQ_WAVE + c16 * SQ_STR + 16 * g;
#define SB_KLD(ks, T) (((ks) < 16) ? *(LAS const bf16x8*)(kb + (16 * (T) + c16) * SK_STR + (32 * (ks) + 8 * g) * 2) : *(LAS const bf16x8*)(kb + SK_MAIN + (4 * ((ks) - 16) + g) * 512 + (16 * (T) + c16) * 16))
#define SB_LDB(dst, k0) do { dst[0] = SB_KLD((k0), 0); dst[1] = SB_KLD((k0), 1); dst[2] = SB_KLD((k0) + 1, 0); dst[3] = SB_KLD((k0) + 1, 1); } while (0)
#define SB_QF(ks) (((ks) < 10) ? qf[(ks) < 10 ? (ks) : 0] : *(LAS const bf16x8*)(qlp + ((ks) - 10) * 64))
#define SB_MMB(src, k0) do { const bf16x8 q0_ = SB_QF(k0), q1_ = SB_QF((k0) + 1); \
            sT[0] = __builtin_amdgcn_mfma_f32_16x16x32_bf16(src[0], q0_, sT[0], 0, 0, 0); sT[1] = __builtin_amdgcn_mfma_f32_16x16x32_bf16(src[1], q0_, sT[1], 0, 0, 0); \
            sT[0] = __builtin_amdgcn_mfma_f32_16x16x32_bf16(src[2], q1_, sT[0], 0, 0, 0); sT[1] = __builtin_amdgcn_mfma_f32_16x16x32_bf16(src[3], q1_, sT[1], 0, 0, 0); } while (0)
            bf16x8 ka[4], kc[4];
            SB_LDB(ka, 0);
#pragma unroll
            for (int bi = 0; bi < 9; bi += 2) {
                if (bi + 1 < 9) { SB_LDB(kc, 2 * (bi + 1)); } __builtin_amdgcn_sched_barrier(0);
                SB_MMB(ka, 2 * bi); __builtin_amdgcn_sched_barrier(0);
                if (bi + 2 < 9) { SB_LDB(ka, 2 * (bi + 2)); } __builtin_amdgcn_sched_barrier(0);
                if (bi + 1 < 9) { SB_MMB(kc, 2 * (bi + 1)); } __builtin_amdgcn_sched_barrier(0);
            }
#undef SB_KLD
#undef SB_LDB
#undef SB_QF
#undef SB_MMB
        }
        float mt = fmaxf(fmaxf(fmaxf(sT[0][0], sT[0][1]), fmaxf(sT[0][2], sT[0][3])), fmaxf(fmaxf(sT[1][0], sT[1][1]), fmaxf(sT[1][2], sT[1][3])));
        mt = fmaxf(mt, __shfl_xor(mt, 16)); mt = fmaxf(mt, __shfl_xor(mt, 32));
        if (__any(mt > m_run + 8.0f)) {
            const float m_new = fmaxf(m_run, mt); const float alpha = __builtin_amdgcn_exp2f(m_run - m_new); m_run = m_new; l_run *= alpha;
#pragma unroll
            for (int c = 0; c < 32; ++c) oT[c] = oT[c] * alpha;
        }
        float p[8];
#pragma unroll
        for (int T = 0; T < 2; ++T)
#pragma unroll
            for (int r = 0; r < 4; ++r) { p[4 * T + r] = __builtin_amdgcn_exp2f(sT[T][r] - m_run); l_run += p[4 * T + r]; }
        const bf16x8 pf = __builtin_bit_cast(bf16x8, (u32x4){pkbf(p[0], p[1]), pkbf(p[2], p[3]), pkbf(p[4], p[5]), pkbf(p[6], p[7])});
        {
            LAS const unsigned char* tp0 = kb + (4 * g + (c16 >> 2)) * SK_STR + (4 * (c16 & 3)) * 2;
#define SB_VLD(dst, c0) do { dst[0] = tr16(tp0 + (c0) * 32); dst[1] = tr16(tp0 + (c0) * 32 + 16 * SK_STR); dst[2] = tr16(tp0 + ((c0) + 1) * 32); dst[3] = tr16(tp0 + ((c0) + 1) * 32 + 16 * SK_STR); } while (0)
#define SB_VMM(src, c0) do { oT[(c0)] = __builtin_amdgcn_mfma_f32_16x16x32_bf16((bf16x8){src[0][0], src[0][1], src[0][2], src[0][3], src[1][0], src[1][1], src[1][2], src[1][3]}, pf, oT[(c0)], 0, 0, 0); \
                oT[(c0) + 1] = __builtin_amdgcn_mfma_f32_16x16x32_bf16((bf16x8){src[2][0], src[2][1], src[2][2], src[2][3], src[3][0], src[3][1], src[3][2], src[3][3]}, pf, oT[(c0) + 1], 0, 0, 0); } while (0)
            v4i16 va[4], vc[4];
            SB_VLD(va, 0);
#pragma unroll
            for (int cb = 0; cb < 16; cb += 2) {
                SB_VLD(vc, 2 * (cb + 1)); __builtin_amdgcn_sched_barrier(0);
                SB_VMM(va, 2 * cb); __builtin_amdgcn_sched_barrier(0);
                if (cb + 2 < 16) { SB_VLD(va, 2 * (cb + 2)); } __builtin_amdgcn_sched_barrier(0);
                SB_VMM(vc, 2 * (cb + 1)); __builtin_amdgcn_sched_barrier(0);
            }
#undef SB_VLD
#undef SB_VMM
        }
        asm volatile("s_waitcnt vmcnt(0)" ::: "memory");
        __syncthreads();
    }
    l_run += __shfl_xor(l_run, 16); l_run += __shfl_xor(l_run, 32);
    const float rl = 1.0f / l_run;
    bf16x8 of[16];
#pragma unroll
    for (int kb2 = 0; kb2 < 16; ++kb2) { const f32x4 a = oT[2 * kb2] * rl, c2 = oT[2 * kb2 + 1] * rl;
        of[kb2] = __builtin_bit_cast(bf16x8, (u32x4){pkbf(a[0], a[1]), pkbf(a[2], a[3]), pkbf(c2[0], c2[1]), pkbf(c2[2], c2[3])}); }
    const bf16_t* wuv = (const bf16_t*)(ws + WS_WUV) + (size_t)(hh * 128 + c16) * 512 + 4 * g;
    bf16_t* orow = (bf16_t*)(ws + WS_O) + (size_t)(MP + b * 32 + q0 + c16) * 2048 + hh * 128 + 4 * g;
#pragma unroll 2
    for (int vt = 0; vt < 8; ++vt) { f32x4 a = (f32x4){0.f, 0.f, 0.f, 0.f};
#pragma unroll
        for (int kb2 = 0; kb2 < 16; ++kb2) { const u32x2 w0 = *(const u32x2*)(wuv + (size_t)vt * 16 * 512 + 32 * kb2), w1 = *(const u32x2*)(wuv + (size_t)vt * 16 * 512 + 32 * kb2 + 16);
            a = __builtin_amdgcn_mfma_f32_16x16x32_bf16(__builtin_bit_cast(bf16x8, (u32x4){w0.x, w0.y, w1.x, w1.y}), of[kb2], a, 0, 0, 0); }
        *(u32x2*)(orow + 16 * vt) = (u32x2){pkbf(a[0], a[1]), pkbf(a[2], a[3])}; }
}


struct MixOrder {
    const char *A0, *B0, *A1, *B1; int G, c;
    __device__ __forceinline__ bool next(int i, pg8::Unit& u) const {
        const int idx = (i >> 1) * G + c; if (idx >= (MP / 256) * 4) return false;
        u.pm = idx >> 2; u.pn = idx & 3; u.seg = i & 1;
        u.a = ((i & 1) ? A1 : A0) + (size_t)u.pm * 256 * 2048 * 2; u.b = ((i & 1) ? B1 : B0) + (size_t)u.pn * 256 * 2048 * 2; return true;
    }
};
struct EpiMix {
    static constexpr bool PERM = true;
    const bf16_t* gates; const float* bgate; bf16_t* t1; bf16_t* uo;
    __device__ __forceinline__ void operator()(const f32x4 (&acc)[2][2][4][2], const pg8::Unit& u, int wr, int wc, int fr, int fq) const {
        const int row0 = u.pm * 256 + wr * 64 + fr, col0 = u.pn * 256 + wc * 32 + 8 * fq, gofs = u.seg ? 1024 : 0;
#pragma unroll
        for (int bj = 0; bj < 2; ++bj) { const int col = col0 + bj * 128;
            const f32x4 bg0 = *(const f32x4*)(bgate + gofs + col), bg1 = *(const f32x4*)(bgate + gofs + col + 4);
#pragma unroll
            for (int ai = 0; ai < 2; ++ai)
#pragma unroll
                for (int m = 0; m < 4; ++m) { const size_t row = (size_t)(row0 + ai * 128 + m * 16);
                    const u32x4 gv = *(const u32x4*)(gates + row * 2048 + gofs + col);
                    const f32x4 a0 = acc[ai][bj][m][0], a1 = acc[ai][bj][m][1];
                    f32x4 r0, r1;
                    r0[0] = sigmoidf_(bflo(gv[0]) + bg0[0]) * a0[0]; r0[1] = sigmoidf_(bfhi(gv[0]) + bg0[1]) * a0[1]; r0[2] = sigmoidf_(bflo(gv[1]) + bg0[2]) * a0[2]; r0[3] = sigmoidf_(bfhi(gv[1]) + bg0[3]) * a0[3];
                    r1[0] = sigmoidf_(bflo(gv[2]) + bg1[0]) * a1[0]; r1[1] = sigmoidf_(bfhi(gv[2]) + bg1[1]) * a1[1]; r1[2] = sigmoidf_(bflo(gv[3]) + bg1[2]) * a1[2]; r1[3] = sigmoidf_(bfhi(gv[3]) + bg1[3]) * a1[3];
                    bf16_t* tp = t1 + row * 1024 + col;
                    if (u.seg == 0) { *(u32x4*)tp = (u32x4){pg8::cvt_pk_bf16(r0[0], r0[1]), pg8::cvt_pk_bf16(r0[2], r0[3]), pg8::cvt_pk_bf16(r1[0], r1[1]), pg8::cvt_pk_bf16(r1[2], r1[3])}; }
                    else { const u32x4 pv = *(const u32x4*)tp; r0 = r0 + (f32x4){bflo(pv[0]), bfhi(pv[0]), bflo(pv[1]), bfhi(pv[1])}; r1 = r1 + (f32x4){bflo(pv[2]), bfhi(pv[2]), bflo(pv[3]), bfhi(pv[3])};
                        *(u32x4*)(uo + row * 1024 + col) = (u32x4){pg8::cvt_pk_bf16(r0[0], r0[1]), pg8::cvt_pk_bf16(r0[2], r0[3]), pg8::cvt_pk_bf16(r1[0], r1[1]), pg8::cvt_pk_bf16(r1[2], r1[3])}; } } }
    }
};
struct EpiV1 {
    static constexpr bool PERM = true;
    const bf16_t* xin; bf16_t* ao; float* st;
    __device__ __forceinline__ void operator()(const f32x4 (&acc)[2][2][4][2], const pg8::Unit& u, int wr, int wc, int fr, int fq) const {
        const int row0 = u.pm * 256 + wr * 64 + fr, col0 = u.pn * 256 + wc * 32 + 8 * fq;
#pragma unroll
        for (int ai = 0; ai < 2; ++ai)
#pragma unroll
            for (int m = 0; m < 4; ++m) { const int row = row0 + ai * 128 + m * 16; const bf16_t* rp = xin + (size_t)row * 1024; float s1 = 0.f, s2 = 0.f;
#pragma unroll
                for (int bj = 0; bj < 2; ++bj) { const int col = col0 + bj * 128;
                    const u32x4 xv = *(const u32x4*)(rp + col); const f32x4 x0 = (f32x4){bflo(xv[0]), bfhi(xv[0]), bflo(xv[1]), bfhi(xv[1])}, x1 = (f32x4){bflo(xv[2]), bfhi(xv[2]), bflo(xv[3]), bfhi(xv[3])};
                    const f32x4 a = x0 * ALPHA + acc[ai][bj][m][0], b = x1 * ALPHA + acc[ai][bj][m][1];
                    s1 += ((a[0] + a[1]) + (a[2] + a[3])) + ((b[0] + b[1]) + (b[2] + b[3]));
                    s2 += ((a[0] * a[0] + a[1] * a[1]) + (a[2] * a[2] + a[3] * a[3])) + ((b[0] * b[0] + b[1] * b[1]) + (b[2] * b[2] + b[3] * b[3]));
                    *(u32x4*)(ao + (size_t)row * 1024 + col) = (u32x4){pg8::cvt_pk_bf16(a[0], a[1]), pg8::cvt_pk_bf16(a[2], a[3]), pg8::cvt_pk_bf16(b[0], b[1]), pg8::cvt_pk_bf16(b[2], b[3])}; }
                s1 += __shfl_xor(s1, 16); s1 += __shfl_xor(s1, 32); s2 += __shfl_xor(s2, 16); s2 += __shfl_xor(s2, 32);
                if (fq == 0) { atomicAdd(st + 2 * (size_t)row, s1); atomicAdd(st + 2 * (size_t)row + 1, s2); } }
    }
};
struct EpiV2 {
    static constexpr bool PERM = true;
    const bf16_t* v1i; const float* st; const float* g1; const float* b1; bf16_t* out;
    __device__ __forceinline__ void operator()(const f32x4 (&acc)[2][2][4][2], const pg8::Unit& u, int wr, int wc, int fr, int fq) const {
        const int row0 = u.pm * 256 + wr * 64 + fr, col0 = u.pn * 256 + wc * 32 + 8 * fq;
        f32x4 gA[2][2], bA[2][2];
#pragma unroll
        for (int bj = 0; bj < 2; ++bj) { gA[bj][0] = *(const f32x4*)(g1 + col0 + bj * 128) * ALPHA; gA[bj][1] = *(const f32x4*)(g1 + col0 + bj * 128 + 4) * ALPHA; bA[bj][0] = *(const f32x4*)(b1 + col0 + bj * 128) * ALPHA; bA[bj][1] = *(const f32x4*)(b1 + col0 + bj * 128 + 4) * ALPHA; }
#pragma unroll
        for (int ai = 0; ai < 2; ++ai)
#pragma unroll
            for (int m = 0; m < 4; ++m) { const int row = row0 + ai * 128 + m * 16; const bf16_t* rp = v1i + (size_t)row * 1024;
                const f32x2 ss = *(const f32x2*)(st + 2 * (size_t)row); const float mu = ss.x * (1.f / 1024.f), rs = 1.0f / sqrtf(ss.y * (1.f / 1024.f) - mu * mu + LN_EPS);
#pragma unroll
                for (int bj = 0; bj < 2; ++bj) { const int col = col0 + bj * 128;
                    const u32x4 xv = *(const u32x4*)(rp + col);
                    const f32x4 x0 = ((f32x4){bflo(xv[0]), bfhi(xv[0]), bflo(xv[1]), bfhi(xv[1])} - mu) * rs, x1 = ((f32x4){bflo(xv[2]), bfhi(xv[2]), bflo(xv[3]), bfhi(xv[3])} - mu) * rs;
                    const f32x4 o0 = x0 * gA[bj][0] + bA[bj][0] + acc[ai][bj][m][0], o1 = x1 * gA[bj][1] + bA[bj][1] + acc[ai][bj][m][1];
                    *(u32x4*)(out + (size_t)row * 1024 + col) = (u32x4){pg8::cvt_pk_bf16(o0[0], o0[1]), pg8::cvt_pk_bf16(o0[2], o0[3]), pg8::cvt_pk_bf16(o1[0], o1[1]), pg8::cvt_pk_bf16(o1[2], o1[3])}; } }
    }
};
struct EpiRelu2 {
    static constexpr bool PERM = true;
    bf16_t* out; const float* st; const float* gw;
    __device__ __forceinline__ void operator()(const f32x4 (&acc)[2][2][4][2], const pg8::Unit& u, int wr, int wc, int fr, int fq) const {
        const int row0 = u.pm * 256 + wr * 64 + fr, col0 = u.pn * 256 + wc * 32 + 8 * fq;
        bf16_t* p = out + (size_t)row0 * 4096 + col0;
        f32x4 gA[2][2], bA[2][2];
#pragma unroll
        for (int bj = 0; bj < 2; ++bj) { gA[bj][0] = *(const f32x4*)(gw + col0 + bj * 128); gA[bj][1] = *(const f32x4*)(gw + col0 + bj * 128 + 4); bA[bj][0] = *(const f32x4*)(gw + 4096 + col0 + bj * 128); bA[bj][1] = *(const f32x4*)(gw + 4096 + col0 + bj * 128 + 4); }
#pragma unroll
        for (int ai = 0; ai < 2; ++ai)
#pragma unroll
            for (int m = 0; m < 4; ++m) { const int row = row0 + ai * 128 + m * 16;
                const f32x2 ss = *(const f32x2*)(st + 2 * (size_t)row); const float mu = ss.x * (1.f / 1024.f), rs = 1.0f / sqrtf(ss.y * (1.f / 1024.f) - mu * mu + LN_EPS), rm = rs * mu;
#pragma unroll
                for (int bj = 0; bj < 2; ++bj) { f32x4 v0 = acc[ai][bj][m][0] * rs - gA[bj][0] * rm + bA[bj][0], v1 = acc[ai][bj][m][1] * rs - gA[bj][1] * rm + bA[bj][1];
#pragma unroll
                    for (int e = 0; e < 4; ++e) { const float a = fmaxf(v0[e], 0.f), b = fmaxf(v1[e], 0.f); v0[e] = a * a; v1[e] = b * b; }
                    *(u32x4*)(p + (size_t)(ai * 128 + m * 16) * 4096 + bj * 128) = (u32x4){pg8::cvt_pk_bf16(v0[0], v0[1]), pg8::cvt_pk_bf16(v0[2], v0[3]), pg8::cvt_pk_bf16(v1[0], v1[1]), pg8::cvt_pk_bf16(v1[2], v1[3])}; } }
    }
};
template <bool FINAL> __device__ __forceinline__ void ln_rows(Frame& F, const void* srcv, const float* gam, const float* bet, float* dstf, bf16_t* dstb) {
    const int gw = F.vcu * NWAVES + F.wave, NGW = F.G * NWAVES, lane = F.lane;
    f32x4 gg[4], bb[4];
#pragma unroll
    for (int j = 0; j < 4; ++j) { gg[j] = *(const f32x4*)(gam + 4 * lane + 256 * j); bb[j] = *(const f32x4*)(bet + 4 * lane + 256 * j); }
    for (int m = gw; m < M; m += NGW) {
        f32x4 v[4]; float s = 0.f;
#pragma unroll
        for (int j = 0; j < 4; ++j) {
            if (FINAL) { const u32x2 t = __builtin_nontemporal_load((const u32x2*)((const bf16_t*)srcv + (size_t)m * 1024 + 4 * lane + 256 * j)); v[j] = (f32x4){bflo(t[0]), bfhi(t[0]), bflo(t[1]), bfhi(t[1])}; }
            else v[j] = *(const f32x4*)((const float*)srcv + (size_t)m * 1024 + 4 * lane + 256 * j);
            s += (v[j].x + v[j].y) + (v[j].z + v[j].w); }
        const float mean = wave_sum(s) * (1.f / 1024.f); float s2 = 0.f;
#pragma unroll
        for (int j = 0; j < 4; ++j) { v[j] = v[j] - mean; s2 += (v[j].x * v[j].x + v[j].y * v[j].y) + (v[j].z * v[j].z + v[j].w * v[j].w); }
        const float rstd = 1.f / sqrtf(wave_sum(s2) * (1.f / 1024.f) + LN_EPS);
        float* of = FINAL ? ((m < MP) ? F.out + O_YP + (size_t)m * 1024 : F.out + O_YS + (size_t)(m - MP) * 1024) : dstf + (size_t)m * 1024;
#pragma unroll
        for (int j = 0; j < 4; ++j) { const f32x4 o = v[j] * rstd * gg[j] + bb[j]; if (FINAL) __builtin_nontemporal_store(o, (f32x4*)(of + 4 * lane + 256 * j)); else *(f32x4*)(of + 4 * lane + 256 * j) = o;
            if (!FINAL) *(u32x2*)(dstb + (size_t)m * 1024 + 4 * lane + 256 * j) = (u32x2){pk2(o.x, o.y), pk2(o.z, o.w)}; }
    }
}
__device__ __forceinline__ void yz_norm_item(Frame& F, const float* gain, int pm) {
    const int lane = F.lane; unsigned char* ws = F.ws;
    f32x4 g0[4], g1[4];
#pragma unroll
    for (int i = 0; i < 4; ++i) { const int ch = lane * 8 + 512 * i; g0[i] = *(const f32x4*)(gain + ch); g1[i] = *(const f32x4*)(gain + ch + 4); }
#pragma unroll 1
    for (int hb = 0; hb < 4; ++hb) {
        u32x4 v[2][4]; f32x4 q4[2][4];
#pragma unroll
        for (int r = 0; r < 2; ++r) { const size_t row = (size_t)pm * 64 + F.wave * 8 + hb * 2 + r; const bf16_t* p = (const bf16_t*)(ws + WS_YZ) + row * 2048; const float* sq = (const float*)(ws + WS_SSQ) + row * 32;
#pragma unroll
            for (int i = 0; i < 4; ++i) { const int ch = lane * 8 + 512 * i; v[r][i] = *(const u32x4*)(p + ch); q4[r][i] = *(const f32x4*)(sq + 4 * (ch >> 8)); } }
#pragma unroll
        for (int r = 0; r < 2; ++r) { const size_t row = (size_t)pm * 64 + F.wave * 8 + hb * 2 + r; bf16_t* p = (bf16_t*)(ws + WS_YZ) + row * 2048;
#pragma unroll
            for (int i = 0; i < 4; ++i) { const int ch = lane * 8 + 512 * i; const f32x4 q = q4[r][i]; const float rs = 1.0f / sqrtf(((q.x + q.y) + (q.z + q.w)) * (1.0f / 256.0f) + RMS_EPS); const u32x4 x = v[r][i];
                *(u32x4*)(p + ch) = (u32x4){pk2(bflo(x[0]) * rs * g0[i][0], bfhi(x[0]) * rs * g0[i][1]), pk2(bflo(x[1]) * rs * g0[i][2], bfhi(x[1]) * rs * g0[i][3]),
                                            pk2(bflo(x[2]) * rs * g1[i][0], bfhi(x[2]) * rs * g1[i][1]), pk2(bflo(x[3]) * rs * g1[i][2], bfhi(x[3]) * rs * g1[i][3])}; } }
    }
}

__device__ __forceinline__ void sgemm_tile(Frame& F, const bf16_t* a0, int lda, const bf16_t* b0, int ldb, int K, float (&v)[8]) {
    int tid_o = F.tid; asm volatile("" : "+v"(tid_o));
    const int tid = tid_o, lane = tid & 63, w = F.wave, c16 = lane & 15, g = lane >> 4;
    const int kw = K >> 3, nks = kw >> 5;
    const bf16_t* ap = a0 + (size_t)c16 * lda + w * kw + 8 * g;
    const bf16_t* bp = b0 + (size_t)c16 * ldb + w * kw + 8 * g;
    f32x4 acc[4][4];
#pragma unroll
    for (int i = 0; i < 4; ++i)
#pragma unroll
        for (int j = 0; j < 4; ++j) acc[i][j] = (f32x4){0.f, 0.f, 0.f, 0.f};
    bf16x8 af[4], bfr[4], an[4], bn[4];
#pragma unroll
    for (int i = 0; i < 4; ++i) { af[i] = *(const bf16x8*)(ap + (size_t)i * 16 * lda); bfr[i] = *(const bf16x8*)(bp + (size_t)i * 16 * ldb); }
    for (int ks = 0; ks < nks; ++ks) {
        const int kn = (ks + 1 < nks) ? (ks + 1) * 32 : ks * 32;
#pragma unroll
        for (int i = 0; i < 4; ++i) { an[i] = *(const bf16x8*)(ap + (size_t)i * 16 * lda + kn); bn[i] = *(const bf16x8*)(bp + (size_t)i * 16 * ldb + kn); }
#pragma unroll
        for (int i = 0; i < 4; ++i)
#pragma unroll
            for (int j = 0; j < 4; ++j) acc[i][j] = __builtin_amdgcn_mfma_f32_16x16x32_bf16(af[i], bfr[j], acc[i][j], 0, 0, 0);
#pragma unroll
        for (int i = 0; i < 4; ++i) { af[i] = an[i]; bfr[i] = bn[i]; }
    }
    __syncthreads();
    LAS float* slab = (LAS float*)(F.lds + w * 16384);
#pragma unroll
    for (int i = 0; i < 4; ++i)
#pragma unroll
        for (int j = 0; j < 4; ++j)
#pragma unroll
            for (int r = 0; r < 4; ++r) slab[(16 * i + 4 * g + r) * 64 + 16 * j + c16] = acc[i][j][r];
    __syncthreads();
    const int row = tid >> 3, c8 = tid & 7;
    f32x4 s0 = (f32x4){0.f, 0.f, 0.f, 0.f}, s1 = s0;
#pragma unroll
    for (int ww = 0; ww < 8; ++ww) { LAS const float* p = (LAS const float*)(F.lds + ww * 16384) + row * 64 + c8 * 8; s0 = s0 + *(LAS const f32x4*)p; s1 = s1 + *(LAS const f32x4*)(p + 4); }
    v[0] = s0[0]; v[1] = s0[1]; v[2] = s0[2]; v[3] = s0[3]; v[4] = s1[0]; v[5] = s1[1]; v[6] = s1[2]; v[7] = s1[3];
}

constexpr int N_PHASES = 11;
__global__ void __launch_bounds__(NTHREADS, 2) fwd_kernel(Args args) {
    extern __shared__ __attribute__((aligned(16))) unsigned char lds_raw[];
    Frame F;
    F.lds = (LAS unsigned char*)lds_raw;
    F.tid = threadIdx.x; F.lane = F.tid & 63; F.wave = __builtin_amdgcn_readfirstlane(F.tid >> 6);
    F.G = gridDim.x; { const int bx = blockIdx.x; F.vcu = (F.G % 8 == 0) ? (bx % 8) * (F.G / 8) + bx / 8 : bx; }
    F.ws = args.ws; F.out = args.out;
    unsigned* ctl = (unsigned*)(args.ws + WS_CTL);
    volatile LAS unsigned* MISC = (volatile LAS unsigned*)(F.lds + MISC_OFF);
    for (int u = F.tid; u < (LDS_BYTES - LDSCTL_OFF) / 4; u += NTHREADS) ((LAS unsigned*)(F.lds + LDSCTL_OFF))[u] = 0u;
    __syncthreads();
    XcdBarrier bar; bar.bar = ctl + CW_BAR; bar.x = 0; bar.st = nullptr;
#if !MK_PER_PHASE
    bar = xcd_barrier_post(ctl + CW_BAR, MISC + 8);
#define GRID_BAR() xcd_barrier(bar)
#else
#define GRID_BAR() do {} while (0)
#endif
    const int lo = args.ph_lo, hi = args.ph_hi;
#define IN(k) (lo <= (k) && (k) < hi)
#define BOTH(k) (IN(k) && IN((k) + 1))

    if (IN(0)) { for (int rep = 0; rep < NREP(0); ++rep) { p0_prologue(F, args); if (BOTH(0)) GRID_BAR(); } }
    if (IN(1)) {
        unsigned char* ws = args.ws;
        {
            pg8::SegOrder S; S.nseg = 1; S.G = F.G; S.c = (int)blockIdx.x; S.dup = 1;
            S.s[0] = pg8::Seg{(const char*)(ws + WS_XB), (const char*)(ws + WS_WIN), M / 256, NPROJ / 256, 0, (M / 256) * (NPROJ / 256), (size_t)256 * 1024 * 2, (size_t)256 * 1024 * 2};
            S.total = S.s[0].count; S.dup = DIAG_DUP_G1;
            EpiProj E{ws, args.out};
            pg8::gemm_phase<EpiProj, pg8::SegOrder>(F.lds, 1024, 1024, 1024, S, E);
        }
        {
            pg8::WqlOrder S{(const char*)(ws + WS_WUKB), (const char*)(ws + WS_BQL), F.G, (int)blockIdx.x};
            bf16_t* wq = (bf16_t*)(ws + WS_WQL); EpiStore E{wq, wq, wq, wq, 512, 512, 512, 512};
            pg8::gemm_phase<EpiStore, pg8::WqlOrder>(F.lds, 256, 2048, 256, S, E);
        }
        if (BOTH(1)) GRID_BAR();
    }
    if (IN(2)) { p1b_rows(F, args);
        {
            const int gt = F.vcu * NTHREADS + F.tid, NGT = F.G * NTHREADS; const float* part = (const float*)(args.ws + WS_GWP); float* gwv = (float*)(args.ws + WS_GW); float* stz = (float*)(args.ws + WS_ST);
            for (int i = gt; i < 2 * 4096; i += NGT) { const int n = i & 4095, wh = i >> 12; float a = 0.f;
#pragma unroll 8
                for (int ks = 0; ks < 32; ++ks) a += part[(ks * 2 + wh) * 4096 + n];
                gwv[i] = a; }
            for (int i = gt; i < M * 2; i += NGT) stz[i] = 0.f;
        }
        for (int item = F.vcu; item < (M / 64) * 8; item += F.G) conv_item(F, args, item);
        if (BOTH(2)) GRID_BAR(); }
    if (IN(3)) {
        unsigned char* ws = args.ws;
        for (int item = F.vcu; item < 1280 + (DIAG_DUP_SSD == 2 ? 1280 : DIAG_DUP_SSD == 3 ? 256 : DIAG_DUP_SSD == 4 ? 1024 : 0); item += F.G) ssd_item(F, args, item < 1280 ? item : (DIAG_DUP_SSD == 4 ? item - 1024 : item - 1280));
        {
            pg8::SegOrder S; S.nseg = 4; S.G = F.G; S.c = (int)blockIdx.x; S.dup = DIAG_DUP_G2;
            const size_t pt = (size_t)256 * 512 * 2;
            S.s[0] = pg8::Seg{(const char*)(ws + WS_QAN), (const char*)(ws + WS_WQ), M / 256, 12, 0, (M / 256) * 12, pt, pt};
            S.s[1] = pg8::Seg{(const char*)(ws + WS_CKVN), (const char*)(ws + WS_WUK), MP / 256, 8, 816, 512, pt, pt};
            S.s[2] = pg8::Seg{(const char*)(ws + WS_CKVN), (const char*)(ws + WS_WUV), MP / 256, 8, 1328, 512, pt, pt};
            S.s[3] = pg8::Seg{(const char*)(ws + WS_QAN) + (size_t)MP * 512 * 2, (const char*)(ws + WS_WQL), MS / 256, 32, 1840, 128, pt, pt};
            S.total = 1968;
            EpiStore E{(bf16_t*)(ws + WS_Q), (bf16_t*)(ws + WS_KN), (bf16_t*)(ws + WS_V), (bf16_t*)(ws + WS_QLAT), 3072, 2048, 2048, 8192};
            pg8::gemm_phase<EpiStore, pg8::SegOrder>(F.lds, 512, 512, 512, S, E);
        }
        if (BOTH(3)) GRID_BAR();
    }
    if (IN(4)) for (int rep = 0; rep < NREP(4); ++rep) {
        constexpr int NNORM = M / 64;
        const int NITEMS = 128 + NNORM + 1024;
        const bool pin_mode = F.G >= 256;
        bool pinned = pin_mode && (F.vcu & 1) == 0 && (F.vcu >> 1) < 128;
        for (;;) {
            __syncthreads();
            if (F.tid == 0) MISC[0] = pinned ? (unsigned)(F.vcu >> 1) : (pin_mode ? 128u : 0u) + __hip_atomic_fetch_add(ctl + CW_QUEUE + 64 * rep, 1u, __ATOMIC_RELAXED, __HIP_MEMORY_SCOPE_AGENT);
            __syncthreads();
            pinned = false;
            const int item = (int)MISC[0];
            if (item >= NITEMS) break;
            if (item < 128) attn_sample_item<0>(F, item >> 2, item & 3);
            else if (item < 128 + NNORM) yz_norm_item(F, args.in[13], item - 128);
            else { const int j = item - 128 - NNORM, qb = 7 - (j >> 7), bh = j & 127; attn_prompt_unit<0>(F, bh >> 4, bh & 15, qb); }
        }
        if (BOTH(4)) GRID_BAR();
    }
    if (IN(5)) for (int rep = 0; rep < NREP(5); ++rep) {
        unsigned char* ws = args.ws;
        MixOrder S{(const char*)(ws + WS_YZ), (const char*)(ws + WS_WSSM), (const char*)(ws + WS_O), (const char*)(ws + WS_WMLA), F.G, (int)blockIdx.x};
        EpiMix E{(const bf16_t*)(ws + WS_G), args.in[7], (bf16_t*)(ws + WS_T1), (bf16_t*)(ws + WS_U)};
        pg8::gemm_phase<EpiMix, MixOrder>(F.lds, 2048, 2048, 2048, S, E);
        for (int tile = F.vcu; tile < 256; tile += F.G) {
            const int rt = tile >> 4, ctile = tile & 15, row = MP + rt * 64 + (F.tid >> 3), col = ctile * 64 + (F.tid & 7) * 8;
            const bf16_t* gp = (const bf16_t*)(ws + WS_G) + (size_t)row * 2048 + col; const float* bg = args.in[7] + col;
            float v[8], r1[8];
            sgemm_tile(F, (const bf16_t*)(ws + WS_YZ) + (size_t)(MP + rt * 64) * 2048, 2048, (const bf16_t*)(ws + WS_WSSM) + (size_t)(ctile * 64) * 2048, 2048, 2048, v);
            { const u32x4 gv = *(const u32x4*)gp;
#pragma unroll
              for (int e = 0; e < 8; ++e) { const float gg = (e & 1) ? bfhi(gv[e >> 1]) : bflo(gv[e >> 1]); r1[e] = sigmoidf_(gg + bg[e]) * v[e]; } }
            sgemm_tile(F, (const bf16_t*)(ws + WS_O) + (size_t)(MP + rt * 64) * 2048, 2048, (const bf16_t*)(ws + WS_WMLA) + (size_t)(ctile * 64) * 2048, 2048, 2048, v);
            { const u32x4 gv = *(const u32x4*)(gp + 1024);
#pragma unroll
              for (int e = 0; e < 8; ++e) { const float gg = (e & 1) ? bfhi(gv[e >> 1]) : bflo(gv[e >> 1]); r1[e] += sigmoidf_(gg + bg[1024 + e]) * v[e]; } }
            *(u32x4*)((bf16_t*)(ws + WS_U) + (size_t)row * 1024 + col) = (u32x4){pk2(r1[0], r1[1]), pk2(r1[2], r1[3]), pk2(r1[4], r1[5]), pk2(r1[6], r1[7])};
        }
        if (BOTH(5)) GRID_BAR();
    }
    if (IN(6)) for (int rep = 0; rep < NREP(6); ++rep) {
        unsigned char* ws = args.ws;
        pg8::SegOrder S; S.nseg = 1; S.G = F.G; S.c = (int)blockIdx.x; S.dup = 1;
        S.s[0] = pg8::Seg{(const char*)(ws + WS_U), (const char*)(ws + WS_WOUT), MP / 256, 4, 0, (MP / 256) * 4, (size_t)256 * 1024 * 2, (size_t)256 * 1024 * 2}; S.total = S.s[0].count;
        EpiV1 E{(const bf16_t*)(ws + WS_XB), (bf16_t*)(ws + WS_HB), (float*)(ws + WS_ST)};
        pg8::gemm_phase<EpiV1, pg8::SegOrder>(F.lds, 1024, 1024, 1024, S, E);
        for (int tile = F.vcu; tile < 256; tile += F.G) {
            const int rt = tile >> 4, ctile = tile & 15, row = MP + rt * 64 + (F.tid >> 3), col = ctile * 64 + (F.tid & 7) * 8;
            float v[8];
            sgemm_tile(F, (const bf16_t*)(ws + WS_U) + (size_t)(MP + rt * 64) * 1024, 1024, (const bf16_t*)(ws + WS_WOUT) + (size_t)(ctile * 64) * 1024, 1024, 1024, v);
            const float* xr = args.in[1] + (size_t)(row - MP) * 1024 + col; const f32x4 x0 = *(const f32x4*)xr, x1 = *(const f32x4*)(xr + 4);
            const f32x4 a = (f32x4){x0[0] * ALPHA + v[0], x0[1] * ALPHA + v[1], x0[2] * ALPHA + v[2], x0[3] * ALPHA + v[3]}, b = (f32x4){x1[0] * ALPHA + v[4], x1[1] * ALPHA + v[5], x1[2] * ALPHA + v[6], x1[3] * ALPHA + v[7]};
            *(u32x4*)((bf16_t*)(ws + WS_HB) + (size_t)row * 1024 + col) = (u32x4){pk2(a[0], a[1]), pk2(a[2], a[3]), pk2(b[0], b[1]), pk2(b[2], b[3])};
            float s1 = ((a[0] + a[1]) + (a[2] + a[3])) + ((b[0] + b[1]) + (b[2] + b[3]));
            float s2 = ((a[0] * a[0] + a[1] * a[1]) + (a[2] * a[2] + a[3] * a[3])) + ((b[0] * b[0] + b[1] * b[1]) + (b[2] * b[2] + b[3] * b[3]));
            s1 += __shfl_xor(s1, 1); s1 += __shfl_xor(s1, 2); s1 += __shfl_xor(s1, 4); s2 += __shfl_xor(s2, 1); s2 += __shfl_xor(s2, 2); s2 += __shfl_xor(s2, 4);
            if ((F.tid & 7) == 0) { float* stp = (float*)(ws + WS_ST) + 2 * (size_t)row; atomicAdd(stp, s1); atomicAdd(stp + 1, s2); }
        }
        if (BOTH(6)) GRID_BAR();
    }
    if (IN(8)) for (int rep = 0; rep < NREP(8); ++rep) {
        unsigned char* ws = args.ws;
        pg8::SegOrder S; S.nseg = 1; S.G = F.G; S.c = (int)blockIdx.x; S.dup = 1;
        S.s[0] = pg8::Seg{(const char*)(ws + WS_HB), (const char*)(ws + WS_WUP), M / 256, 16, 0, (M / 256) * 16, (size_t)256 * 1024 * 2, (size_t)256 * 1024 * 2}; S.total = S.s[0].count;
        EpiRelu2 E{(bf16_t*)(ws + WS_A1), (const float*)(ws + WS_ST), (const float*)(ws + WS_GW)};
        pg8::gemm_phase<EpiRelu2, pg8::SegOrder>(F.lds, 1024, 1024, 1024, S, E);
        if (BOTH(8)) GRID_BAR();
    }
    if (IN(9)) for (int rep = 0; rep < NREP(9); ++rep) {
        unsigned char* ws = args.ws;
        pg8::SegOrder S; S.nseg = 1; S.G = F.G; S.c = (int)blockIdx.x; S.dup = 1;
        S.s[0] = pg8::Seg{(const char*)(ws + WS_A1), (const char*)(ws + WS_WDOWN), MP / 256, 4, 0, (MP / 256) * 4, (size_t)256 * 4096 * 2, (size_t)256 * 4096 * 2}; S.total = S.s[0].count;
        EpiV2 E{(const bf16_t*)(ws + WS_HB), (const float*)(ws + WS_ST), args.in[22], args.in[23], (bf16_t*)(ws + WS_V2)};
        pg8::gemm_phase<EpiV2, pg8::SegOrder>(F.lds, 4096, 4096, 4096, S, E);
        for (int tile = F.vcu; tile < 256; tile += F.G) {
            const int rt = tile >> 4, ctile = tile & 15, row = MP + rt * 64 + (F.tid >> 3), col = ctile * 64 + (F.tid & 7) * 8;
            float v[8];
            sgemm_tile(F, (const bf16_t*)(ws + WS_A1) + (size_t)(MP + rt * 64) * 4096, 4096, (const bf16_t*)(ws + WS_WDOWN) + (size_t)(ctile * 64) * 4096, 4096, 4096, v);
            const u32x4 xv = *(const u32x4*)((const bf16_t*)(ws + WS_HB) + (size_t)row * 1024 + col); const f32x4 x0 = (f32x4){bflo(xv[0]), bfhi(xv[0]), bflo(xv[1]), bfhi(xv[1])}, x1 = (f32x4){bflo(xv[2]), bfhi(xv[2]), bflo(xv[3]), bfhi(xv[3])};
            const f32x2 ss = *(const f32x2*)((const float*)(ws + WS_ST) + 2 * (size_t)row); const float mu = ss.x * (1.f / 1024.f), rs = 1.0f / sqrtf(ss.y * (1.f / 1024.f) - mu * mu + LN_EPS);
            const f32x4 g0 = *(const f32x4*)(args.in[22] + col), g1v = *(const f32x4*)(args.in[22] + col + 4), b0 = *(const f32x4*)(args.in[23] + col), b1v = *(const f32x4*)(args.in[23] + col + 4);
            const f32x4 h0 = (x0 - mu) * rs * g0 + b0, h1 = (x1 - mu) * rs * g1v + b1v;
            *(u32x4*)((bf16_t*)(ws + WS_V2) + (size_t)row * 1024 + col) = (u32x4){pk2(h0[0] * ALPHA + v[0], h0[1] * ALPHA + v[1]), pk2(h0[2] * ALPHA + v[2], h0[3] * ALPHA + v[3]), pk2(h1[0] * ALPHA + v[4], h1[1] * ALPHA + v[5]), pk2(h1[2] * ALPHA + v[6], h1[3] * ALPHA + v[7])};
        }
        if (BOTH(9)) GRID_BAR();
    }
    if (IN(10)) { ln_rows<true>(F, (const void*)(args.ws + WS_V2), args.in[26], args.in[27], nullptr, nullptr); }
#undef IN
#undef BOTH
}

extern "C" void kernel_launch(void* const* d_in, const int* in_sizes, int n_in, void* d_out, int out_size, void* d_ws, size_t ws_size, hipStream_t stream) {
    static int grid = 0;
    if (grid == 0) {
        int dev = 0, cus = 0;
        if (hipGetDevice(&dev) != hipSuccess || hipDeviceGetAttribute(&cus, hipDeviceAttributeMultiprocessorCount, dev) != hipSuccess) { fprintf(stderr, "kernel_launch: device query failed\n"); grid = -1; return; }
        if (hipFuncSetAttribute((const void*)fwd_kernel, hipFuncAttributeMaxDynamicSharedMemorySize, LDS_BYTES) != hipSuccess) { fprintf(stderr, "kernel_launch: hipFuncSetAttribute failed\n"); grid = -1; return; }
        int per_cu = 0;
        (void)hipOccupancyMaxActiveBlocksPerMultiprocessor(&per_cu, (const void*)fwd_kernel, NTHREADS, LDS_BYTES);
        (void)hipGetLastError();
        if (ws_size < WS_END) { fprintf(stderr, "kernel_launch: workspace too small (%zu < %zu)\n", ws_size, (size_t)WS_END); grid = -1; return; }
        grid = cus;
    }
    if (grid < 0) return;
    (void)hipMemsetAsync((char*)d_ws + WS_CTL, 0, CTL_ZERO_BYTES, stream);
    Args a{};
    for (int i = 0; i < 28; ++i) a.in[i] = (const float*)d_in[i];
    a.out = (float*)d_out; a.ws = (unsigned char*)d_ws;
#if MK_PER_PHASE
    for (int p = 0; p < N_PHASES; ++p) { a.ph_lo = p; a.ph_hi = p + 1; hipLaunchKernelGGL(fwd_kernel, dim3(grid), dim3(NTHREADS), LDS_BYTES, stream, a); }
#else
    a.ph_lo = 0; a.ph_hi = N_PHASES; hipLaunchKernelGGL(fwd_kernel, dim3(grid), dim3(NTHREADS), LDS_BYTES, stream, a);
#endif
}
```

```cpp
#include <hip/hip_runtime.h>
#include <cstdio>
#include <cstdint>

#ifndef MK_PER_PHASE
#define MK_PER_PHASE 0
#endif

#ifndef DIAG_REP
#define DIAG_REP 0
#endif
#ifndef DIAG_DUP_G1
#define DIAG_DUP_G1 1
#define DIAG_DUP_G2 1
#define DIAG_DUP_SSD 1
#define DIAG_DUP_ATT 0
#define DIAG_SMODE 0
#define DIAG_PMODE 0
#endif
#define NREP(k) (((DIAG_REP >> (k)) & 1) ? 2 : 1)
#define LAS __attribute__((address_space(3)))
#define GAS __attribute__((address_space(1)))
typedef unsigned short bf16_t;
typedef short bf16x8 __attribute__((ext_vector_type(8)));
typedef float f32x4 __attribute__((ext_vector_type(4)));
typedef float f32x2 __attribute__((ext_vector_type(2)));
typedef unsigned u32x4 __attribute__((ext_vector_type(4)));
typedef unsigned u32x2 __attribute__((ext_vector_type(2)));

constexpr int D_MODEL = 1024, BATCH = 8, SEQ = 2048, DEC_BATCH = 32, DEC_SEQ = 32, PAST = 4096;
constexpr int MP = BATCH * SEQ, MS = DEC_BATCH * DEC_SEQ, M = MP + MS;
constexpr int D_INNER = 2048, NHEADS = 32, HDIM = 64, NGROUPS = 8, NSTATE = 128, CONV_DIM = 4096;
constexpr int MLA_H = 16, QK_NOPE = 128, QK_ROPE = 64, V_HEAD = 128, Q_RANK = 512, KV_RANK = 512, QHD = 192;
constexpr int D_FF = 4096, IN_COLS = 9312, NPROJ = 9472;
constexpr float RMS_EPS = 1e-6f, LN_EPS = 1e-5f;
constexpr float ALPHA = 1.189207115002721f;
constexpr int SMALL_LD = 1280;

constexpr size_t O_YP = 0, O_YS = 16777216, O_CKVP = 17825792, O_KPEP = 26214400, O_SSMP = 27262976, O_CONVP = 29360128,
                 O_CKVS = 29458432, O_KPES = 29982720, O_SSMS = 30048256, O_CONVS = 38436864;

constexpr size_t MiB = 1u << 20;
constexpr size_t WS_CTL = 0, CTL_ZERO_BYTES = 1 * MiB;
constexpr size_t WS_ROPE = 1 * MiB;
constexpr size_t WS_WIN = 2 * MiB, WS_WQ = 21 * MiB, WS_WUK = 24 * MiB, WS_WUV = 26 * MiB, WS_BQL = 28 * MiB, WS_WUKB = 32 * MiB,
                 WS_WQL = 35 * MiB, WS_WSSM = 43 * MiB, WS_WMLA = 47 * MiB, WS_WOUT = 51 * MiB, WS_WUP = 53 * MiB, WS_WDOWN = 61 * MiB;
constexpr size_t WS_XBC = 72 * MiB;
constexpr size_t WS_Z = 208 * MiB;
constexpr size_t WS_G = 276 * MiB;
constexpr size_t WS_SMALL = 344 * MiB;
constexpr size_t WS_KN = 344 * MiB, WS_V = 408 * MiB;
constexpr size_t WS_XB = 472 * MiB;
constexpr size_t WS_QAN = 987 * MiB, WS_CKVN = 1004 * MiB;
constexpr size_t WS_Q = 506 * MiB;
constexpr size_t WS_U = 506 * MiB, WS_HB = 540 * MiB;
constexpr size_t WS_QLAT = 608 * MiB;
constexpr size_t WS_YZ = 624 * MiB;
constexpr size_t WS_O = 692 * MiB;
constexpr size_t WS_KPER = 760 * MiB, WS_DT = 763 * MiB, WS_SSQ = 766 * MiB;
constexpr size_t WS_CACHE = 769 * MiB;
constexpr int KVLEN = PAST + DEC_SEQ;
constexpr size_t WS_XACT = 692 * MiB;
constexpr size_t WS_BCACT = 916 * MiB;
constexpr size_t WS_GWP = 984 * MiB;
constexpr size_t WS_GW = 985 * MiB;
constexpr size_t WS_ST = 986 * MiB;
constexpr size_t WS_END = 1021 * MiB;
constexpr size_t WS_A1 = WS_XBC, WS_T1 = WS_Z, WS_V2 = WS_Z, WS_HF = WS_G;

constexpr int CW_BAR = 4096;
constexpr int CW_QUEUE = 16384;

constexpr int LDS_BYTES = 163840;
constexpr int LDSCTL_OFF = LDS_BYTES - 512, MISC_OFF = LDSCTL_OFF + 320;
constexpr int NWAVES = 8, NTHREADS = 512;

#define LDS_WAIT() asm volatile("s_waitcnt lgkmcnt(0)" ::: "memory")
#define VM_WAIT() asm volatile("s_waitcnt vmcnt(0)" ::: "memory")
__device__ __forceinline__ unsigned f2bf(float f) { unsigned u = __builtin_bit_cast(unsigned, f); return (u + 0x7fffu + ((u >> 16) & 1u)) >> 16; }
__device__ __forceinline__ unsigned pk2(float lo, float hi) { return f2bf(lo) | (f2bf(hi) << 16); }
__device__ __forceinline__ float bf2f(unsigned short b) { return __builtin_bit_cast(float, (unsigned)b << 16); }
__device__ __forceinline__ float bflo(unsigned w) { return __builtin_bit_cast(float, w << 16); }
__device__ __forceinline__ float bfhi(unsigned w) { return __builtin_bit_cast(float, w & 0xffff0000u); }
__device__ __forceinline__ float wave_sum(float v) {
#pragma unroll
    for (int o = 1; o < 64; o <<= 1) v += __shfl_xor(v, o);
    return v;
}
__device__ __forceinline__ float sigmoidf_(float x) { return __builtin_amdgcn_rcpf(1.f + __builtin_amdgcn_exp2f(-1.4426950408889634f * x)); }
__device__ __forceinline__ float siluf_(float x) { return x * __builtin_amdgcn_rcpf(1.f + __builtin_amdgcn_exp2f(-1.4426950408889634f * x)); }

namespace pg8 {
constexpr int BM = 256, BK = 64, HALF = 128, HTB = HALF * BK * 2, STAGE_BYTES = 8 * HTB;
__host__ __device__ __forceinline__ int lds_byte(int r, int c) { const int st = (r >> 4) * 2 + (c >> 5), rr = r & 15, cc = c & 31, ob = rr * 64 + cc * 2; return st * 1024 + (ob ^ (((ob >> 9) & 1) << 5)); }
__host__ __device__ __forceinline__ void stage_rc(int b, int& R, int& C) { const int st = b / 1024, sb = b % 1024, swz = sb ^ (((sb >> 9) & 1) << 5); R = (st >> 1) * 16 + swz / 64; C = (st & 1) * 32 + (swz % 64) / 2; }
__host__ __device__ __forceinline__ int perm32(int rho) { const int n = rho >> 4, i = rho & 15; return 8 * (i >> 2) + 4 * n + (i & 3); }

struct Unit { const char* a; const char* b; int pm, pn, seg; };

__device__ __forceinline__ unsigned cvt_pk_bf16(float lo, float hi) { unsigned r; asm volatile("v_cvt_pk_bf16_f32 %0, %1, %2" : "=v"(r) : "v"(lo), "v"(hi)); return r; }

template <class Epi, class Sched>
__device__ __forceinline__ void gemm_phase(LAS unsigned char* lds, const int K, const int lda, const int ldb, const Sched& S, const Epi& E) {
    const int tid = threadIdx.x, wid = __builtin_amdgcn_readfirstlane(tid >> 6), lane = tid & 63, wr = wid >> 2, wc = wid & 3, fr = lane & 15, fq = lane >> 4;
    const int nt = K / BK;
    unsigned voffA[2], voffB[2];
#pragma unroll
    for (int i = 0; i < 2; ++i) { int R, C; stage_rc(tid * 16 + i * 8192, R, C); const int Rb = Epi::PERM ? ((R & ~31) + perm32(R & 31)) : R;
        voffA[i] = (unsigned)(R * lda + C) * 2u; voffB[i] = (unsigned)(Rb * ldb + C) * 2u; }
    const size_t kstep = (size_t)(BK * 2);
    const size_t hstepA = (size_t)HALF * lda * 2, hstepB = (size_t)HALF * ldb * 2;
    const unsigned ldsw = (unsigned)wid * 1024u;
    const int aoff = lds_byte(wr * 64 + fr, fq * 8), boff = lds_byte(wc * 32 + fr, fq * 8);
#define PG8_SA(b, h) (((b) * 2 + (h)) * HTB)
#define PG8_SB(b, h) ((4 + (b) * 2 + (h)) * HTB)
#define PG8_STAGE(bufoff, gbase, voff) do { _Pragma("unroll") for (int _i = 0; _i < 2; ++_i) \
        __builtin_amdgcn_global_load_lds((const unsigned*)((const char*)(gbase) + (voff)[_i]), (LAS unsigned*)(lds + (bufoff) + ldsw + _i * 8192), 16, 0, 0); } while (0)
#define PG8_LDA(dst, b, h) do { _Pragma("unroll") for (int m = 0; m < 4; ++m) _Pragma("unroll") for (int k = 0; k < 2; ++k) dst[m][k] = *(const LAS bf16x8*)(lds + PG8_SA(b, h) + aoff + m * 2048 + k * 1024); } while (0)
#define PG8_LDB(dst, b, h) do { _Pragma("unroll") for (int n = 0; n < 2; ++n) _Pragma("unroll") for (int k = 0; k < 2; ++k) dst[n][k] = *(const LAS bf16x8*)(lds + PG8_SB(b, h) + boff + n * 2048 + k * 1024); } while (0)
#define PG8_MMA(ai, bj, At, Bt) do { __builtin_amdgcn_s_setprio(1); _Pragma("unroll") for (int m = 0; m < 4; ++m) _Pragma("unroll") for (int n = 0; n < 2; ++n) _Pragma("unroll") for (int k = 0; k < 2; ++k) \
        acc[ai][bj][m][n] = __builtin_amdgcn_mfma_f32_16x16x32_bf16(Bt[n][k], At[m][k], acc[ai][bj][m][n], 0, 0, 0); __builtin_amdgcn_s_setprio(0); } while (0)
#define PG8_WAIT_V(n) asm volatile("s_waitcnt vmcnt(" #n ")" ::: "memory")
#define PG8_WAIT_L(n) asm volatile("s_waitcnt lgkmcnt(" #n ")" ::: "memory")
#define PG8_BAR __builtin_amdgcn_s_barrier()
#define PG8_SCHED __builtin_amdgcn_sched_barrier(0)
    Unit cur, nxt; int ui = 0;
    if (!S.next(0, cur)) return;
    f32x4 acc[2][2][4][2];
#pragma unroll
    for (int a = 0; a < 2; ++a)
#pragma unroll
        for (int b = 0; b < 2; ++b)
#pragma unroll
            for (int m = 0; m < 4; ++m)
#pragma unroll
                for (int n = 0; n < 2; ++n) acc[a][b][m][n] = (f32x4){0.f, 0.f, 0.f, 0.f};
    bf16x8 At[4][2], B0[2][2], B1[2][2];
    const char* cA = cur.a; const char* cB = cur.b;
    PG8_STAGE(PG8_SB(0, 0), cB, voffB); PG8_STAGE(PG8_SB(0, 1), cB + hstepB, voffB); PG8_STAGE(PG8_SA(0, 0), cA, voffA); PG8_STAGE(PG8_SA(0, 1), cA + hstepA, voffA);
    if (wr == 1) PG8_BAR;
    PG8_WAIT_V(2); PG8_BAR;
    PG8_STAGE(PG8_SB(1, 0), cB + kstep, voffB); PG8_STAGE(PG8_SA(1, 0), cA + kstep, voffA); PG8_STAGE(PG8_SB(1, 1), cB + hstepB + kstep, voffB);
    PG8_WAIT_V(6); PG8_BAR;
    for (;;) {
        const bool has_next = S.next(ui + 1, nxt);
        const char* nA = has_next ? nxt.a : cA; const char* nB = has_next ? nxt.b : cB;
#pragma unroll 1
        for (int t = 0; t < nt; t += 2) {
            const bool last = (t == nt - 2);
            const char* a1 = cA + (size_t)(t + 1) * kstep;
            const char* a2 = last ? nA : cA + (size_t)(t + 2) * kstep; const char* b2 = last ? nB : cB + (size_t)(t + 2) * kstep;
            const char* a3 = a2 + kstep; const char* b3 = b2 + kstep;
            PG8_LDB(B0, 0, 0); PG8_LDB(B1, 0, 1); PG8_SCHED; PG8_LDA(At, 0, 0); PG8_STAGE(PG8_SA(1, 1), a1 + hstepA, voffA);
            PG8_WAIT_V(8); PG8_WAIT_L(0); PG8_BAR; PG8_MMA(0, 0, At, B0); PG8_MMA(0, 1, At, B1); PG8_BAR; PG8_SCHED;
            PG8_LDA(At, 0, 1); PG8_STAGE(PG8_SB(0, 0), b2, voffB); PG8_STAGE(PG8_SB(0, 1), b2 + hstepB, voffB); PG8_STAGE(PG8_SA(0, 0), a2, voffA);
            PG8_WAIT_V(8); PG8_WAIT_L(0); PG8_BAR; PG8_MMA(1, 0, At, B0); PG8_MMA(1, 1, At, B1); PG8_BAR; PG8_SCHED;
            PG8_LDB(B0, 1, 0); PG8_LDB(B1, 1, 1); PG8_SCHED; PG8_LDA(At, 1, 0); PG8_STAGE(PG8_SA(0, 1), a2 + hstepA, voffA);
            PG8_WAIT_V(8); PG8_WAIT_L(0); PG8_BAR; PG8_MMA(0, 0, At, B0); PG8_MMA(0, 1, At, B1); PG8_BAR; PG8_SCHED;
            PG8_LDA(At, 1, 1); PG8_STAGE(PG8_SB(1, 0), b3, voffB); PG8_STAGE(PG8_SB(1, 1), b3 + hstepB, voffB); PG8_STAGE(PG8_SA(1, 0), a3, voffA);
            PG8_WAIT_V(8); PG8_WAIT_L(0); PG8_BAR; PG8_MMA(1, 0, At, B0); PG8_MMA(1, 1, At, B1); PG8_BAR; PG8_SCHED;
        }
        if (wr == 0) PG8_BAR;
        E(acc, cur, wr, wc, fr, fq);
        if (!has_next) break;
#pragma unroll
        for (int a = 0; a < 2; ++a)
#pragma unroll
            for (int b = 0; b < 2; ++b)
#pragma unroll
                for (int m = 0; m < 4; ++m)
#pragma unroll
                    for (int n = 0; n < 2; ++n) acc[a][b][m][n] = (f32x4){0.f, 0.f, 0.f, 0.f};
        cur = nxt; cA = nA; cB = nB; ++ui;
        if (wr == 1) PG8_BAR;
    }
    PG8_WAIT_V(0);
    PG8_BAR;
#undef PG8_SA
#undef PG8_SB
#undef PG8_STAGE
#undef PG8_LDA
#undef PG8_LDB
#undef PG8_MMA
#undef PG8_WAIT_V
#undef PG8_WAIT_L
#undef PG8_BAR
#undef PG8_SCHED
}

struct Seg { const char* A; const char* B; int nM, nN, start, count; size_t a_tile, b_tile; };
struct SegOrder {
    Seg s[4]; int nseg, total, G, c, dup;
    __device__ __forceinline__ bool next(int i, Unit& u) const {
        int L = i * G + c; if (L >= total * dup) return false; if (L >= total) L -= total;
        int k = 0; const char* gA = s[0].A; const char* gB = s[0].B; int gnM = s[0].nM, gnN = s[0].nN, gstart = 0, nwg = s[0].count; size_t gat = s[0].a_tile, gbt = s[0].b_tile;
#pragma unroll
        for (int j = 1; j < 4; ++j) if (j < nseg && L >= s[j].start) { k = j; gA = s[j].A; gB = s[j].B; gnM = s[j].nM; gnN = s[j].nN; gstart = s[j].start; nwg = s[j].count; gat = s[j].a_tile; gbt = s[j].b_tile; }
        int wgid = L - gstart;
        { const int q = nwg / 8, r = nwg % 8, xcd = wgid % 8, off = wgid / 8; wgid = (xcd < r ? xcd * (q + 1) : r * (q + 1) + (xcd - r) * q) + off; }
        const int nig = 8 * gnN, gid = wgid / nig, fm = gid * 8, gsz = (gnM - fm) < 8 ? (gnM - fm) : 8;
        u.pm = fm + ((wgid % nig) % gsz); u.pn = (wgid % nig) / gsz; u.seg = k;
        u.a = gA + (size_t)u.pm * gat; u.b = gB + (size_t)u.pn * gbt; return true;
    }
};
struct WqlOrder {
    const char* A; const char* B; int G, c;
    __device__ __forceinline__ bool next(int i, Unit& u) const {
        const int L = i * G + c; if (L >= 64) return false;
        const int h = L >> 2, pm = (L >> 1) & 1, pn = L & 1;
        u.pm = h * 2 + pm; u.pn = pn; u.seg = 1;
        u.a = A + (size_t)pm * 256 * 2048 * 2 + (size_t)h * 128 * 2; u.b = B + (size_t)h * 512 * 256 * 2 + (size_t)pn * 256 * 256 * 2; return true;
    }
};
}

#define XB_TMO      128
#define XB_XCNT(j)  (256  + 64 * (j))
#define XB_XSUB(j)  (1280 + 64 * (j))
#define XB_XGEN(j)  (2304 + 64 * (j))
#define XB_TOP      3328
#define XB_TOPGEN   3392
#define XCD_BAR_WORDS 3456
#define XB_SPIN_CAP (1u << 18)
__device__ __forceinline__ unsigned xb_ld(unsigned* p)              { return __hip_atomic_load(p, __ATOMIC_RELAXED, __HIP_MEMORY_SCOPE_AGENT); }
__device__ __forceinline__ unsigned xb_add(unsigned* p, unsigned v) { return __hip_atomic_fetch_add(p, v, __ATOMIC_RELAXED, __HIP_MEMORY_SCOPE_AGENT); }
__device__ __forceinline__ unsigned xb_xcc_id() { return (unsigned)__builtin_amdgcn_s_getreg((3 << 11) | 20) & 0xFu; }
#define XB_SPIN(cond, bar) do { unsigned _sp = 0; while (cond) { __builtin_amdgcn_s_sleep(1); \
    if ((++_sp & 255u) == 0u) { if (xb_ld(&(bar)[XB_TMO])) break; if (_sp > XB_SPIN_CAP) { atomicAdd(&(bar)[XB_TMO], 1u); break; } } } } while (0)
struct XcdBarrier { unsigned* bar; unsigned x; volatile LAS unsigned* st; };
__device__ __forceinline__ XcdBarrier xcd_barrier_post(unsigned* bar, volatile LAS unsigned* st) {
    XcdBarrier b; b.bar = bar; b.x = xb_xcc_id(); b.st = st;
    if (threadIdx.x == 0) (void)xb_add(&bar[XB_XCNT(b.x)], 1u);
    return b;
}
__device__ __forceinline__ void xcd_barrier_complete(unsigned* bar, unsigned x, unsigned& nloc, unsigned& nx) {
    const unsigned G = gridDim.x * gridDim.y * gridDim.z;
    unsigned sum, cnt, mine, sp = 0u;
    for (;;) {
        sum = 0u; cnt = 0u; mine = 0u;
#pragma unroll
        for (unsigned j = 0; j < 16; ++j) { const unsigned c = xb_ld(&bar[XB_XCNT(j)]); sum += c; cnt += (c > 0u) ? 1u : 0u; mine = (j == x) ? c : mine; }
        if (sum == G) break;
        __builtin_amdgcn_s_sleep(1);
        if ((++sp & 255u) == 0u) { if (xb_ld(&bar[XB_TMO])) break; if (sp > XB_SPIN_CAP) { atomicAdd(&bar[XB_TMO], 1u); break; } }
    }
    nloc = mine > 0u ? mine : 1u; nx = cnt > 0u ? cnt : 1u;
}
__device__ __forceinline__ void xcd_barrier(const XcdBarrier& b) {
    asm volatile("s_waitcnt vmcnt(0)" ::: "memory");
    __syncthreads();
    if (threadIdx.x == 0) {
        unsigned* bar = b.bar;
        __builtin_amdgcn_s_waitcnt(0);
        unsigned nloc = b.st[0], nx = b.st[1];
        if (nloc == 0u) { xcd_barrier_complete(bar, b.x, nloc, nx); b.st[0] = nloc; b.st[1] = nx; }
        const unsigned old = xb_add(&bar[XB_XSUB(b.x)], 1u);
        const unsigned gen = old / nloc;
        if (old + 1u == (gen + 1u) * nloc) {
            __builtin_amdgcn_fence(__ATOMIC_RELEASE, "agent");
            asm volatile("s_waitcnt vmcnt(0)" ::: "memory");
            const unsigned og = xb_add(&bar[XB_TOP], 1u);
            const unsigned tg = og / nx;
            if (og + 1u == (tg + 1u) * nx) xb_add(&bar[XB_TOPGEN], 1u);
            else XB_SPIN(xb_ld(&bar[XB_TOPGEN]) == tg, bar);
            __builtin_amdgcn_fence(__ATOMIC_ACQUIRE, "agent");
            xb_add(&bar[XB_XGEN(b.x)], 1u);
            asm volatile("s_waitcnt vmcnt(0)" ::: "memory");
        } else {
            XB_SPIN(xb_ld(&bar[XB_XGEN(b.x)]) == gen, bar);
            __builtin_amdgcn_fence(__ATOMIC_ACQUIRE, "agent");
            asm volatile("s_waitcnt vmcnt(0)" ::: "memory");
        }
    }
    __syncthreads();
}

struct Args { const float* in[28]; float* out; unsigned char* ws; int ph_lo, ph_hi; };
struct Frame {
    LAS unsigned char* lds;
    int tid, lane, wave, vcu, G;
    unsigned char* ws; float* out;
};

__device__ __forceinline__ void p0_transpose_item(const float* W, int K, int N, bf16_t* WT, int ldt, int k0, int n0, int drow0, LAS float* scr, int lane, const float* kscale = nullptr) {
    float tv[32];
#pragma unroll
    for (int i = 0; i < 32; ++i) { const int kk = 2 * i + (lane >> 5); tv[i] = __builtin_nontemporal_load(W + (size_t)(k0 + kk) * N + n0 + (lane & 31)); }
#pragma unroll
    for (int i = 0; i < 32; ++i) { const int kk = 2 * i + (lane >> 5); scr[kk * 33 + (lane & 31)] = kscale ? tv[i] * kscale[k0 + kk] : tv[i]; }
    LDS_WAIT(); asm volatile("" ::: "memory");
    const int c = lane & 7;
#pragma unroll
    for (int j = 0; j < 4; ++j) { const int n = (lane >> 3) + 8 * j; const LAS float* s = scr + (8 * c) * 33 + n;
        u32x4 o; o.x = pk2(s[0 * 33], s[1 * 33]); o.y = pk2(s[2 * 33], s[3 * 33]); o.z = pk2(s[4 * 33], s[5 * 33]); o.w = pk2(s[6 * 33], s[7 * 33]);
        *(u32x4*)(WT + (size_t)(drow0 + n) * ldt + k0 + 8 * c) = o; }
    LDS_WAIT(); asm volatile("" ::: "memory");
}
__device__ __forceinline__ int win_dst_col(int n0) {
    if (n0 < 8192) return n0;
    if (n0 < 8224) return 9280 + (n0 - 8192);
    if (n0 < 8736) return 8192 + (n0 - 8224);
    if (n0 < 9248) return 8704 + (n0 - 8736);
    return 9216 + (n0 - 9248);
}
struct TItem { const float* W; int K, N; bf16_t* WT; int kind; };

__device__ __forceinline__ void p0_prologue(Frame& F, const Args& args) {
    LAS float* scr = (LAS float*)(F.lds + F.wave * 16384);
    const int gw = F.vcu * NWAVES + F.wave, NGW = F.G * NWAVES, lane = F.lane;
    unsigned char* ws = F.ws;
    {
        const float* Ws[9] = {args.in[6], args.in[16], args.in[18], args.in[19], args.in[14], args.in[20], args.in[21], args.in[24], args.in[25]};
        const int Ks[9] = {1024, 512, 512, 512, 2048, 2048, 1024, 1024, 4096};
        const int Ns[9] = {IN_COLS, 3072, 2048, 2048, 1024, 1024, 1024, 4096, 1024};
        const size_t Os[9] = {WS_WIN, WS_WQ, WS_WUK, WS_WUV, WS_WSSM, WS_WMLA, WS_WOUT, WS_WUP, WS_WDOWN};
        int base = 0;
#pragma unroll
        for (int w = 0; w < 9; ++w) {
            const int nblk = Ns[w] / 32, nitems = (Ks[w] / 64) * nblk;
            int first = gw - (base % NGW); if (first < 0) first += NGW;
            for (int it = first; it < nitems; it += NGW) {
                const int kb = it / nblk, nb = it % nblk, n0 = 32 * nb;
                const int drow0 = (w == 0) ? win_dst_col(n0) : n0;
                p0_transpose_item(Ws[w], Ks[w], Ns[w], (bf16_t*)(ws + Os[w]), Ks[w], 64 * kb, n0, drow0, scr, lane, (w == 7) ? args.in[22] : nullptr);
            }
            base += nitems;
        }
    }
    const int gt = F.vcu * NTHREADS + F.tid, NGT = F.G * NTHREADS;
    for (int i = gt; i < 20480; i += NGT) ((u32x4*)(ws + WS_WIN + (size_t)9312 * 1024 * 2))[i] = (u32x4){0u, 0u, 0u, 0u};
    {
        const f32x4* xp = (const f32x4*)args.in[0]; const f32x4* xs = (const f32x4*)args.in[1]; u32x4* xb = (u32x4*)(ws + WS_XB);
        const int n8p = MP * D_MODEL / 8, n8 = M * D_MODEL / 8;
        for (int i0 = gt; i0 < n8; i0 += 4 * NGT) {
            f32x4 a[4], b[4];
#pragma unroll
            for (int u = 0; u < 4; ++u) { const int i = i0 + u * NGT; const int ii = (i < n8) ? i : 0; const f32x4* src = (ii < n8p) ? xp + 2 * (size_t)ii : xs + 2 * (size_t)(ii - n8p); a[u] = __builtin_nontemporal_load(src); b[u] = __builtin_nontemporal_load(src + 1); }
#pragma unroll
            for (int u = 0; u < 4; ++u) { const int i = i0 + u * NGT; if (i < n8) xb[i] = (u32x4){pk2(a[u].x, a[u].y), pk2(a[u].z, a[u].w), pk2(b[u].x, b[u].y), pk2(b[u].z, b[u].w)}; }
        }
    }
    {
        const f32x4* src = (const f32x4*)args.in[18]; u32x4* dst = (u32x4*)(ws + WS_WUKB);
        for (int i = gt; i < 512 * 2048 / 8; i += NGT) { const f32x4 a = src[2 * (size_t)i], b = src[2 * (size_t)i + 1]; dst[i] = (u32x4){pk2(a.x, a.y), pk2(a.z, a.w), pk2(b.x, b.y), pk2(b.z, b.w)}; }
        for (int i = gt; i < 64; i += NGT) dst[512 * 2048 / 8 + i] = (u32x4){0u, 0u, 0u, 0u};
    }
    {
        const float* wq = args.in[16]; u32x4* dst = (u32x4*)(ws + WS_BQL);
        for (int i = gt; i < 16 * 512 * 32; i += NGT) {
            const int d8 = i & 31, r = (i >> 5) & 511, h = i >> 14;
            u32x4 o = (u32x4){0u, 0u, 0u, 0u};
            if (d8 < 16) { const f32x4* s = (const f32x4*)(wq + (size_t)r * 3072 + h * 192 + d8 * 8); const f32x4 a = s[0], b = s[1]; o = (u32x4){pk2(a.x, a.y), pk2(a.z, a.w), pk2(b.x, b.y), pk2(b.z, b.w)}; }
            dst[i] = o;
        }
    }
    {
        float* ct = (float*)(ws + WS_ROPE); float* st = ct + 2080 * 32;
        for (int i = gt; i < 2080 * 32; i += NGT) {
            const int p = i >> 5, j = i & 31; const float pos = (float)(p < 2048 ? p : 4096 + (p - 2048));
            const float inv = powf(10000.0f, -(float)(2 * j) / 64.0f); const float ang = pos * inv;
            ct[i] = cosf(ang); st[i] = sinf(ang);
        }
    }
    {
        const float* wup = args.in[24]; const float* g1 = args.in[22]; const float* b1 = args.in[23]; float* part = (float*)(ws + WS_GWP);
        for (int i = gt; i < 32 * 4096; i += NGT) { const int n = i & 4095, ks = i >> 12; float sg = 0.f, sb = 0.f;
#pragma unroll 8
            for (int k = 0; k < 32; ++k) { const float wv_ = wup[(size_t)(ks * 32 + k) * 4096 + n]; sg += bf2f((unsigned short)f2bf(g1[ks * 32 + k] * wv_)); sb += b1[ks * 32 + k] * wv_; }
            part[(ks * 2) * 4096 + n] = sg; part[(ks * 2 + 1) * 4096 + n] = sb; }
    }
}

struct EpiStore {
    static constexpr bool PERM = true;
    bf16_t *b0, *b1, *b2, *b3; int l0, l1, l2, l3;
    __device__ __forceinline__ void operator()(const f32x4 (&acc)[2][2][4][2], const pg8::Unit& u, int wr, int wc, int fr, int fq) const {
        bf16_t* b = (u.seg == 0) ? b0 : (u.seg == 1) ? b1 : (u.seg == 2) ? b2 : b3;
        const int ld = (u.seg == 0) ? l0 : (u.seg == 1) ? l1 : (u.seg == 2) ? l2 : l3;
        bf16_t* p = b + (size_t)(u.pm * 256 + wr * 64 + fr) * ld + u.pn * 256 + wc * 32 + 8 * fq;
#pragma unroll
        for (int ai = 0; ai < 2; ++ai)
#pragma unroll
            for (int m = 0; m < 4; ++m) { bf16_t* rowp = p + (size_t)(ai * 128 + m * 16) * ld;
#pragma unroll
                for (int bj = 0; bj < 2; ++bj) { const f32x4 v0 = acc[ai][bj][m][0], v1 = acc[ai][bj][m][1];
                    *(u32x4*)(rowp + bj * 128) = (u32x4){pg8::cvt_pk_bf16(v0[0], v0[1]), pg8::cvt_pk_bf16(v0[2], v0[3]), pg8::cvt_pk_bf16(v1[0], v1[1]), pg8::cvt_pk_bf16(v1[2], v1[3])}; } }
    }
};

struct EpiProj {
    static constexpr bool PERM = true;
    unsigned char* ws; float* out;
    __device__ __forceinline__ void operator()(const f32x4 (&acc)[2][2][4][2], const pg8::Unit& u, int wr, int wc, int fr, int fq) const {
        const int row0 = u.pm * 256 + wr * 64 + fr, colt = wc * 32 + 8 * fq;
        if (u.pn < 32) {
            bf16_t* base; int ldc, c0;
            if (u.pn < 8) { base = (bf16_t*)(ws + WS_G); ldc = 2048; c0 = u.pn * 256; }
            else if (u.pn < 16) { base = (bf16_t*)(ws + WS_Z); ldc = 2048; c0 = (u.pn - 8) * 256; }
            else { base = (bf16_t*)(ws + WS_XBC); ldc = 4096; c0 = (u.pn - 16) * 256; }
#pragma unroll
            for (int ai = 0; ai < 2; ++ai)
#pragma unroll
                for (int m = 0; m < 4; ++m) { const int row = row0 + ai * 128 + m * 16; bf16_t* rowp = base + (size_t)row * ldc + c0 + colt;
#pragma unroll
                    for (int bj = 0; bj < 2; ++bj) { const f32x4 v0 = acc[ai][bj][m][0], v1 = acc[ai][bj][m][1];
                        *(u32x4*)(rowp + bj * 128) = (u32x4){pg8::cvt_pk_bf16(v0[0], v0[1]), pg8::cvt_pk_bf16(v0[2], v0[3]), pg8::cvt_pk_bf16(v1[0], v1[1]), pg8::cvt_pk_bf16(v1[2], v1[3])}; } }
            if (u.pn >= 16 && ((u.pm & 7) == 7 || u.pm >= MP / 256)) {
#pragma unroll
                for (int ai = 0; ai < 2; ++ai)
#pragma unroll
                    for (int m = 0; m < 4; ++m) { const int row = row0 + ai * 128 + m * 16;
                        long off = -1;
                        if (row < MP) { const int t = row & 2047; if (t >= 2045) off = (long)O_CONVP + ((long)(row >> 11) * 3 + (t - 2045)) * 4096; }
                        else { const int q = (row - MP) & 31; if (q >= 29) off = (long)O_CONVS + ((long)((row - MP) >> 5) * 3 + (q - 29)) * 4096; }
                        if (off >= 0) { float* cp = out + off + c0 + colt;
#pragma unroll
                            for (int bj = 0; bj < 2; ++bj) { *(f32x4*)(cp + bj * 128) = acc[ai][bj][m][0]; *(f32x4*)(cp + bj * 128 + 4) = acc[ai][bj][m][1]; } } }
            }
        } else {
            bf16_t* base = (bf16_t*)(ws + WS_SMALL); const int c0 = (u.pn - 32) * 256;
#pragma unroll
            for (int ai = 0; ai < 2; ++ai)
#pragma unroll
                for (int m = 0; m < 4; ++m) { bf16_t* rowp = base + (size_t)(row0 + ai * 128 + m * 16) * SMALL_LD + c0 + colt;
#pragma unroll
                    for (int bj = 0; bj < 2; ++bj) { const f32x4 v0 = acc[ai][bj][m][0], v1 = acc[ai][bj][m][1];
                        *(u32x4*)(rowp + bj * 128) = (u32x4){pg8::cvt_pk_bf16(v0[0], v0[1]), pg8::cvt_pk_bf16(v0[2], v0[3]), pg8::cvt_pk_bf16(v1[0], v1[1]), pg8::cvt_pk_bf16(v1[2], v1[3])}; } }
        }
    }
};

__device__ __forceinline__ void p1b_rows(Frame& F, const Args& args) {
    const int gw = F.vcu * NWAVES + F.wave, NGW = F.G * NWAVES, lane = F.lane;
    unsigned char* ws = F.ws;
    const float* gq = args.in[15]; const float* gkv = args.in[17]; const float* dtb = args.in[10];
    const float* ct = (const float*)(ws + WS_ROPE); const float* st = ct + 2080 * 32;
    const f32x4 gq0 = *(const f32x4*)(gq + 4 * lane), gq1 = *(const f32x4*)(gq + 256 + 4 * lane);
    const f32x4 gk0 = *(const f32x4*)(gkv + 4 * lane), gk1 = *(const f32x4*)(gkv + 256 + 4 * lane);
    for (int m = gw; m < M; m += NGW) {
        const bf16_t* srow = (const bf16_t*)(ws + WS_SMALL) + (size_t)m * SMALL_LD;
        const u32x2 tq0 = __builtin_nontemporal_load((const u32x2*)(srow + 4 * lane)), tq1 = __builtin_nontemporal_load((const u32x2*)(srow + 256 + 4 * lane));
        const u32x2 tk0 = __builtin_nontemporal_load((const u32x2*)(srow + 512 + 4 * lane)), tk1 = __builtin_nontemporal_load((const u32x2*)(srow + 768 + 4 * lane));
        const f32x4 q0 = (f32x4){bflo(tq0[0]), bfhi(tq0[0]), bflo(tq0[1]), bfhi(tq0[1])}, q1 = (f32x4){bflo(tq1[0]), bfhi(tq1[0]), bflo(tq1[1]), bfhi(tq1[1])};
        const f32x4 k0 = (f32x4){bflo(tk0[0]), bfhi(tk0[0]), bflo(tk0[1]), bfhi(tk0[1])}, k1 = (f32x4){bflo(tk1[0]), bfhi(tk1[0]), bflo(tk1[1]), bfhi(tk1[1])};
        float sq = (q0.x * q0.x + q0.y * q0.y) + (q0.z * q0.z + q0.w * q0.w) + (q1.x * q1.x + q1.y * q1.y) + (q1.z * q1.z + q1.w * q1.w);
        float sk = (k0.x * k0.x + k0.y * k0.y) + (k0.z * k0.z + k0.w * k0.w) + (k1.x * k1.x + k1.y * k1.y) + (k1.z * k1.z + k1.w * k1.w);
        sq = wave_sum(sq); sk = wave_sum(sk);
        const float rq = 1.0f / sqrtf(sq * (1.0f / 512.0f) + RMS_EPS), rk = 1.0f / sqrtf(sk * (1.0f / 512.0f) + RMS_EPS);
        { bf16_t* o = (bf16_t*)(ws + WS_QAN) + (size_t)m * 512;
          const f32x4 a = q0 * rq * gq0, b = q1 * rq * gq1;
          *(u32x2*)(o + 4 * lane) = (u32x2){pk2(a.x, a.y), pk2(a.z, a.w)}; *(u32x2*)(o + 256 + 4 * lane) = (u32x2){pk2(b.x, b.y), pk2(b.z, b.w)}; }
        { bf16_t* o = (bf16_t*)(ws + WS_CKVN) + (size_t)m * 512;
          const f32x4 a = k0 * rk * gk0, b = k1 * rk * gk1;
          *(u32x2*)(o + 4 * lane) = (u32x2){pk2(a.x, a.y), pk2(a.z, a.w)}; *(u32x2*)(o + 256 + 4 * lane) = (u32x2){pk2(b.x, b.y), pk2(b.z, b.w)};
          float* fo = (m < MP) ? F.out + O_CKVP + (size_t)m * 512 : F.out + O_CKVS + (size_t)(m - MP) * 512;
          __builtin_nontemporal_store(a, (f32x4*)(fo + 4 * lane)); __builtin_nontemporal_store(b, (f32x4*)(fo + 256 + 4 * lane));
          if (m >= MP) { bf16_t* cr = (bf16_t*)(ws + WS_CACHE) + ((size_t)((m - MP) >> 5) * KVLEN + PAST + ((m - MP) & 31)) * 576;
              *(u32x2*)(cr + 4 * lane) = (u32x2){pk2(a.x, a.y), pk2(a.z, a.w)}; *(u32x2*)(cr + 256 + 4 * lane) = (u32x2){pk2(b.x, b.y), pk2(b.z, b.w)}; } }
        const int pidx = (m < MP) ? (m & 2047) : 2048 + ((m - MP) & 31);
        if (lane < 32) {
            const float t1 = bf2f(srow[1024 + lane]), t2 = bf2f(srow[1056 + lane]); const float c = ct[pidx * 32 + lane], s = st[pidx * 32 + lane];
            const float o1 = t1 * c - t2 * s, o2 = t1 * s + t2 * c;
            float* fo = (m < MP) ? F.out + O_KPEP + (size_t)m * 64 : F.out + O_KPES + (size_t)(m - MP) * 64;
            fo[lane] = o1; fo[32 + lane] = o2;
            bf16_t* o = (bf16_t*)(ws + WS_KPER) + (size_t)m * 64; o[lane] = (bf16_t)f2bf(o1); o[32 + lane] = (bf16_t)f2bf(o2);
            if (m >= MP) { bf16_t* cr = (bf16_t*)(ws + WS_CACHE) + ((size_t)((m - MP) >> 5) * KVLEN + PAST + ((m - MP) & 31)) * 576 + 512; cr[lane] = (bf16_t)f2bf(o1); cr[32 + lane] = (bf16_t)f2bf(o2); }
        } else {
            const int hh = lane - 32; const float x = bf2f(srow[1088 + hh]) + dtb[hh];
            const float sp = (x > 20.f) ? x : log1pf(expf(x));
            ((float*)(ws + WS_DT))[(size_t)m * 32 + hh] = sp;
        }
    }
}


__device__ __forceinline__ void conv_item(Frame& F, const Args& args, int item) {
    int tid_o = F.tid; asm volatile("" : "+v"(tid_o));
    const int tid = tid_o, rb = item >> 3, sl = item & 7, ch = sl * 512 + (tid & 63) * 8, r0 = rb * 64 + (tid >> 6) * 8;
    unsigned char* ws = F.ws; const bf16_t* xbc = (const bf16_t*)(ws + WS_XBC);
    const float* conv_w = args.in[8]; const float* conv_b = args.in[9];
    float wv[4][8], bv[8];
#pragma unroll
    for (int k = 0; k < 4; ++k) { const f32x4 a = *(const f32x4*)(conv_w + k * 4096 + ch), c = *(const f32x4*)(conv_w + k * 4096 + ch + 4);
        wv[k][0] = a[0]; wv[k][1] = a[1]; wv[k][2] = a[2]; wv[k][3] = a[3]; wv[k][4] = c[0]; wv[k][5] = c[1]; wv[k][6] = c[2]; wv[k][7] = c[3]; }
    { const f32x4 a = *(const f32x4*)(conv_b + ch), c = *(const f32x4*)(conv_b + ch + 4); bv[0] = a[0]; bv[1] = a[1]; bv[2] = a[2]; bv[3] = a[3]; bv[4] = c[0]; bv[5] = c[1]; bv[6] = c[2]; bv[7] = c[3]; }
    float h0[8], h1[8], h2[8];
    const bool prompt = r0 < MP; const int t0 = prompt ? (r0 & 2047) : ((r0 - MP) & 31);
    u32x4 hv[3];
    if (t0 == 0) {
        if (prompt) { hv[0] = hv[1] = hv[2] = (u32x4){0u, 0u, 0u, 0u}; }
        else { const float* sc = args.in[5] + (size_t)((r0 - MP) >> 5) * 3 * 4096 + ch;
#pragma unroll
            for (int k = 0; k < 3; ++k) { const f32x4 a = *(const f32x4*)(sc + k * 4096), c = *(const f32x4*)(sc + k * 4096 + 4); hv[k] = (u32x4){pk2(a.x, a.y), pk2(a.z, a.w), pk2(c.x, c.y), pk2(c.z, c.w)}; } }
    } else {
#pragma unroll
        for (int k = 0; k < 3; ++k) hv[k] = *(const u32x4*)(xbc + (size_t)(r0 - 3 + k) * 4096 + ch);
    }
#pragma unroll
    for (int e = 0; e < 4; ++e) { h0[2 * e] = bflo(hv[0][e]); h0[2 * e + 1] = bfhi(hv[0][e]); h1[2 * e] = bflo(hv[1][e]); h1[2 * e + 1] = bfhi(hv[1][e]); h2[2 * e] = bflo(hv[2][e]); h2[2 * e + 1] = bfhi(hv[2][e]); }
    u32x4 rv[8];
#pragma unroll
    for (int i = 0; i < 8; ++i) rv[i] = (i < 5) ? __builtin_nontemporal_load((const u32x4*)(xbc + (size_t)(r0 + i) * 4096 + ch)) : *(const u32x4*)(xbc + (size_t)(r0 + i) * 4096 + ch);
    bf16_t* dst = (ch < 2048) ? (bf16_t*)(ws + WS_XACT) + (size_t)r0 * 2048 + ch : (bf16_t*)(ws + WS_BCACT) + (size_t)r0 * 2048 + (ch - 2048);
#pragma unroll
    for (int i = 0; i < 8; ++i) {
        float x[8], o[8];
#pragma unroll
        for (int e = 0; e < 4; ++e) { x[2 * e] = bflo(rv[i][e]); x[2 * e + 1] = bfhi(rv[i][e]); }
#pragma unroll
        for (int e = 0; e < 8; ++e) { o[e] = siluf_(bv[e] + wv[0][e] * h0[e] + wv[1][e] * h1[e] + wv[2][e] * h2[e] + wv[3][e] * x[e]); h0[e] = h1[e]; h1[e] = h2[e]; h2[e] = x[e]; }
        *(u32x4*)(dst + (size_t)i * 2048) = (u32x4){pk2(o[0], o[1]), pk2(o[2], o[3]), pk2(o[4], o[5]), pk2(o[6], o[7])};
    }
}

namespace ssd {
constexpr int SC = 272, SX = 144;
constexpr int L_CT = 0, L_BN = L_CT + 64 * SC, L_SB = L_BN + 64 * SC, L_XT = L_SB + 64 * SC, L_XS = L_XT + 64 * SX, L_MM = L_XS + 64 * SX, L_YO = L_MM + 64 * SX, L_SCAL = L_YO + 64 * SX, L_END = L_SCAL + 1024;
static_assert(L_END <= LDSCTL_OFF, "ssd LDS map");
typedef short v4i16 __attribute__((ext_vector_type(4)));
__device__ __forceinline__ v4i16 tr16(LAS const unsigned char* p) { return __builtin_amdgcn_ds_read_tr16_b64_v4i16((LAS v4i16*)p); }
}
__device__ __forceinline__ void ssd_item(Frame& F, const Args& args, int item) {
    using namespace ssd;
    LAS unsigned char* lds = F.lds;
    int tid_o = F.tid; asm volatile("" : "+v"(tid_o));
    const int tid = tid_o, lane = tid & 63, w = F.wave, g = lane >> 4, c16 = lane & 15;
    const bool sample = item >= 256;
    const int bb = sample ? (item - 256) >> 5 : item >> 5, h = item & 31, grp = h >> 2;
    const int nchunks = sample ? 1 : 32, nvalid = sample ? 32 : 64;
    const int rowbase = sample ? MP + bb * 32 : bb * 2048;
    unsigned char* ws = F.ws;
    const bf16_t* xact = (const bf16_t*)(ws + WS_XACT); const bf16_t* bcact = (const bf16_t*)(ws + WS_BCACT); const bf16_t* zbuf = (const bf16_t*)(ws + WS_Z); const float* dtbuf = (const float*)(ws + WS_DT);
    const float a_h = -__expf(args.in[11][h]); const float d_h = args.in[12][h];
    const int it = w >> 1, half = w & 1;
    f32x4 st[4];
#pragma unroll
    for (int nt = 0; nt < 4; ++nt) st[nt] = (f32x4){0.f, 0.f, 0.f, 0.f};
    if (sample) {
        const float* s0 = args.in[4] + ((size_t)(bb * 32 + h) * 64) * 128;
#pragma unroll
        for (int nt = 0; nt < 4; ++nt) st[nt] = *(const f32x4*)(s0 + (size_t)(16 * it + c16) * 128 + 16 * (4 * half + nt) + 4 * g);
    }
    __syncthreads();
#pragma unroll
    for (int nt = 0; nt < 4; ++nt) *(LAS u32x2*)(lds + L_SB + (16 * it + c16) * SC + (16 * (4 * half + nt) + 4 * g) * 2) = (u32x2){pk2(st[nt][0], st[nt][1]), pk2(st[nt][2], st[nt][3])};

    struct PF { u32x4 px, pb[2], pc[2]; float pdt; u32x2 pz[2]; };
    PF pfA, pfB;
    const int prow = tid >> 3, ppx = tid & 7, brow = tid >> 4, bpc = tid & 15;
    auto prefetch = [&](PF& P, int c) {
        const size_t r0 = (size_t)(rowbase + c * 64);
        const u32x4 zero4 = (u32x4){0u, 0u, 0u, 0u};
        P.px = (prow < nvalid) ? *(const u32x4*)(xact + (r0 + prow) * 2048 + h * 64 + ppx * 8) : zero4;
#pragma unroll
        for (int q = 0; q < 2; ++q) { const int rr = brow + 32 * q;
            P.pb[q] = (rr < nvalid) ? *(const u32x4*)(bcact + (r0 + rr) * 2048 + grp * 128 + bpc * 8) : zero4;
            P.pc[q] = (rr < nvalid) ? *(const u32x4*)(bcact + (r0 + rr) * 2048 + 1024 + grp * 128 + bpc * 8) : zero4; }
        P.pdt = (lane < nvalid) ? dtbuf[(r0 + lane) * 32 + h] : 0.f;
#pragma unroll
        for (int pt = 0; pt < 2; ++pt) P.pz[pt] = (16 * it + c16 < nvalid) ? *(const u32x2*)(zbuf + (r0 + 16 * it + c16) * 2048 + h * 64 + 16 * (2 * half + pt) + 4 * g) : (u32x2){0u, 0u};
    };
    prefetch(pfA, 0); if (nchunks > 1) prefetch(pfB, 1);
    const float* cache_c = args.in[2]; const float* cache_k = args.in[3]; bf16_t* cache_dst = (bf16_t*)(ws + WS_CACHE);
    constexpr int NPIECES = DEC_BATCH * PAST * 72;
    auto chunk = [&](PF& P, int c) {
        const size_t r0 = (size_t)(rowbase + c * 64);
        f32x4 cva[3], cvc[3]; int cdo[3];
        if (!sample) {
#pragma unroll
            for (int u = 0; u < 3; ++u) { const int i = ((item * 32 + c) * 3 + u) * 512 + tid; const bool ok = i < NPIECES; const int ii = ok ? i : 0;
                const int pc = ii % 72, row = ii / 72;
                const float* src = (pc < 64) ? cache_c + (size_t)row * 512 + pc * 8 : cache_k + (size_t)row * 64 + (pc - 64) * 8;
                cva[u] = __builtin_nontemporal_load((const f32x4*)src); cvc[u] = __builtin_nontemporal_load((const f32x4*)(src + 4)); cdo[u] = ok ? ((row >> 12) * KVLEN + (row & 4095)) * 72 + pc : -1; }
        }
        const float dtl = P.pdt; float acl = dtl * a_h; const u32x4 px = P.px; const u32x4 pb0 = P.pb[0], pb1 = P.pb[1], pc0 = P.pc[0], pc1 = P.pc[1];
#pragma unroll
        for (int o = 1; o < 64; o <<= 1) { const float t = __shfl_up(acl, o); if (lane >= o) acl += t; }
        const float tot = __shfl(acl, 63), dec = __expf(tot);
        const float s4l = dtl * __expf(tot - acl);
        {
            const float s4r = __shfl(s4l, prow);
            *(LAS u32x4*)(lds + L_XT + prow * SX + ppx * 16) = px;
            *(LAS u32x4*)(lds + L_XS + prow * SX + ppx * 16) = (u32x4){pk2(bflo(px[0]) * s4r, bfhi(px[0]) * s4r), pk2(bflo(px[1]) * s4r, bfhi(px[1]) * s4r), pk2(bflo(px[2]) * s4r, bfhi(px[2]) * s4r), pk2(bflo(px[3]) * s4r, bfhi(px[3]) * s4r)};
            *(LAS u32x4*)(lds + L_BN + brow * SC + bpc * 16) = pb0; *(LAS u32x4*)(lds + L_CT + brow * SC + bpc * 16) = pc0;
            *(LAS u32x4*)(lds + L_BN + (brow + 32) * SC + bpc * 16) = pb1; *(LAS u32x4*)(lds + L_CT + (brow + 32) * SC + bpc * 16) = pc1;
        }
        const u32x2 zc0 = P.pz[0], zc1 = P.pz[1];
        const float acum_i = __shfl(acl, 16 * it + c16);
        if (c + 2 < nchunks) prefetch(P, c + 2);
        __syncthreads();
        f32x4 acc3[2];
        {
            bf16x8 cb[4];
#pragma unroll
            for (int ks = 0; ks < 4; ++ks) cb[ks] = *(LAS const bf16x8*)(lds + L_CT + (16 * it + c16) * SC + (32 * ks + 8 * g) * 2);
#pragma unroll
            for (int t2 = 0; t2 < 2; ++t2) { const int jt = 2 * half + t2; f32x4 a1 = (f32x4){0.f, 0.f, 0.f, 0.f}, a3 = (f32x4){0.f, 0.f, 0.f, 0.f};
                bf16x8 bfr[4], sfr[4];
#pragma unroll
                for (int ks = 0; ks < 4; ++ks) { bfr[ks] = *(LAS const bf16x8*)(lds + L_BN + (16 * jt + c16) * SC + (32 * ks + 8 * g) * 2); sfr[ks] = *(LAS const bf16x8*)(lds + L_SB + (16 * jt + c16) * SC + (32 * ks + 8 * g) * 2); }
#pragma unroll
                for (int ks = 0; ks < 4; ++ks) { a1 = __builtin_amdgcn_mfma_f32_16x16x32_bf16(bfr[ks], cb[ks], a1, 0, 0, 0); a3 = __builtin_amdgcn_mfma_f32_16x16x32_bf16(sfr[ks], cb[ks], a3, 0, 0, 0); }
                acc3[t2] = a3;
                const int i = 16 * it + c16; float mv[4];
#pragma unroll
                for (int r = 0; r < 4; ++r) { const int j = 16 * jt + 4 * g + r; const float acj = __shfl(acl, j), dtj = __shfl(dtl, j); mv[r] = (j <= i) ? a1[r] * __expf(acum_i - acj) * dtj : 0.f; }
                *(LAS u32x2*)(lds + L_MM + i * SX + (16 * jt + 4 * g) * 2) = (u32x2){pk2(mv[0], mv[1]), pk2(mv[2], mv[3])};
            }
        }
        {
            bf16x8 xb[2];
#pragma unroll
            for (int ks = 0; ks < 2; ++ks) { LAS const unsigned char* tp = lds + L_XS + (32 * ks + 8 * g + (c16 >> 2)) * SX + (16 * it + 4 * (c16 & 3)) * 2;
                const v4i16 lo = tr16(tp), hi = tr16(tp + 4 * SX); xb[ks] = (bf16x8){lo[0], lo[1], lo[2], lo[3], hi[0], hi[1], hi[2], hi[3]}; }
#pragma unroll
            for (int nt = 0; nt < 4; ++nt) { f32x4 a4 = st[nt] * dec; const int n0 = 16 * (4 * half + nt);
#pragma unroll
                for (int ks = 0; ks < 2; ++ks) {
                    LAS const unsigned char* tp = lds + L_BN + (32 * ks + 8 * g + (c16 >> 2)) * SC + (n0 + 4 * (c16 & 3)) * 2;
                    const v4i16 lo = tr16(tp), hi = tr16(tp + 4 * SC);
                    a4 = __builtin_amdgcn_mfma_f32_16x16x32_bf16((bf16x8){lo[0], lo[1], lo[2], lo[3], hi[0], hi[1], hi[2], hi[3]}, xb[ks], a4, 0, 0, 0);
                }
                st[nt] = a4; }
        }
        __syncthreads();
        {
            bf16x8 mb[2];
#pragma unroll
            for (int ks = 0; ks < 2; ++ks) mb[ks] = *(LAS const bf16x8*)(lds + L_MM + (16 * it + c16) * SX + (32 * ks + 8 * g) * 2);
            const float ea = __expf(acum_i); const int i = 16 * it + c16;
            float ss = 0.f;
#pragma unroll
            for (int t2 = 0; t2 < 2; ++t2) { const int pt = 2 * half + t2;
                f32x4 y = acc3[t2] * ea;
#pragma unroll
                for (int ks = 0; ks < 2; ++ks) { LAS const unsigned char* tp = lds + L_XT + (32 * ks + 8 * g + (c16 >> 2)) * SX + (16 * pt + 4 * (c16 & 3)) * 2;
                    const v4i16 lo = tr16(tp), hi = tr16(tp + 4 * SX);
                    y = __builtin_amdgcn_mfma_f32_16x16x32_bf16((bf16x8){lo[0], lo[1], lo[2], lo[3], hi[0], hi[1], hi[2], hi[3]}, mb[ks], y, 0, 0, 0); }
                const u32x2 xi = *(LAS const u32x2*)(lds + L_XT + i * SX + (16 * pt + 4 * g) * 2); const u32x2 zz = t2 ? zc1 : zc0;
                const float y0 = (y[0] + d_h * bflo(xi.x)) * siluf_(bflo(zz.x)), y1 = (y[1] + d_h * bfhi(xi.x)) * siluf_(bfhi(zz.x)), y2 = (y[2] + d_h * bflo(xi.y)) * siluf_(bflo(zz.y)), y3 = (y[3] + d_h * bfhi(xi.y)) * siluf_(bfhi(zz.y));
                ss += (y0 * y0 + y1 * y1) + (y2 * y2 + y3 * y3);
                *(LAS u32x2*)(lds + L_YO + i * SX + (16 * pt + 4 * g) * 2) = (u32x2){pk2(y0, y1), pk2(y2, y3)};
            }
            ss += __shfl_xor(ss, 16); ss += __shfl_xor(ss, 32);
            if (g == 0) *(LAS float*)(lds + L_SCAL + half * 256 + i * 4) = ss;
#pragma unroll
            for (int nt = 0; nt < 4; ++nt) *(LAS u32x2*)(lds + L_SB + (16 * it + c16) * SC + (16 * (4 * half + nt) + 4 * g) * 2) = (u32x2){pk2(st[nt][0], st[nt][1]), pk2(st[nt][2], st[nt][3])};
        }
        __syncthreads();
        {
            const int row = tid >> 3, pc8 = tid & 7;
            if (row < nvalid) { const u32x4 v = *(LAS const u32x4*)(lds + L_YO + row * SX + pc8 * 16);
                *(u32x4*)((bf16_t*)(ws + WS_YZ) + (r0 + row) * 2048 + h * 64 + pc8 * 8) = v; }
            if (tid < nvalid) { LAS const float* pp = (LAS const float*)(lds + L_SCAL); ((float*)(ws + WS_SSQ))[(r0 + tid) * 32 + h] = pp[tid] + pp[64 + tid]; }
            if (!sample) {
#pragma unroll
                for (int u = 0; u < 3; ++u) if (cdo[u] >= 0) *(u32x4*)(cache_dst + (size_t)cdo[u] * 8) = (u32x4){pk2(cva[u].x, cva[u].y), pk2(cva[u].z, cva[u].w), pk2(cvc[u].x, cvc[u].y), pk2(cvc[u].z, cvc[u].w)};
            }
        }
    };
    for (int c = 0; c < nchunks; c += 2) { chunk(pfA, c); if (c + 1 < nchunks) chunk(pfB, c + 1); }
    {
        float* so = sample ? F.out + O_SSMS + ((size_t)(bb * 32 + h) * 64) * 128 : F.out + O_SSMP + ((size_t)(bb * 32 + h) * 64) * 128;
#pragma unroll
        for (int nt = 0; nt < 4; ++nt) __builtin_nontemporal_store(st[nt], (f32x4*)(so + (size_t)(16 * it + c16) * 128 + 16 * (4 * half + nt) + 4 * g));
    }
    __syncthreads();
}

namespace att {
typedef float f32x16 __attribute__((ext_vector_type(16)));
typedef short v4i16 __attribute__((ext_vector_type(4)));
__device__ __forceinline__ v4i16 tr16(LAS const unsigned char* p) { return __builtin_amdgcn_ds_read_tr16_b64_v4i16((LAS v4i16*)p); }
constexpr float QSCALE = 0.07216878364870322f * 1.4426950408889634f;
constexpr int PK_STR = 400, PV_STR = 320, PK_BYTES = 64 * PK_STR, PV_BYTES = 64 * PV_STR, PBUF = PK_BYTES + PV_BYTES;
static_assert(2 * PBUF <= LDSCTL_OFF, "prompt attention LDS");
constexpr int SK_STR = 1056, SK_MAIN = 32 * SK_STR, SK_TAIL = 32 * 128, SK_BUF = SK_MAIN + SK_TAIL;
constexpr int SQ_STR = 208, SQ_WAVE = 32 * SQ_STR, SQ_OFF = 2 * SK_BUF;
constexpr int SX_OFF = SQ_OFF + 8 * SQ_WAVE;
static_assert(SX_OFF + 8 * 4096 <= LDSCTL_OFF, "sample attention LDS");
__device__ __forceinline__ unsigned pkbf(float lo, float hi) { return pg8::cvt_pk_bf16(lo, hi); }
__device__ __forceinline__ void glds16(const void* gsrc, unsigned lds_dst) { unsigned keep;
    asm volatile("s_mov_b32 %0, m0\n\ts_mov_b32 m0, %2\n\ts_nop 0\n\tglobal_load_lds_dwordx4 %1, off\n\ts_mov_b32 m0, %0" : "=&s"(keep) : "v"(gsrc), "s"(lds_dst) : "memory"); }
__device__ __forceinline__ void glds16s(const void* sbase, unsigned voff, unsigned lds_dst) { unsigned keep;
    asm volatile("s_mov_b32 %0, m0\n\ts_mov_b32 m0, %2\n\ts_nop 4\n\tglobal_load_lds_dwordx4 %1, %3\n\ts_mov_b32 m0, %0" : "=&s"(keep) : "v"(voff), "s"(lds_dst), "s"(sbase) : "memory"); }
}

template <int MODE> __device__ __forceinline__ void attn_prompt_unit(Frame& F, int b, int h, int qb) {
    using namespace att;
    LAS unsigned char* lds = F.lds; unsigned char* ws = F.ws;
    int tid_o = F.tid; asm volatile("" : "+v"(tid_o));
    const int tid = tid_o, lane = tid & 63, w = F.wave, r32 = lane & 31, hi = lane >> 5, i16 = lane & 15, gi = lane >> 4;
    const bf16_t* qg = (const bf16_t*)(ws + WS_Q); const bf16_t* kn = (const bf16_t*)(ws + WS_KN); const bf16_t* vv = (const bf16_t*)(ws + WS_V); const bf16_t* kpe = (const bf16_t*)(ws + WS_KPER);
    const float* ct = (const float*)(ws + WS_ROPE); const float* st = ct + 2080 * 32;
    const size_t rowb = (size_t)b * SEQ;
    const int NT = 4 * qb + 4, my_last = 4 * qb + (w >> 1);
    bf16x8 qf[12];
    {
        const int pos = 256 * qb + 32 * w + r32; const bf16_t* qrow = qg + (rowb + pos) * 3072 + h * 192 + 8 * hi;
#pragma unroll
        for (int ks = 0; ks < 8; ++ks) { const u32x4 v = *(const u32x4*)(qrow + 16 * ks); u32x4 o;
#pragma unroll
            for (int e = 0; e < 4; ++e) o[e] = pkbf(bflo(v[e]) * QSCALE, bfhi(v[e]) * QSCALE);
            qf[ks] = __builtin_bit_cast(bf16x8, o); }
#pragma unroll
        for (int kp = 0; kp < 2; ++kp) {
            const u32x4 v1 = *(const u32x4*)(qrow + 128 + 16 * kp), v2 = *(const u32x4*)(qrow + 160 + 16 * kp);
            const float* cp = ct + pos * 32 + 16 * kp + 8 * hi; const float* sp = st + pos * 32 + 16 * kp + 8 * hi;
            const f32x4 c0 = *(const f32x4*)cp, c1 = *(const f32x4*)(cp + 4), s0 = *(const f32x4*)sp, s1 = *(const f32x4*)(sp + 4);
            float t1[8], t2[8], o1[8], o2[8];
#pragma unroll
            for (int e = 0; e < 4; ++e) { t1[2 * e] = bflo(v1[e]); t1[2 * e + 1] = bfhi(v1[e]); t2[2 * e] = bflo(v2[e]); t2[2 * e + 1] = bfhi(v2[e]); }
#pragma unroll
            for (int e = 0; e < 8; ++e) { const float c = (e < 4) ? c0[e & 3] : c1[e & 3], sn = (e < 4) ? s0[e & 3] : s1[e & 3];
                o1[e] = (t1[e] * c - t2[e] * sn) * QSCALE; o2[e] = (t1[e] * sn + t2[e] * c) * QSCALE; }
            qf[8 + kp] = __builtin_bit_cast(bf16x8, (u32x4){pkbf(o1[0], o1[1]), pkbf(o1[2], o1[3]), pkbf(o1[4], o1[5]), pkbf(o1[6], o1[7])});
            qf[10 + kp] = __builtin_bit_cast(bf16x8, (u32x4){pkbf(o2[0], o2[1]), pkbf(o2[2], o2[3]), pkbf(o2[4], o2[5]), pkbf(o2[6], o2[7])});
        }
    }
    f32x16 oT[4];
#pragma unroll
    for (int d = 0; d < 4; ++d)
#pragma unroll
        for (int r = 0; r < 16; ++r) oT[d][r] = 0.f;
    float m_run = -INFINITY, l_run = 0.f;
    u32x4 pk[3], pv[2];
    auto gload = [&](int t) {
        const size_t r0 = rowb + (size_t)t * 64;
#pragma unroll
        for (int i = 0; i < 3; ++i) { const int idx = tid + 512 * i, row = idx / 24, pc = idx % 24;
            pk[i] = (pc < 16) ? *(const u32x4*)(kn + (r0 + row) * 2048 + h * 128 + pc * 8) : *(const u32x4*)(kpe + (r0 + row) * 64 + (pc - 16) * 8); }
#pragma unroll
        for (int i = 0; i < 2; ++i) { const int idx = tid + 512 * i, row = idx >> 4, pc = idx & 15; pv[i] = *(const u32x4*)(vv + (r0 + row) * 2048 + h * 128 + pc * 8); }
    };
    auto lstore = [&](int buf) {
        LAS unsigned char* kb = lds + buf * PBUF; LAS unsigned char* vb = kb + PK_BYTES;
#pragma unroll
        for (int i = 0; i < 3; ++i) { const int idx = tid + 512 * i, row = idx / 24, pc = idx % 24; *(LAS u32x4*)(kb + row * PK_STR + pc * 16) = pk[i]; }
#pragma unroll
        for (int i = 0; i < 2; ++i) { const int idx = tid + 512 * i, row = idx >> 4, pc = idx & 15; *(LAS u32x4*)(vb + row * PV_STR + pc * 16) = pv[i]; }
    };
    __syncthreads();
    if (MODE != 1) { gload(0); lstore(0); }
    __syncthreads();
    for (int t = 0; t < NT; ++t) {
        if (MODE != 1 && t + 1 < NT) gload(t + 1);
        if (MODE != 2 && t <= my_last) {
            LAS const unsigned char* kb = lds + (t & 1) * PBUF; LAS const unsigned char* vb = kb + PK_BYTES;
#pragma unroll
            for (int T = 0; T < 2; ++T) {
                f32x16 sT;
#pragma unroll
                for (int r = 0; r < 16; ++r) sT[r] = 0.f;
                {
                    LAS const unsigned char* kp = kb + (32 * T + r32) * PK_STR + 16 * hi;
#define PA_LDK(dst, k0) do { _Pragma("unroll") for (int i_ = 0; i_ < 4; ++i_) dst[i_] = *(LAS const bf16x8*)(kp + ((k0) + i_) * 32); } while (0)
#define PA_MMK(src, k0) do { _Pragma("unroll") for (int i_ = 0; i_ < 4; ++i_) sT = __builtin_amdgcn_mfma_f32_32x32x16_bf16(src[i_], qf[(k0) + i_], sT, 0, 0, 0); } while (0)
                    bf16x8 ka[4], kc[4];
                    PA_LDK(ka, 0); PA_LDK(kc, 4); __builtin_amdgcn_sched_barrier(0);
                    PA_MMK(ka, 0); __builtin_amdgcn_sched_barrier(0);
                    PA_LDK(ka, 8); __builtin_amdgcn_sched_barrier(0);
                    PA_MMK(kc, 4); __builtin_amdgcn_sched_barrier(0);
                    PA_MMK(ka, 8); __builtin_amdgcn_sched_barrier(0);
#undef PA_LDK
#undef PA_MMK
                }
                float mt = sT[0];
#pragma unroll
                for (int r = 1; r < 16; ++r) mt = fmaxf(mt, sT[r]);
                mt = fmaxf(mt, __shfl_xor(mt, 32));
                if (__any(mt > m_run + 8.0f)) {
                    const float m_new = fmaxf(m_run, mt); const float alpha = __builtin_amdgcn_exp2f(m_run - m_new); m_run = m_new; l_run *= alpha;
#pragma unroll
                    for (int d = 0; d < 4; ++d)
#pragma unroll
                        for (int r = 0; r < 16; ++r) oT[d][r] *= alpha;
                }
                float ps = 0.f;
#pragma unroll
                for (int r = 0; r < 16; ++r) { const float p = __builtin_amdgcn_exp2f(sT[r] - m_run); sT[r] = p; ps += p; }
                l_run += ps;
                bf16x8 pf[2];
#pragma unroll
                for (int sp = 0; sp < 2; ++sp) pf[sp] = __builtin_bit_cast(bf16x8, (u32x4){pkbf(sT[8 * sp], sT[8 * sp + 1]), pkbf(sT[8 * sp + 2], sT[8 * sp + 3]), pkbf(sT[8 * sp + 4], sT[8 * sp + 5]), pkbf(sT[8 * sp + 6], sT[8 * sp + 7])});
                __builtin_amdgcn_sched_barrier(0);
                {
                    LAS const unsigned char* tp0 = vb + (32 * T + 4 * hi + (i16 >> 2)) * PV_STR + (16 * (gi & 1) + 4 * (i16 & 3)) * 2;
#define PA_LDV(dst, d_) do { dst[0] = tr16(tp0 + (d_) * 64); dst[1] = tr16(tp0 + (d_) * 64 + 8 * PV_STR); dst[2] = tr16(tp0 + (d_) * 64 + 16 * PV_STR); dst[3] = tr16(tp0 + (d_) * 64 + 24 * PV_STR); } while (0)
#define PA_MMV(src, d_) do { oT[d_] = __builtin_amdgcn_mfma_f32_32x32x16_bf16((bf16x8){src[0][0], src[0][1], src[0][2], src[0][3], src[1][0], src[1][1], src[1][2], src[1][3]}, pf[0], oT[d_], 0, 0, 0); \
                        oT[d_] = __builtin_amdgcn_mfma_f32_32x32x16_bf16((bf16x8){src[2][0], src[2][1], src[2][2], src[2][3], src[3][0], src[3][1], src[3][2], src[3][3]}, pf[1], oT[d_], 0, 0, 0); } while (0)
                    v4i16 va[4], vc[4];
                    PA_LDV(va, 0); PA_LDV(vc, 1); __builtin_amdgcn_sched_barrier(0);
                    PA_MMV(va, 0); __builtin_amdgcn_sched_barrier(0);
                    PA_LDV(va, 2); __builtin_amdgcn_sched_barrier(0);
                    PA_MMV(vc, 1); __builtin_amdgcn_sched_barrier(0);
                    PA_LDV(vc, 3); __builtin_amdgcn_sched_barrier(0);
                    PA_MMV(va, 2); __builtin_amdgcn_sched_barrier(0);
                    PA_MMV(vc, 3); __builtin_amdgcn_sched_barrier(0);
#undef PA_LDV
#undef PA_MMV
                }
            }
        }
        if (MODE != 1 && t + 1 < NT) lstore((t + 1) & 1);
        __syncthreads();
    }
    if (MODE != 0 && l_run != 12345.f) return;
    l_run += __shfl_xor(l_run, 32);
    const float rl = 1.0f / l_run;
    bf16_t* orow = (bf16_t*)(ws + WS_O) + (rowb + 256 * qb + 32 * w + r32) * 2048 + h * 128 + 4 * hi;
#pragma unroll
    for (int d = 0; d < 4; ++d)
#pragma unroll
        for (int u = 0; u < 4; ++u) *(u32x2*)(orow + 32 * d + 8 * u) = (u32x2){pkbf(oT[d][4 * u] * rl, oT[d][4 * u + 1] * rl), pkbf(oT[d][4 * u + 2] * rl, oT[d][4 * u + 3] * rl)};
}

template <int MODE> __device__ __forceinline__ void attn_sample_item(Frame& F, int b, int rg) {
    using namespace att;
    LAS unsigned char* lds = F.lds; unsigned char* ws = F.ws;
    int tid_o = F.tid; asm volatile("" : "+v"(tid_o));
    const int tid = tid_o, lane = tid & 63, w = F.wave, c16 = lane & 15, g = lane >> 4;
    const int wu = __builtin_amdgcn_readfirstlane(w), hh = 4 * rg + (wu >> 1), half = wu & 1;
    const bf16_t* cache = (const bf16_t*)(ws + WS_CACHE) + (size_t)b * KVLEN * 576;
    const float* ct = (const float*)(ws + WS_ROPE); const float* st = ct + 2080 * 32;
    __syncthreads();
    bf16x8 qf[2][6];
    LAS unsigned char* qlp = lds + SQ_OFF + wu * SQ_WAVE + c16 * SQ_STR + 16 * g;
#pragma unroll
    for (int Qb = 0; Qb < 2; ++Qb) {
        const int qrow = b * 32 + 16 * Qb + c16; const bf16_t* ql = (const bf16_t*)(ws + WS_QLAT) + (size_t)qrow * 8192 + hh * 512 + 8 * g + 288 * half;
#pragma unroll
        for (int i = 0; i < 7; ++i) { const u32x4 v = *(const u32x4*)(ql + 32 * i); u32x4 o;
#pragma unroll
            for (int e = 0; e < 4; ++e) o[e] = pkbf(bflo(v[e]) * QSCALE, bfhi(v[e]) * QSCALE);
            if (i < 6) qf[Qb][i] = __builtin_bit_cast(bf16x8, o); else *(LAS u32x4*)(qlp + Qb * 16 * SQ_STR) = o; }
        LAS unsigned char* qd = qlp + Qb * 16 * SQ_STR + 64;
        if (half == 0) {
#pragma unroll
            for (int i = 7; i < 9; ++i) { const u32x4 v = *(const u32x4*)(ql + 32 * i); u32x4 o;
#pragma unroll
                for (int e = 0; e < 4; ++e) o[e] = pkbf(bflo(v[e]) * QSCALE, bfhi(v[e]) * QSCALE);
                *(LAS u32x4*)(qd + (i - 7) * 64) = o; }
        } else {
            const bf16_t* qp = (const bf16_t*)(ws + WS_Q) + (size_t)(MP + qrow) * 3072 + hh * 192 + 128 + 8 * g;
            const u32x4 v1 = *(const u32x4*)qp, v2 = *(const u32x4*)(qp + 32);
            const int pidx = 2048 + 16 * Qb + c16; const float* cp = ct + pidx * 32 + 8 * g; const float* sp = st + pidx * 32 + 8 * g;
            const f32x4 c0 = *(const f32x4*)cp, c1 = *(const f32x4*)(cp + 4), s0 = *(const f32x4*)sp, s1 = *(const f32x4*)(sp + 4);
            float t1[8], t2[8], o1[8], o2[8];
#pragma unroll
            for (int e = 0; e < 4; ++e) { t1[2 * e] = bflo(v1[e]); t1[2 * e + 1] = bfhi(v1[e]); t2[2 * e] = bflo(v2[e]); t2[2 * e + 1] = bfhi(v2[e]); }
#pragma unroll
            for (int e = 0; e < 8; ++e) { const float c = (e < 4) ? c0[e & 3] : c1[e & 3], sn = (e < 4) ? s0[e & 3] : s1[e & 3];
                o1[e] = (t1[e] * c - t2[e] * sn) * QSCALE; o2[e] = (t1[e] * sn + t2[e] * c) * QSCALE; }
            *(LAS u32x4*)(qd) = (u32x4){pkbf(o1[0], o1[1]), pkbf(o1[2], o1[3]), pkbf(o1[4], o1[5]), pkbf(o1[6], o1[7])};
            *(LAS u32x4*)(qd + 64) = (u32x4){pkbf(o2[0], o2[1]), pkbf(o2[2], o2[3]), pkbf(o2[4], o2[5]), pkbf(o2[6], o2[7])};
        }
    }
    f32x4 oT[16][2];
#pragma unroll
    for (int c = 0; c < 16; ++c) { oT[c][0] = (f32x4){0.f, 0.f, 0.f, 0.f}; oT[c][1] = oT[c][0]; }
    float m_run0 = -INFINITY, m_run1 = -INFINITY, l_run0 = 0.f, l_run1 = 0.f;
    const unsigned lds0 = (unsigned)(uintptr_t)lds;
    const unsigned voff_main = (unsigned)lane * 16u, voff_tail = (unsigned)(((lane & 31) * 576 + 512 + (lane >> 5) * 8) * 2);
    auto dma = [&](int t, int buf) {
        const unsigned long long src = (unsigned long long)(uintptr_t)(cache + (size_t)t * 32 * 576);
#pragma unroll
        for (int i = 0; i < 5; ++i) { const int p = wu + 8 * i;
            if (p < 32) { const unsigned long long sb = src + (unsigned long long)p * 1152ull;
                glds16s((const void*)(uintptr_t)(((unsigned long long)(unsigned)__builtin_amdgcn_readfirstlane((unsigned)(sb >> 32)) << 32) | (unsigned)__builtin_amdgcn_readfirstlane((unsigned)sb)), voff_main, (unsigned)__builtin_amdgcn_readfirstlane(lds0 + buf * SK_BUF + p * SK_STR)); }
            else if (p < 36) { const unsigned long long sb = src + (unsigned long long)(p - 32) * 32ull;
                glds16s((const void*)(uintptr_t)(((unsigned long long)(unsigned)__builtin_amdgcn_readfirstlane((unsigned)(sb >> 32)) << 32) | (unsigned)__builtin_amdgcn_readfirstlane((unsigned)sb)), voff_tail, (unsigned)__builtin_amdgcn_readfirstlane(lds0 + buf * SK_BUF + SK_MAIN + (p - 32) * 1024)); } }
    };
    const int kofs = c16 * SK_STR + 16 * g + 576 * half;
    const int kofs7 = half ? SK_MAIN + g * 512 + c16 * 16 : c16 * SK_STR + 16 * g + 448;
    const int k8st = half ? 2048 : 64, ktst = half ? 256 : 16 * SK_STR;
    const int exwo = SX_OFF + wu * 4096, exro = SX_OFF + (wu ^ 1) * 4096;
    constexpr int NT = KVLEN / 32;
    dma(0, 0);
    asm volatile("s_waitcnt vmcnt(0)" ::: "memory");
    __syncthreads();
    for (int t = 0; t < NT; ++t) {
        if (t + 1 < NT) dma(t + 1, (t + 1) & 1);
        LAS const unsigned char* kb = lds + (t & 1) * SK_BUF;
        f32x4 sT[2][2];
        sT[0][0] = (f32x4){0.f, 0.f, 0.f, 0.f}; sT[0][1] = sT[0][0]; sT[1][0] = sT[0][0]; sT[1][1] = sT[0][0];
        {
#define ZK_LD(dst, i) do { if ((i) < 7) { dst[0] = *(LAS const bf16x8*)(kb + kofs + 64 * (i)); dst[1] = *(LAS const bf16x8*)(kb + kofs + 16 * SK_STR + 64 * (i)); } \
                           else { const int o_ = ((i) == 7) ? kofs7 : kofs7 + k8st; dst[0] = *(LAS const bf16x8*)(kb + o_); dst[1] = *(LAS const bf16x8*)(kb + o_ + ktst); } } while (0)
#define ZK_Q(Qb, i) (((i) < 6) ? qf[Qb][(i) < 6 ? (i) : 0] : *(LAS const bf16x8*)(qlp + (Qb) * 16 * SQ_STR + ((i) - 6) * 64))
#define ZK_MM(src, i) do { const bf16x8 qa_ = ZK_Q(0, i), qb_ = ZK_Q(1, i); \
            sT[0][0] = __builtin_amdgcn_mfma_f32_16x16x32_bf16(src[0], qa_, sT[0][0], 0, 0, 0); sT[1][0] = __builtin_amdgcn_mfma_f32_16x16x32_bf16(src[1], qa_, sT[1][0], 0, 0, 0); \
            sT[0][1] = __builtin_amdgcn_mfma_f32_16x16x32_bf16(src[0], qb_, sT[0][1], 0, 0, 0); sT[1][1] = __builtin_amdgcn_mfma_f32_16x16x32_bf16(src[1], qb_, sT[1][1], 0, 0, 0); } while (0)
            bf16x8 ka[2], kc[2], ke[2];
            ZK_LD(ka, 0); ZK_LD(kc, 1); __builtin_amdgcn_sched_barrier(0);
#pragma unroll
            for (int i = 0; i < 9; i += 3) {
                if (i + 2 < 9) { ZK_LD(ke, i + 2); } __builtin_amdgcn_sched_barrier(0);
                ZK_MM(ka, i); __builtin_amdgcn_sched_barrier(0);
                if (i + 3 < 9) { ZK_LD(ka, i + 3); } __builtin_amdgcn_sched_barrier(0);
                ZK_MM(kc, i + 1); __builtin_amdgcn_sched_barrier(0);
                if (i + 4 < 9) { ZK_LD(kc, i + 4); } __builtin_amdgcn_sched_barrier(0);
                ZK_MM(ke, i + 2); __builtin_amdgcn_sched_barrier(0);
            }
#undef ZK_LD
#undef ZK_Q
#undef ZK_MM
        }
        { LAS unsigned char* exw = lds + exwo + lane * 16;
          *(LAS f32x4*)(exw) = sT[0][0]; *(LAS f32x4*)(exw + 1024) = sT[1][0]; *(LAS f32x4*)(exw + 2048) = sT[0][1]; *(LAS f32x4*)(exw + 3072) = sT[1][1]; }
        LAS const unsigned char* tp0 = kb + (4 * g + (c16 >> 2)) * SK_STR + (4 * (c16 & 3)) * 2 + 512 * half;
#define ZV_LD(dst, c0) do { dst[0] = tr16(tp0 + (c0) * 32); dst[1] = tr16(tp0 + (c0) * 32 + 16 * SK_STR); dst[2] = tr16(tp0 + ((c0) + 1) * 32); dst[3] = tr16(tp0 + ((c0) + 1) * 32 + 16 * SK_STR); } while (0)
        v4i16 va[4], vc[4];
        ZV_LD(va, 0);
        __syncthreads();
        { LAS const unsigned char* exr = lds + exro + lane * 16;
          const f32x4 e0 = *(LAS const f32x4*)(exr), e1 = *(LAS const f32x4*)(exr + 1024), e2 = *(LAS const f32x4*)(exr + 2048), e3 = *(LAS const f32x4*)(exr + 3072);
          sT[0][0] = sT[0][0] + e0; sT[1][0] = sT[1][0] + e1; sT[0][1] = sT[0][1] + e2; sT[1][1] = sT[1][1] + e3; }
        float mt0 = fmaxf(fmaxf(fmaxf(sT[0][0][0], sT[0][0][1]), fmaxf(sT[0][0][2], sT[0][0][3])), fmaxf(fmaxf(sT[1][0][0], sT[1][0][1]), fmaxf(sT[1][0][2], sT[1][0][3])));
        float mt1 = fmaxf(fmaxf(fmaxf(sT[0][1][0], sT[0][1][1]), fmaxf(sT[0][1][2], sT[0][1][3])), fmaxf(fmaxf(sT[1][1][0], sT[1][1][1]), fmaxf(sT[1][1][2], sT[1][1][3])));
        if (__any(mt0 > m_run0 + 8.0f || mt1 > m_run1 + 8.0f)) {
            mt0 = fmaxf(mt0, __shfl_xor(mt0, 16)); mt0 = fmaxf(mt0, __shfl_xor(mt0, 32)); mt1 = fmaxf(mt1, __shfl_xor(mt1, 16)); mt1 = fmaxf(mt1, __shfl_xor(mt1, 32));
            const float n0 = fmaxf(m_run0, mt0), n1 = fmaxf(m_run1, mt1); const float a0 = __builtin_amdgcn_exp2f(m_run0 - n0), a1 = __builtin_amdgcn_exp2f(m_run1 - n1);
            m_run0 = n0; m_run1 = n1; l_run0 *= a0; l_run1 *= a1;
#pragma unroll
            for (int c = 0; c < 16; ++c) { oT[c][0] = oT[c][0] * a0; oT[c][1] = oT[c][1] * a1; }
        }
        bf16x8 pf0, pf1;
        { float p[8];
#pragma unroll
          for (int T = 0; T < 2; ++T)
#pragma unroll
              for (int r = 0; r < 4; ++r) { p[4 * T + r] = __builtin_amdgcn_exp2f(sT[T][0][r] - m_run0); l_run0 += p[4 * T + r]; }
          pf0 = __builtin_bit_cast(bf16x8, (u32x4){pkbf(p[0], p[1]), pkbf(p[2], p[3]), pkbf(p[4], p[5]), pkbf(p[6], p[7])});
#pragma unroll
          for (int T = 0; T < 2; ++T)
#pragma unroll
              for (int r = 0; r < 4; ++r) { p[4 * T + r] = __builtin_amdgcn_exp2f(sT[T][1][r] - m_run1); l_run1 += p[4 * T + r]; }
          pf1 = __builtin_bit_cast(bf16x8, (u32x4){pkbf(p[0], p[1]), pkbf(p[2], p[3]), pkbf(p[4], p[5]), pkbf(p[6], p[7])}); }
        {
#define ZV_MM(src, c0) do { const bf16x8 v0_ = (bf16x8){src[0][0], src[0][1], src[0][2], src[0][3], src[1][0], src[1][1], src[1][2], src[1][3]}, v1_ = (bf16x8){src[2][0], src[2][1], src[2][2], src[2][3], src[3][0], src[3][1], src[3][2], src[3][3]}; \
                oT[(c0)][0] = __builtin_amdgcn_mfma_f32_16x16x32_bf16(v0_, pf0, oT[(c0)][0], 0, 0, 0); oT[(c0)][1] = __builtin_amdgcn_mfma_f32_16x16x32_bf16(v0_, pf1, oT[(c0)][1], 0, 0, 0); \
                oT[(c0) + 1][0] = __builtin_amdgcn_mfma_f32_16x16x32_bf16(v1_, pf0, oT[(c0) + 1][0], 0, 0, 0); oT[(c0) + 1][1] = __builtin_amdgcn_mfma_f32_16x16x32_bf16(v1_, pf1, oT[(c0) + 1][1], 0, 0, 0); } while (0)
#pragma unroll
            for (int cb = 0; cb < 8; cb += 2) {
                ZV_LD(vc, 2 * (cb + 1)); __builtin_amdgcn_sched_barrier(0);
                ZV_MM(va, 2 * cb); __builtin_amdgcn_sched_barrier(0);
                if (cb + 2 < 8) { ZV_LD(va, 2 * (cb + 2)); } __builtin_amdgcn_sched_barrier(0);
                ZV_MM(vc, 2 * (cb + 1)); __builtin_amdgcn_sched_barrier(0);
            }
#undef ZV_LD
#undef ZV_MM
        }
        asm volatile("s_waitcnt vmcnt(0)" ::: "memory");
        __syncthreads();
    }
    l_run0 += __shfl_xor(l_run0, 16); l_run0 += __shfl_xor(l_run0, 32); l_run1 += __shfl_xor(l_run1, 16); l_run1 += __shfl_xor(l_run1, 32);
    const float rl0 = 1.0f / l_run0, rl1 = 1.0f / l_run1;
    bf16x8 of[8][2];
#pragma unroll
    for (int kb2 = 0; kb2 < 8; ++kb2) {
        { const f32x4 a = oT[2 * kb2][0] * rl0, c2 = oT[2 * kb2 + 1][0] * rl0; of[kb2][0] = __builtin_bit_cast(bf16x8, (u32x4){pkbf(a[0], a[1]), pkbf(a[2], a[3]), pkbf(c2[0], c2[1]), pkbf(c2[2], c2[3])}); }
        { const f32x4 a = oT[2 * kb2][1] * rl1, c2 = oT[2 * kb2 + 1][1] * rl1; of[kb2][1] = __builtin_bit_cast(bf16x8, (u32x4){pkbf(a[0], a[1]), pkbf(a[2], a[3]), pkbf(c2[0], c2[1]), pkbf(c2[2], c2[3])}); } }
    const bf16_t* wuv = (const bf16_t*)(ws + WS_WUV) + (size_t)(hh * 128 + c16) * 512 + 256 * half + 4 * g;
    LAS unsigned char* e2w = lds + wu * 8192 + lane * 16; LAS const unsigned char* e2r = lds + (wu ^ 1) * 8192 + lane * 16;
    f32x4 keep[8];
#pragma unroll
    for (int vt = 0; vt < 8; ++vt) { f32x4 a0 = (f32x4){0.f, 0.f, 0.f, 0.f}, a1 = a0;
#pragma unroll
        for (int kb2 = 0; kb2 < 8; ++kb2) { const u32x2 w0 = *(const u32x2*)(wuv + (size_t)vt * 16 * 512 + 32 * kb2), w1 = *(const u32x2*)(wuv + (size_t)vt * 16 * 512 + 32 * kb2 + 16);
            const bf16x8 wa = __builtin_bit_cast(bf16x8, (u32x4){w0.x, w0.y, w1.x, w1.y});
            a0 = __builtin_amdgcn_mfma_f32_16x16x32_bf16(wa, of[kb2][0], a0, 0, 0, 0); a1 = __builtin_amdgcn_mfma_f32_16x16x32_bf16(wa, of[kb2][1], a1, 0, 0, 0); }
        keep[vt] = half ? a1 : a0; *(LAS f32x4*)(e2w + vt * 1024) = half ? a0 : a1; }
    __syncthreads();
    bf16_t* orow = (bf16_t*)(ws + WS_O) + (size_t)(MP + b * 32 + 16 * half + c16) * 2048 + hh * 128 + 4 * g;
#pragma unroll
    for (int vt = 0; vt < 8; ++vt) { const f32x4 a = keep[vt] + *(LAS const f32x4*)(e2r + vt * 1024);
        *(u32x2*)(orow + 16 * vt) = (u32x2){pkbf(a[0], a[1]), pkbf(a[2], a[3])}; }
}


struct MixOrder {
    const char *A0, *B0, *A1, *B1; int G, c;
    __device__ __forceinline__ bool next(int i, pg8::Unit& u) const {
        const int idx = (i >> 1) * G + c; if (idx >= (MP / 256) * 4) return false;
        u.pm = idx >> 2; u.pn = idx & 3; u.seg = i & 1;
        u.a = ((i & 1) ? A1 : A0) + (size_t)u.pm * 256 * 2048 * 2; u.b = ((i & 1) ? B1 : B0) + (size_t)u.pn * 256 * 2048 * 2; return true;
    }
};
struct EpiMix {
    static constexpr bool PERM = true;
    const bf16_t* gates; const float* bgate; bf16_t* t1; bf16_t* uo;
    __device__ __forceinline__ void operator()(const f32x4 (&acc)[2][2][4][2], const pg8::Unit& u, int wr, int wc, int fr, int fq) const {
        const int row0 = u.pm * 256 + wr * 64 + fr, col0 = u.pn * 256 + wc * 32 + 8 * fq, gofs = u.seg ? 1024 : 0;
#pragma unroll
        for (int bj = 0; bj < 2; ++bj) { const int col = col0 + bj * 128;
            const f32x4 bg0 = *(const f32x4*)(bgate + gofs + col), bg1 = *(const f32x4*)(bgate + gofs + col + 4);
#pragma unroll
            for (int ai = 0; ai < 2; ++ai)
#pragma unroll
                for (int m = 0; m < 4; ++m) { const size_t row = (size_t)(row0 + ai * 128 + m * 16);
                    const u32x4 gv = *(const u32x4*)(gates + row * 2048 + gofs + col);
                    const f32x4 a0 = acc[ai][bj][m][0], a1 = acc[ai][bj][m][1];
                    f32x4 r0, r1;
                    r0[0] = sigmoidf_(bflo(gv[0]) + bg0[0]) * a0[0]; r0[1] = sigmoidf_(bfhi(gv[0]) + bg0[1]) * a0[1]; r0[2] = sigmoidf_(bflo(gv[1]) + bg0[2]) * a0[2]; r0[3] = sigmoidf_(bfhi(gv[1]) + bg0[3]) * a0[3];
                    r1[0] = sigmoidf_(bflo(gv[2]) + bg1[0]) * a1[0]; r1[1] = sigmoidf_(bfhi(gv[2]) + bg1[1]) * a1[1]; r1[2] = sigmoidf_(bflo(gv[3]) + bg1[2]) * a1[2]; r1[3] = sigmoidf_(bfhi(gv[3]) + bg1[3]) * a1[3];
                    bf16_t* tp = t1 + row * 1024 + col;
                    if (u.seg == 0) { *(u32x4*)tp = (u32x4){pg8::cvt_pk_bf16(r0[0], r0[1]), pg8::cvt_pk_bf16(r0[2], r0[3]), pg8::cvt_pk_bf16(r1[0], r1[1]), pg8::cvt_pk_bf16(r1[2], r1[3])}; }
                    else { const u32x4 pv = *(const u32x4*)tp; r0 = r0 + (f32x4){bflo(pv[0]), bfhi(pv[0]), bflo(pv[1]), bfhi(pv[1])}; r1 = r1 + (f32x4){bflo(pv[2]), bfhi(pv[2]), bflo(pv[3]), bfhi(pv[3])};
                        *(u32x4*)(uo + row * 1024 + col) = (u32x4){pg8::cvt_pk_bf16(r0[0], r0[1]), pg8::cvt_pk_bf16(r0[2], r0[3]), pg8::cvt_pk_bf16(r1[0], r1[1]), pg8::cvt_pk_bf16(r1[2], r1[3])}; } } }
    }
};
struct EpiV1 {
    static constexpr bool PERM = true;
    const bf16_t* xin; bf16_t* ao; float* st;
    __device__ __forceinline__ void operator()(const f32x4 (&acc)[2][2][4][2], const pg8::Unit& u, int wr, int wc, int fr, int fq) const {
        const int row0 = u.pm * 256 + wr * 64 + fr, col0 = u.pn * 256 + wc * 32 + 8 * fq;
#pragma unroll
        for (int ai = 0; ai < 2; ++ai)
#pragma unroll
            for (int m = 0; m < 4; ++m) { const int row = row0 + ai * 128 + m * 16; const bf16_t* rp = xin + (size_t)row * 1024; float s1 = 0.f, s2 = 0.f;
#pragma unroll
                for (int bj = 0; bj < 2; ++bj) { const int col = col0 + bj * 128;
                    const u32x4 xv = *(const u32x4*)(rp + col); const f32x4 x0 = (f32x4){bflo(xv[0]), bfhi(xv[0]), bflo(xv[1]), bfhi(xv[1])}, x1 = (f32x4){bflo(xv[2]), bfhi(xv[2]), bflo(xv[3]), bfhi(xv[3])};
                    const f32x4 a = x0 * ALPHA + acc[ai][bj][m][0], b = x1 * ALPHA + acc[ai][bj][m][1];
                    s1 += ((a[0] + a[1]) + (a[2] + a[3])) + ((b[0] + b[1]) + (b[2] + b[3]));
                    s2 += ((a[0] * a[0] + a[1] * a[1]) + (a[2] * a[2] + a[3] * a[3])) + ((b[0] * b[0] + b[1] * b[1]) + (b[2] * b[2] + b[3] * b[3]));
                    *(u32x4*)(ao + (size_t)row * 1024 + col) = (u32x4){pg8::cvt_pk_bf16(a[0], a[1]), pg8::cvt_pk_bf16(a[2], a[3]), pg8::cvt_pk_bf16(b[0], b[1]), pg8::cvt_pk_bf16(b[2], b[3])}; }
                s1 += __shfl_xor(s1, 16); s1 += __shfl_xor(s1, 32); s2 += __shfl_xor(s2, 16); s2 += __shfl_xor(s2, 32);
                if (fq == 0) { atomicAdd(st + 2 * (size_t)row, s1); atomicAdd(st + 2 * (size_t)row + 1, s2); } }
    }
};
struct EpiV2 {
    static constexpr bool PERM = true;
    const bf16_t* v1i; const float* st; const float* g1; const float* b1; bf16_t* out;
    __device__ __forceinline__ void operator()(const f32x4 (&acc)[2][2][4][2], const pg8::Unit& u, int wr, int wc, int fr, int fq) const {
        const int row0 = u.pm * 256 + wr * 64 + fr, col0 = u.pn * 256 + wc * 32 + 8 * fq;
        f32x4 gA[2][2], bA[2][2];
#pragma unroll
        for (int bj = 0; bj < 2; ++bj) { gA[bj][0] = *(const f32x4*)(g1 + col0 + bj * 128) * ALPHA; gA[bj][1] = *(const f32x4*)(g1 + col0 + bj * 128 + 4) * ALPHA; bA[bj][0] = *(const f32x4*)(b1 + col0 + bj * 128) * ALPHA; bA[bj][1] = *(const f32x4*)(b1 + col0 + bj * 128 + 4) * ALPHA; }
#pragma unroll
        for (int ai = 0; ai < 2; ++ai)
#pragma unroll
            for (int m = 0; m < 4; ++m) { const int row = row0 + ai * 128 + m * 16; const bf16_t* rp = v1i + (size_t)row * 1024;
                const f32x2 ss = *(const f32x2*)(st + 2 * (size_t)row); const float mu = ss.x * (1.f / 1024.f), rs = 1.0f / sqrtf(ss.y * (1.f / 1024.f) - mu * mu + LN_EPS);
#pragma unroll
                for (int bj = 0; bj < 2; ++bj) { const int col = col0 + bj * 128;
                    const u32x4 xv = *(const u32x4*)(rp + col);
                    const f32x4 x0 = ((f32x4){bflo(xv[0]), bfhi(xv[0]), bflo(xv[1]), bfhi(xv[1])} - mu) * rs, x1 = ((f32x4){bflo(xv[2]), bfhi(xv[2]), bflo(xv[3]), bfhi(xv[3])} - mu) * rs;
                    const f32x4 o0 = x0 * gA[bj][0] + bA[bj][0] + acc[ai][bj][m][0], o1 = x1 * gA[bj][1] + bA[bj][1] + acc[ai][bj][m][1];
                    *(u32x4*)(out + (size_t)row * 1024 + col) = (u32x4){pg8::cvt_pk_bf16(o0[0], o0[1]), pg8::cvt_pk_bf16(o0[2], o0[3]), pg8::cvt_pk_bf16(o1[0], o1[1]), pg8::cvt_pk_bf16(o1[2], o1[3])}; } }
    }
};
struct EpiRelu2 {
    static constexpr bool PERM = true;
    bf16_t* out; const float* st; const float* gw;
    __device__ __forceinline__ void operator()(const f32x4 (&acc)[2][2][4][2], const pg8::Unit& u, int wr, int wc, int fr, int fq) const {
        const int row0 = u.pm * 256 + wr * 64 + fr, col0 = u.pn * 256 + wc * 32 + 8 * fq;
        bf16_t* p = out + (size_t)row0 * 4096 + col0;
        f32x4 gA[2][2], bA[2][2];
#pragma unroll
        for (int bj = 0; bj < 2; ++bj) { gA[bj][0] = *(const f32x4*)(gw + col0 + bj * 128); gA[bj][1] = *(const f32x4*)(gw + col0 + bj * 128 + 4); bA[bj][0] = *(const f32x4*)(gw + 4096 + col0 + bj * 128); bA[bj][1] = *(const f32x4*)(gw + 4096 + col0 + bj * 128 + 4); }
#pragma unroll
        for (int ai = 0; ai < 2; ++ai)
#pragma unroll
            for (int m = 0; m < 4; ++m) { const int row = row0 + ai * 128 + m * 16;
                const f32x2 ss = *(const f32x2*)(st + 2 * (size_t)row); const float mu = ss.x * (1.f / 1024.f), rs = 1.0f / sqrtf(ss.y * (1.f / 1024.f) - mu * mu + LN_EPS), rm = rs * mu;
#pragma unroll
                for (int bj = 0; bj < 2; ++bj) { f32x4 v0 = acc[ai][bj][m][0] * rs - gA[bj][0] * rm + bA[bj][0], v1 = acc[ai][bj][m][1] * rs - gA[bj][1] * rm + bA[bj][1];
#pragma unroll
                    for (int e = 0; e < 4; ++e) { const float a = fmaxf(v0[e], 0.f), b = fmaxf(v1[e], 0.f); v0[e] = a * a; v1[e] = b * b; }
                    *(u32x4*)(p + (size_t)(ai * 128 + m * 16) * 4096 + bj * 128) = (u32x4){pg8::cvt_pk_bf16(v0[0], v0[1]), pg8::cvt_pk_bf16(v0[2], v0[3]), pg8::cvt_pk_bf16(v1[0], v1[1]), pg8::cvt_pk_bf16(v1[2], v1[3])}; } }
    }
};
template <bool FINAL> __device__ __forceinline__ void ln_rows(Frame& F, const void* srcv, const float* gam, const float* bet, float* dstf, bf16_t* dstb) {
    const int gw = F.vcu * NWAVES + F.wave, NGW = F.G * NWAVES, lane = F.lane;
    f32x4 gg[4], bb[4];
#pragma unroll
    for (int j = 0; j < 4; ++j) { gg[j] = *(const f32x4*)(gam + 4 * lane + 256 * j); bb[j] = *(const f32x4*)(bet + 4 * lane + 256 * j); }
    for (int m = gw; m < M; m += NGW) {
        f32x4 v[4]; float s = 0.f;
#pragma unroll
        for (int j = 0; j < 4; ++j) {
            if (FINAL) { const u32x2 t = __builtin_nontemporal_load((const u32x2*)((const bf16_t*)srcv + (size_t)m * 1024 + 4 * lane + 256 * j)); v[j] = (f32x4){bflo(t[0]), bfhi(t[0]), bflo(t[1]), bfhi(t[1])}; }
            else v[j] = *(const f32x4*)((const float*)srcv + (size_t)m * 1024 + 4 * lane + 256 * j);
            s += (v[j].x + v[j].y) + (v[j].z + v[j].w); }
        const float mean = wave_sum(s) * (1.f / 1024.f); float s2 = 0.f;
#pragma unroll
        for (int j = 0; j < 4; ++j) { v[j] = v[j] - mean; s2 += (v[j].x * v[j].x + v[j].y * v[j].y) + (v[j].z * v[j].z + v[j].w * v[j].w); }
        const float rstd = 1.f / sqrtf(wave_sum(s2) * (1.f / 1024.f) + LN_EPS);
        float* of = FINAL ? ((m < MP) ? F.out + O_YP + (size_t)m * 1024 : F.out + O_YS + (size_t)(m - MP) * 1024) : dstf + (size_t)m * 1024;
#pragma unroll
        for (int j = 0; j < 4; ++j) { const f32x4 o = v[j] * rstd * gg[j] + bb[j]; if (FINAL) __builtin_nontemporal_store(o, (f32x4*)(of + 4 * lane + 256 * j)); else *(f32x4*)(of + 4 * lane + 256 * j) = o;
            if (!FINAL) *(u32x2*)(dstb + (size_t)m * 1024 + 4 * lane + 256 * j) = (u32x2){pk2(o.x, o.y), pk2(o.z, o.w)}; }
    }
}
__device__ __forceinline__ void yz_norm_item(Frame& F, const float* gain, int pm) {
    int lane_o = F.lane; asm volatile("" : "+v"(lane_o));
    const int lane = lane_o; unsigned char* ws = F.ws;
    f32x4 g0[4], g1[4];
#pragma unroll
    for (int i = 0; i < 4; ++i) { const int ch = lane * 8 + 512 * i; g0[i] = *(const f32x4*)(gain + ch); g1[i] = *(const f32x4*)(gain + ch + 4); }
#pragma unroll 1
    for (int hb = 0; hb < 4; ++hb) {
        u32x4 v[2][4]; f32x4 q4[2][4];
#pragma unroll
        for (int r = 0; r < 2; ++r) { const size_t row = (size_t)pm * 64 + F.wave * 8 + hb * 2 + r; const bf16_t* p = (const bf16_t*)(ws + WS_YZ) + row * 2048; const float* sq = (const float*)(ws + WS_SSQ) + row * 32;
#pragma unroll
            for (int i = 0; i < 4; ++i) { const int ch = lane * 8 + 512 * i; v[r][i] = *(const u32x4*)(p + ch); q4[r][i] = *(const f32x4*)(sq + 4 * (ch >> 8)); } }
#pragma unroll
        for (int r = 0; r < 2; ++r) { const size_t row = (size_t)pm * 64 + F.wave * 8 + hb * 2 + r; bf16_t* p = (bf16_t*)(ws + WS_YZ) + row * 2048;
#pragma unroll
            for (int i = 0; i < 4; ++i) { const int ch = lane * 8 + 512 * i; const f32x4 q = q4[r][i]; const float rs = 1.0f / sqrtf(((q.x + q.y) + (q.z + q.w)) * (1.0f / 256.0f) + RMS_EPS); const u32x4 x = v[r][i];
                *(u32x4*)(p + ch) = (u32x4){pk2(bflo(x[0]) * rs * g0[i][0], bfhi(x[0]) * rs * g0[i][1]), pk2(bflo(x[1]) * rs * g0[i][2], bfhi(x[1]) * rs * g0[i][3]),
                                            pk2(bflo(x[2]) * rs * g1[i][0], bfhi(x[2]) * rs * g1[i][1]), pk2(bflo(x[3]) * rs * g1[i][2], bfhi(x[3]) * rs * g1[i][3])}; } }
    }
}

__device__ __forceinline__ void sgemm_tile(Frame& F, const bf16_t* a0, int lda, const bf16_t* b0, int ldb, int K, float (&v)[8]) {
    int tid_o = F.tid; asm volatile("" : "+v"(tid_o));
    const int tid = tid_o, lane = tid & 63, w = F.wave, c16 = lane & 15, g = lane >> 4;
    const int kw = K >> 3, nks = kw >> 5;
    const bf16_t* ap = a0 + (size_t)c16 * lda + w * kw + 8 * g;
    const bf16_t* bp = b0 + (size_t)c16 * ldb + w * kw + 8 * g;
    f32x4 acc[4][4];
#pragma unroll
    for (int i = 0; i < 4; ++i)
#pragma unroll
        for (int j = 0; j < 4; ++j) acc[i][j] = (f32x4){0.f, 0.f, 0.f, 0.f};
    bf16x8 af[4], bfr[4], an[4], bn[4];
#pragma unroll
    for (int i = 0; i < 4; ++i) { af[i] = *(const bf16x8*)(ap + (size_t)i * 16 * lda); bfr[i] = *(const bf16x8*)(bp + (size_t)i * 16 * ldb); }
    for (int ks = 0; ks < nks; ++ks) {
        const int kn = (ks + 1 < nks) ? (ks + 1) * 32 : ks * 32;
#pragma unroll
        for (int i = 0; i < 4; ++i) { an[i] = *(const bf16x8*)(ap + (size_t)i * 16 * lda + kn); bn[i] = *(const bf16x8*)(bp + (size_t)i * 16 * ldb + kn); }
#pragma unroll
        for (int i = 0; i < 4; ++i)
#pragma unroll
            for (int j = 0; j < 4; ++j) acc[i][j] = __builtin_amdgcn_mfma_f32_16x16x32_bf16(af[i], bfr[j], acc[i][j], 0, 0, 0);
#pragma unroll
        for (int i = 0; i < 4; ++i) { af[i] = an[i]; bfr[i] = bn[i]; }
    }
    __syncthreads();
    LAS float* slab = (LAS float*)(F.lds + w * 16384);
#pragma unroll
    for (int i = 0; i < 4; ++i)
#pragma unroll
        for (int j = 0; j < 4; ++j)
#pragma unroll
            for (int r = 0; r < 4; ++r) slab[(16 * i + 4 * g + r) * 64 + 16 * j + c16] = acc[i][j][r];
    __syncthreads();
    const int row = tid >> 3, c8 = tid & 7;
    f32x4 s0 = (f32x4){0.f, 0.f, 0.f, 0.f}, s1 = s0;
#pragma unroll
    for (int ww = 0; ww < 8; ++ww) { LAS const float* p = (LAS const float*)(F.lds + ww * 16384) + row * 64 + c8 * 8; s0 = s0 + *(LAS const f32x4*)p; s1 = s1 + *(LAS const f32x4*)(p + 4); }
    v[0] = s0[0]; v[1] = s0[1]; v[2] = s0[2]; v[3] = s0[3]; v[4] = s1[0]; v[5] = s1[1]; v[6] = s1[2]; v[7] = s1[3];
}

constexpr int N_PHASES = 11;
__global__ void __launch_bounds__(NTHREADS, 2) fwd_kernel(Args args) {
    extern __shared__ __attribute__((aligned(16))) unsigned char lds_raw[];
    Frame F;
    F.lds = (LAS unsigned char*)lds_raw;
    F.tid = threadIdx.x; F.lane = F.tid & 63; F.wave = __builtin_amdgcn_readfirstlane(F.tid >> 6);
    F.G = gridDim.x; { const int bx = blockIdx.x; F.vcu = (F.G % 8 == 0) ? (bx % 8) * (F.G / 8) + bx / 8 : bx; }
    F.ws = args.ws; F.out = args.out;
    unsigned* ctl = (unsigned*)(args.ws + WS_CTL);
    volatile LAS unsigned* MISC = (volatile LAS unsigned*)(F.lds + MISC_OFF);
    for (int u = F.tid; u < (LDS_BYTES - LDSCTL_OFF) / 4; u += NTHREADS) ((LAS unsigned*)(F.lds + LDSCTL_OFF))[u] = 0u;
    __syncthreads();
    XcdBarrier bar; bar.bar = ctl + CW_BAR; bar.x = 0; bar.st = nullptr;
#if !MK_PER_PHASE
    bar = xcd_barrier_post(ctl + CW_BAR, MISC + 8);
#define GRID_BAR() xcd_barrier(bar)
#else
#define GRID_BAR() do {} while (0)
#endif
    const int lo = args.ph_lo, hi = args.ph_hi;
#define IN(k) (lo <= (k) && (k) < hi)
#define BOTH(k) (IN(k) && IN((k) + 1))

    if (IN(0)) { for (int rep = 0; rep < NREP(0); ++rep) { p0_prologue(F, args); if (BOTH(0)) GRID_BAR(); } }
    if (IN(1)) {
        unsigned char* ws = args.ws;
        {
            pg8::SegOrder S; S.nseg = 1; S.G = F.G; S.c = (int)blockIdx.x; S.dup = 1;
            S.s[0] = pg8::Seg{(const char*)(ws + WS_XB), (const char*)(ws + WS_WIN), M / 256, NPROJ / 256, 0, (M / 256) * (NPROJ / 256), (size_t)256 * 1024 * 2, (size_t)256 * 1024 * 2};
            S.total = S.s[0].count; S.dup = DIAG_DUP_G1;
            EpiProj E{ws, args.out};
            pg8::gemm_phase<EpiProj, pg8::SegOrder>(F.lds, 1024, 1024, 1024, S, E);
        }
        {
            pg8::WqlOrder S{(const char*)(ws + WS_WUKB), (const char*)(ws + WS_BQL), F.G, (int)blockIdx.x};
            bf16_t* wq = (bf16_t*)(ws + WS_WQL); EpiStore E{wq, wq, wq, wq, 512, 512, 512, 512};
            pg8::gemm_phase<EpiStore, pg8::WqlOrder>(F.lds, 256, 2048, 256, S, E);
        }
        if (BOTH(1)) GRID_BAR();
    }
    if (IN(2)) { p1b_rows(F, args);
        {
            const int gt = F.vcu * NTHREADS + F.tid, NGT = F.G * NTHREADS; const float* part = (const float*)(args.ws + WS_GWP); float* gwv = (float*)(args.ws + WS_GW); float* stz = (float*)(args.ws + WS_ST);
            for (int i = gt; i < 2 * 4096; i += NGT) { const int n = i & 4095, wh = i >> 12; float a = 0.f;
#pragma unroll 8
                for (int ks = 0; ks < 32; ++ks) a += part[(ks * 2 + wh) * 4096 + n];
                gwv[i] = a; }
            for (int i = gt; i < M * 2; i += NGT) stz[i] = 0.f;
        }
        for (int item = F.vcu; item < (M / 64) * 8; item += F.G) conv_item(F, args, item);
        if (BOTH(2)) GRID_BAR(); }
    if (IN(3)) {
        unsigned char* ws = args.ws;
        for (int item = F.vcu; item < 1280 + (DIAG_DUP_SSD == 2 ? 1280 : DIAG_DUP_SSD == 3 ? 256 : DIAG_DUP_SSD == 4 ? 1024 : 0); item += F.G) ssd_item(F, args, item < 1280 ? item : (DIAG_DUP_SSD == 4 ? item - 1024 : item - 1280));
        {
            pg8::SegOrder S; S.nseg = 4; S.G = F.G; S.c = (int)blockIdx.x; S.dup = DIAG_DUP_G2;
            const size_t pt = (size_t)256 * 512 * 2;
            S.s[0] = pg8::Seg{(const char*)(ws + WS_QAN), (const char*)(ws + WS_WQ), M / 256, 12, 0, (M / 256) * 12, pt, pt};
            S.s[1] = pg8::Seg{(const char*)(ws + WS_CKVN), (const char*)(ws + WS_WUK), MP / 256, 8, 816, 512, pt, pt};
            S.s[2] = pg8::Seg{(const char*)(ws + WS_CKVN), (const char*)(ws + WS_WUV), MP / 256, 8, 1328, 512, pt, pt};
            S.s[3] = pg8::Seg{(const char*)(ws + WS_QAN) + (size_t)MP * 512 * 2, (const char*)(ws + WS_WQL), MS / 256, 32, 1840, 128, pt, pt};
            S.total = 1968;
            EpiStore E{(bf16_t*)(ws + WS_Q), (bf16_t*)(ws + WS_KN), (bf16_t*)(ws + WS_V), (bf16_t*)(ws + WS_QLAT), 3072, 2048, 2048, 8192};
            pg8::gemm_phase<EpiStore, pg8::SegOrder>(F.lds, 512, 512, 512, S, E);
        }
        if (BOTH(3)) GRID_BAR();
    }
    if (IN(4)) for (int rep = 0; rep < NREP(4); ++rep) {
        constexpr int NNORM = M / 64;
        const int NITEMS = 128 + NNORM + 1024;
        const bool pin_mode = F.G >= 256;
        bool pinned = pin_mode && (F.vcu & 1) == 0 && (F.vcu >> 1) < 128;
        for (;;) {
            __syncthreads();
            if (F.tid == 0) MISC[0] = pinned ? (unsigned)(F.vcu >> 1) : (pin_mode ? 128u : 0u) + __hip_atomic_fetch_add(ctl + CW_QUEUE + 64 * rep, 1u, __ATOMIC_RELAXED, __HIP_MEMORY_SCOPE_AGENT);
            __syncthreads();
            pinned = false;
            const int item = (int)MISC[0];
            if (item >= NITEMS) break;
            if (item < 128) attn_sample_item<0>(F, item >> 2, item & 3);
            else if (item < 128 + NNORM) yz_norm_item(F, args.in[13], item - 128);
            else { const int j = item - 128 - NNORM, qb = 7 - (j >> 7), bh = j & 127; attn_prompt_unit<0>(F, bh >> 4, bh & 15, qb); }
        }
        if (BOTH(4)) GRID_BAR();
    }
    if (IN(5)) for (int rep = 0; rep < NREP(5); ++rep) {
        unsigned char* ws = args.ws;
        MixOrder S{(const char*)(ws + WS_YZ), (const char*)(ws + WS_WSSM), (const char*)(ws + WS_O), (const char*)(ws + WS_WMLA), F.G, (int)blockIdx.x};
        EpiMix E{(const bf16_t*)(ws + WS_G), args.in[7], (bf16_t*)(ws + WS_T1), (bf16_t*)(ws + WS_U)};
        pg8::gemm_phase<EpiMix, MixOrder>(F.lds, 2048, 2048, 2048, S, E);
        for (int tile = F.vcu; tile < 256; tile += F.G) {
            const int rt = tile >> 4, ctile = tile & 15, row = MP + rt * 64 + (F.tid >> 3), col = ctile * 64 + (F.tid & 7) * 8;
            const bf16_t* gp = (const bf16_t*)(ws + WS_G) + (size_t)row * 2048 + col; const float* bg = args.in[7] + col;
            float v[8], r1[8];
            sgemm_tile(F, (const bf16_t*)(ws + WS_YZ) + (size_t)(MP + rt * 64) * 2048, 2048, (const bf16_t*)(ws + WS_WSSM) + (size_t)(ctile * 64) * 2048, 2048, 2048, v);
            { const u32x4 gv = *(const u32x4*)gp;
#pragma unroll
              for (int e = 0; e < 8; ++e) { const float gg = (e & 1) ? bfhi(gv[e >> 1]) : bflo(gv[e >> 1]); r1[e] = sigmoidf_(gg + bg[e]) * v[e]; } }
            sgemm_tile(F, (const bf16_t*)(ws + WS_O) + (size_t)(MP + rt * 64) * 2048, 2048, (const bf16_t*)(ws + WS_WMLA) + (size_t)(ctile * 64) * 2048, 2048, 2048, v);
            { const u32x4 gv = *(const u32x4*)(gp + 1024);
#pragma unroll
              for (int e = 0; e < 8; ++e) { const float gg = (e & 1) ? bfhi(gv[e >> 1]) : bflo(gv[e >> 1]); r1[e] += sigmoidf_(gg + bg[1024 + e]) * v[e]; } }
            *(u32x4*)((bf16_t*)(ws + WS_U) + (size_t)row * 1024 + col) = (u32x4){pk2(r1[0], r1[1]), pk2(r1[2], r1[3]), pk2(r1[4], r1[5]), pk2(r1[6], r1[7])};
        }
        if (BOTH(5)) GRID_BAR();
    }
    if (IN(6)) for (int rep = 0; rep < NREP(6); ++rep) {
        unsigned char* ws = args.ws;
        pg8::SegOrder S; S.nseg = 1; S.G = F.G; S.c = (int)blockIdx.x; S.dup = 1;
        S.s[0] = pg8::Seg{(const char*)(ws + WS_U), (const char*)(ws + WS_WOUT), MP / 256, 4, 0, (MP / 256) * 4, (size_t)256 * 1024 * 2, (size_t)256 * 1024 * 2}; S.total = S.s[0].count;
        EpiV1 E{(const bf16_t*)(ws + WS_XB), (bf16_t*)(ws + WS_HB), (float*)(ws + WS_ST)};
        pg8::gemm_phase<EpiV1, pg8::SegOrder>(F.lds, 1024, 1024, 1024, S, E);
        for (int tile = F.vcu; tile < 256; tile += F.G) {
            const int rt = tile >> 4, ctile = tile & 15, row = MP + rt * 64 + (F.tid >> 3), col = ctile * 64 + (F.tid & 7) * 8;
            float v[8];
            sgemm_tile(F, (const bf16_t*)(ws + WS_U) + (size_t)(MP + rt * 64) * 1024, 1024, (const bf16_t*)(ws + WS_WOUT) + (size_t)(ctile * 64) * 1024, 1024, 1024, v);
            const float* xr = args.in[1] + (size_t)(row - MP) * 1024 + col; const f32x4 x0 = *(const f32x4*)xr, x1 = *(const f32x4*)(xr + 4);
            const f32x4 a = (f32x4){x0[0] * ALPHA + v[0], x0[1] * ALPHA + v[1], x0[2] * ALPHA + v[2], x0[3] * ALPHA + v[3]}, b = (f32x4){x1[0] * ALPHA + v[4], x1[1] * ALPHA + v[5], x1[2] * ALPHA + v[6], x1[3] * ALPHA + v[7]};
            *(u32x4*)((bf16_t*)(ws + WS_HB) + (size_t)row * 1024 + col) = (u32x4){pk2(a[0], a[1]), pk2(a[2], a[3]), pk2(b[0], b[1]), pk2(b[2], b[3])};
            float s1 = ((a[0] + a[1]) + (a[2] + a[3])) + ((b[0] + b[1]) + (b[2] + b[3]));
            float s2 = ((a[0] * a[0] + a[1] * a[1]) + (a[2] * a[2] + a[3] * a[3])) + ((b[0] * b[0] + b[1] * b[1]) + (b[2] * b[2] + b[3] * b[3]));
            s1 += __shfl_xor(s1, 1); s1 += __shfl_xor(s1, 2); s1 += __shfl_xor(s1, 4); s2 += __shfl_xor(s2, 1); s2 += __shfl_xor(s2, 2); s2 += __shfl_xor(s2, 4);
            if ((F.tid & 7) == 0) { float* stp = (float*)(ws + WS_ST) + 2 * (size_t)row; atomicAdd(stp, s1); atomicAdd(stp + 1, s2); }
        }
        if (BOTH(6)) GRID_BAR();
    }
    if (IN(8)) for (int rep = 0; rep < NREP(8); ++rep) {
        unsigned char* ws = args.ws;
        pg8::SegOrder S; S.nseg = 1; S.G = F.G; S.c = (int)blockIdx.x; S.dup = 1;
        S.s[0] = pg8::Seg{(const char*)(ws + WS_HB), (const char*)(ws + WS_WUP), M / 256, 16, 0, (M / 256) * 16, (size_t)256 * 1024 * 2, (size_t)256 * 1024 * 2}; S.total = S.s[0].count;
        EpiRelu2 E{(bf16_t*)(ws + WS_A1), (const float*)(ws + WS_ST), (const float*)(ws + WS_GW)};
        pg8::gemm_phase<EpiRelu2, pg8::SegOrder>(F.lds, 1024, 1024, 1024, S, E);
        if (BOTH(8)) GRID_BAR();
    }
    if (IN(9)) for (int rep = 0; rep < NREP(9); ++rep) {
        unsigned char* ws = args.ws;
        pg8::SegOrder S; S.nseg = 1; S.G = F.G; S.c = (int)blockIdx.x; S.dup = 1;
        S.s[0] = pg8::Seg{(const char*)(ws + WS_A1), (const char*)(ws + WS_WDOWN), MP / 256, 4, 0, (MP / 256) * 4, (size_t)256 * 4096 * 2, (size_t)256 * 4096 * 2}; S.total = S.s[0].count;
        EpiV2 E{(const bf16_t*)(ws + WS_HB), (const float*)(ws + WS_ST), args.in[22], args.in[23], (bf16_t*)(ws + WS_V2)};
        pg8::gemm_phase<EpiV2, pg8::SegOrder>(F.lds, 4096, 4096, 4096, S, E);
        for (int tile = F.vcu; tile < 256; tile += F.G) {
            const int rt = tile >> 4, ctile = tile & 15, row = MP + rt * 64 + (F.tid >> 3), col = ctile * 64 + (F.tid & 7) * 8;
            float v[8];
            sgemm_tile(F, (const bf16_t*)(ws + WS_A1) + (size_t)(MP + rt * 64) * 4096, 4096, (const bf16_t*)(ws + WS_WDOWN) + (size_t)(ctile * 64) * 4096, 4096, 4096, v);
            const u32x4 xv = *(const u32x4*)((const bf16_t*)(ws + WS_HB) + (size_t)row * 1024 + col); const f32x4 x0 = (f32x4){bflo(xv[0]), bfhi(xv[0]), bflo(xv[1]), bfhi(xv[1])}, x1 = (f32x4){bflo(xv[2]), bfhi(xv[2]), bflo(xv[3]), bfhi(xv[3])};
            const f32x2 ss = *(const f32x2*)((const float*)(ws + WS_ST) + 2 * (size_t)row); const float mu = ss.x * (1.f / 1024.f), rs = 1.0f / sqrtf(ss.y * (1.f / 1024.f) - mu * mu + LN_EPS);
            const f32x4 g0 = *(const f32x4*)(args.in[22] + col), g1v = *(const f32x4*)(args.in[22] + col + 4), b0 = *(const f32x4*)(args.in[23] + col), b1v = *(const f32x4*)(args.in[23] + col + 4);
            const f32x4 h0 = (x0 - mu) * rs * g0 + b0, h1 = (x1 - mu) * rs * g1v + b1v;
            *(u32x4*)((bf16_t*)(ws + WS_V2) + (size_t)row * 1024 + col) = (u32x4){pk2(h0[0] * ALPHA + v[0], h0[1] * ALPHA + v[1]), pk2(h0[2] * ALPHA + v[2], h0[3] * ALPHA + v[3]), pk2(h1[0] * ALPHA + v[4], h1[1] * ALPHA + v[5]), pk2(h1[2] * ALPHA + v[6], h1[3] * ALPHA + v[7])};
        }
        if (BOTH(9)) GRID_BAR();
    }
    if (IN(10)) { ln_rows<true>(F, (const void*)(args.ws + WS_V2), args.in[26], args.in[27], nullptr, nullptr); }
#undef IN
#undef BOTH
}

extern "C" void kernel_launch(void* const* d_in, const int* in_sizes, int n_in, void* d_out, int out_size, void* d_ws, size_t ws_size, hipStream_t stream) {
    static int grid = 0;
    if (grid == 0) {
        int dev = 0, cus = 0;
        if (hipGetDevice(&dev) != hipSuccess || hipDeviceGetAttribute(&cus, hipDeviceAttributeMultiprocessorCount, dev) != hipSuccess) { fprintf(stderr, "kernel_launch: device query failed\n"); grid = -1; return; }
        if (hipFuncSetAttribute((const void*)fwd_kernel, hipFuncAttributeMaxDynamicSharedMemorySize, LDS_BYTES) != hipSuccess) { fprintf(stderr, "kernel_launch: hipFuncSetAttribute failed\n"); grid = -1; return; }
        int per_cu = 0;
        (void)hipOccupancyMaxActiveBlocksPerMultiprocessor(&per_cu, (const void*)fwd_kernel, NTHREADS, LDS_BYTES);
        (void)hipGetLastError();
        if (ws_size < WS_END) { fprintf(stderr, "kernel_launch: workspace too small (%zu < %zu)\n", ws_size, (size_t)WS_END); grid = -1; return; }
        grid = cus;
    }
    if (grid < 0) return;
    (void)hipMemsetAsync((char*)d_ws + WS_CTL, 0, CTL_ZERO_BYTES, stream);
    Args a{};
    for (int i = 0; i < 28; ++i) a.in[i] = (const float*)d_in[i];
    a.out = (float*)d_out; a.ws = (unsigned char*)d_ws;
#if MK_PER_PHASE
    for (int p = 0; p < N_PHASES; ++p) { a.ph_lo = p; a.ph_hi = p + 1; hipLaunchKernelGGL(fwd_kernel, dim3(grid), dim3(NTHREADS), LDS_BYTES, stream, a); }
#else
    a.ph_lo = 0; a.ph_hi = N_PHASES; hipLaunchKernelGGL(fwd_kernel, dim3(grid), dim3(NTHREADS), LDS_BYTES, stream, a);
#endif
}
```

```cpp
#include <hip/hip_runtime.h>
#include <cstdio>
#include <cstdint>

#ifndef MK_PER_PHASE
#define MK_PER_PHASE 0
#endif

#ifndef DIAG_REP
#define DIAG_REP 0
#endif
#ifndef DIAG_DUP_G1
#define DIAG_DUP_G1 1
#define DIAG_DUP_G2 1
#define DIAG_DUP_SSD 1
#define DIAG_DUP_ATT 0
#define DIAG_SMODE 0
#define DIAG_PMODE 0
#endif
#define NREP(k) (((DIAG_REP >> (k)) & 1) ? 2 : 1)
#define LAS __attribute__((address_space(3)))
#define GAS __attribute__((address_space(1)))
typedef unsigned short bf16_t;
typedef short bf16x8 __attribute__((ext_vector_type(8)));
typedef float f32x4 __attribute__((ext_vector_type(4)));
typedef float f32x2 __attribute__((ext_vector_type(2)));
typedef unsigned u32x4 __attribute__((ext_vector_type(4)));
typedef unsigned u32x2 __attribute__((ext_vector_type(2)));

constexpr int D_MODEL = 1024, BATCH = 8, SEQ = 2048, DEC_BATCH = 32, DEC_SEQ = 32, PAST = 4096;
constexpr int MP = BATCH * SEQ, MS = DEC_BATCH * DEC_SEQ, M = MP + MS;
constexpr int D_INNER = 2048, NHEADS = 32, HDIM = 64, NGROUPS = 8, NSTATE = 128, CONV_DIM = 4096;
constexpr int MLA_H = 16, QK_NOPE = 128, QK_ROPE = 64, V_HEAD = 128, Q_RANK = 512, KV_RANK = 512, QHD = 192;
constexpr int D_FF = 4096, IN_COLS = 9312, NPROJ = 9472;
constexpr float RMS_EPS = 1e-6f, LN_EPS = 1e-5f;
constexpr float ALPHA = 1.189207115002721f;
constexpr int SMALL_LD = 1280;

constexpr size_t O_YP = 0, O_YS = 16777216, O_CKVP = 17825792, O_KPEP = 26214400, O_SSMP = 27262976, O_CONVP = 29360128,
                 O_CKVS = 29458432, O_KPES = 29982720, O_SSMS = 30048256, O_CONVS = 38436864;

constexpr size_t MiB = 1u << 20;
constexpr size_t WS_CTL = 0, CTL_ZERO_BYTES = 1 * MiB;
constexpr size_t WS_ROPE = 1 * MiB;
constexpr size_t WS_WIN = 2 * MiB, WS_WQ = 21 * MiB, WS_WUK = 24 * MiB, WS_WUV = 26 * MiB, WS_BQL = 28 * MiB, WS_WUKB = 32 * MiB,
                 WS_WQL = 35 * MiB, WS_WSSM = 43 * MiB, WS_WMLA = 47 * MiB, WS_WOUT = 51 * MiB, WS_WUP = 53 * MiB, WS_WDOWN = 61 * MiB;
constexpr size_t WS_XBC = 72 * MiB;
constexpr size_t WS_Z = 208 * MiB;
constexpr size_t WS_G = 276 * MiB;
constexpr size_t WS_SMALL = 344 * MiB;
constexpr size_t WS_KN = 344 * MiB, WS_V = 408 * MiB;
constexpr size_t WS_XB = 472 * MiB;
constexpr size_t WS_QAN = 987 * MiB, WS_CKVN = 1004 * MiB;
constexpr size_t WS_Q = 506 * MiB;
constexpr size_t WS_U = 506 * MiB, WS_HB = 540 * MiB;
constexpr size_t WS_QLAT = 608 * MiB;
constexpr size_t WS_YZ = 624 * MiB;
constexpr size_t WS_O = 692 * MiB;
constexpr size_t WS_KPER = 760 * MiB, WS_DT = 763 * MiB, WS_SSQ = 766 * MiB;
constexpr size_t WS_CACHE = 769 * MiB;
constexpr int KVLEN = PAST + DEC_SEQ;
constexpr size_t WS_XACT = 692 * MiB;
constexpr size_t WS_BCACT = 916 * MiB;
constexpr size_t WS_GWP = 984 * MiB;
constexpr size_t WS_GW = 985 * MiB;
constexpr size_t WS_ST = 986 * MiB;
constexpr size_t WS_END = 1021 * MiB;
constexpr size_t WS_A1 = WS_XBC, WS_T1 = WS_Z, WS_V2 = WS_Z, WS_HF = WS_G;

constexpr int CW_BAR = 4096;
constexpr int CW_QUEUE = 16384;

constexpr int LDS_BYTES = 163840;
constexpr int LDSCTL_OFF = LDS_BYTES - 512, MISC_OFF = LDSCTL_OFF + 320;
constexpr int NWAVES = 8, NTHREADS = 512;

#define LDS_WAIT() asm volatile("s_waitcnt lgkmcnt(0)" ::: "memory")
#define VM_WAIT() asm volatile("s_waitcnt vmcnt(0)" ::: "memory")
__device__ __forceinline__ unsigned f2bf(float f) { unsigned u = __builtin_bit_cast(unsigned, f); return (u + 0x7fffu + ((u >> 16) & 1u)) >> 16; }
__device__ __forceinline__ unsigned pk2(float lo, float hi) { return f2bf(lo) | (f2bf(hi) << 16); }
__device__ __forceinline__ float bf2f(unsigned short b) { return __builtin_bit_cast(float, (unsigned)b << 16); }
__device__ __forceinline__ float bflo(unsigned w) { return __builtin_bit_cast(float, w << 16); }
__device__ __forceinline__ float bfhi(unsigned w) { return __builtin_bit_cast(float, w & 0xffff0000u); }
__device__ __forceinline__ float wave_sum(float v) {
#pragma unroll
    for (int o = 1; o < 64; o <<= 1) v += __shfl_xor(v, o);
    return v;
}
__device__ __forceinline__ float sigmoidf_(float x) { return __builtin_amdgcn_rcpf(1.f + __builtin_amdgcn_exp2f(-1.4426950408889634f * x)); }
__device__ __forceinline__ float siluf_(float x) { return x * __builtin_amdgcn_rcpf(1.f + __builtin_amdgcn_exp2f(-1.4426950408889634f * x)); }

namespace pg8 {
constexpr int BM = 256, BK = 64, HALF = 128, HTB = HALF * BK * 2, STAGE_BYTES = 8 * HTB;
__host__ __device__ __forceinline__ int lds_byte(int r, int c) { const int st = (r >> 4) * 2 + (c >> 5), rr = r & 15, cc = c & 31, ob = rr * 64 + cc * 2; return st * 1024 + (ob ^ (((ob >> 9) & 1) << 5)); }
__host__ __device__ __forceinline__ void stage_rc(int b, int& R, int& C) { const int st = b / 1024, sb = b % 1024, swz = sb ^ (((sb >> 9) & 1) << 5); R = (st >> 1) * 16 + swz / 64; C = (st & 1) * 32 + (swz % 64) / 2; }
__host__ __device__ __forceinline__ int perm32(int rho) { const int n = rho >> 4, i = rho & 15; return 8 * (i >> 2) + 4 * n + (i & 3); }

struct Unit { const char* a; const char* b; int pm, pn, seg; };

__device__ __forceinline__ unsigned cvt_pk_bf16(float lo, float hi) { unsigned r; asm volatile("v_cvt_pk_bf16_f32 %0, %1, %2" : "=v"(r) : "v"(lo), "v"(hi)); return r; }

template <class Epi, class Sched>
__device__ __forceinline__ void gemm_phase(LAS unsigned char* lds, const int K, const int lda, const int ldb, const Sched& S, const Epi& E) {
    const int tid = threadIdx.x, wid = __builtin_amdgcn_readfirstlane(tid >> 6), lane = tid & 63, wr = wid >> 2, wc = wid & 3, fr = lane & 15, fq = lane >> 4;
    const int nt = K / BK;
    unsigned voffA[2], voffB[2];
#pragma unroll
    for (int i = 0; i < 2; ++i) { int R, C; stage_rc(tid * 16 + i * 8192, R, C); const int Rb = Epi::PERM ? ((R & ~31) + perm32(R & 31)) : R;
        voffA[i] = (unsigned)(R * lda + C) * 2u; voffB[i] = (unsigned)(Rb * ldb + C) * 2u; }
    const size_t kstep = (size_t)(BK * 2);
    const size_t hstepA = (size_t)HALF * lda * 2, hstepB = (size_t)HALF * ldb * 2;
    const unsigned ldsw = (unsigned)wid * 1024u;
    const int aoff = lds_byte(wr * 64 + fr, fq * 8), boff = lds_byte(wc * 32 + fr, fq * 8);
#define PG8_SA(b, h) (((b) * 2 + (h)) * HTB)
#define PG8_SB(b, h) ((4 + (b) * 2 + (h)) * HTB)
#define PG8_STAGE(bufoff, gbase, voff) do { _Pragma("unroll") for (int _i = 0; _i < 2; ++_i) \
        __builtin_amdgcn_global_load_lds((const unsigned*)((const char*)(gbase) + (voff)[_i]), (LAS unsigned*)(lds + (bufoff) + ldsw + _i * 8192), 16, 0, 0); } while (0)
#define PG8_LDA(dst, b, h) do { _Pragma("unroll") for (int m = 0; m < 4; ++m) _Pragma("unroll") for (int k = 0; k < 2; ++k) dst[m][k] = *(const LAS bf16x8*)(lds + PG8_SA(b, h) + aoff + m * 2048 + k * 1024); } while (0)
#define PG8_LDB(dst, b, h) do { _Pragma("unroll") for (int n = 0; n < 2; ++n) _Pragma("unroll") for (int k = 0; k < 2; ++k) dst[n][k] = *(const LAS bf16x8*)(lds + PG8_SB(b, h) + boff + n * 2048 + k * 1024); } while (0)
#define PG8_MMA(ai, bj, At, Bt) do { __builtin_amdgcn_s_setprio(1); _Pragma("unroll") for (int m = 0; m < 4; ++m) _Pragma("unroll") for (int n = 0; n < 2; ++n) _Pragma("unroll") for (int k = 0; k < 2; ++k) \
        acc[ai][bj][m][n] = __builtin_amdgcn_mfma_f32_16x16x32_bf16(Bt[n][k], At[m][k], acc[ai][bj][m][n], 0, 0, 0); __builtin_amdgcn_s_setprio(0); } while (0)
#define PG8_WAIT_V(n) asm volatile("s_waitcnt vmcnt(" #n ")" ::: "memory")
#define PG8_WAIT_L(n) asm volatile("s_waitcnt lgkmcnt(" #n ")" ::: "memory")
#define PG8_BAR __builtin_amdgcn_s_barrier()
#define PG8_SCHED __builtin_amdgcn_sched_barrier(0)
    Unit cur, nxt; int ui = 0;
    if (!S.next(0, cur)) return;
    f32x4 acc[2][2][4][2];
#pragma unroll
    for (int a = 0; a < 2; ++a)
#pragma unroll
        for (int b = 0; b < 2; ++b)
#pragma unroll
            for (int m = 0; m < 4; ++m)
#pragma unroll
                for (int n = 0; n < 2; ++n) acc[a][b][m][n] = (f32x4){0.f, 0.f, 0.f, 0.f};
    bf16x8 At[4][2], B0[2][2], B1[2][2];
    const char* cA = cur.a; const char* cB = cur.b;
    PG8_STAGE(PG8_SB(0, 0), cB, voffB); PG8_STAGE(PG8_SB(0, 1), cB + hstepB, voffB); PG8_STAGE(PG8_SA(0, 0), cA, voffA); PG8_STAGE(PG8_SA(0, 1), cA + hstepA, voffA);
    if (wr == 1) PG8_BAR;
    PG8_WAIT_V(2); PG8_BAR;
    PG8_STAGE(PG8_SB(1, 0), cB + kstep, voffB); PG8_STAGE(PG8_SA(1, 0), cA + kstep, voffA); PG8_STAGE(PG8_SB(1, 1), cB + hstepB + kstep, voffB);
    PG8_WAIT_V(6); PG8_BAR;
    for (;;) {
        const bool has_next = S.next(ui + 1, nxt);
        const char* nA = has_next ? nxt.a : cA; const char* nB = has_next ? nxt.b : cB;
#pragma unroll 1
        for (int t = 0; t < nt; t += 2) {
            const bool last = (t == nt - 2);
            const char* a1 = cA + (size_t)(t + 1) * kstep;
            const char* a2 = last ? nA : cA + (size_t)(t + 2) * kstep; const char* b2 = last ? nB : cB + (size_t)(t + 2) * kstep;
            const char* a3 = a2 + kstep; const char* b3 = b2 + kstep;
            PG8_LDB(B0, 0, 0); PG8_LDB(B1, 0, 1); PG8_SCHED; PG8_LDA(At, 0, 0); PG8_STAGE(PG8_SA(1, 1), a1 + hstepA, voffA);
            PG8_WAIT_V(8); PG8_WAIT_L(0); PG8_BAR; PG8_MMA(0, 0, At, B0); PG8_MMA(0, 1, At, B1); PG8_BAR; PG8_SCHED;
            PG8_LDA(At, 0, 1); PG8_STAGE(PG8_SB(0, 0), b2, voffB); PG8_STAGE(PG8_SB(0, 1), b2 + hstepB, voffB); PG8_STAGE(PG8_SA(0, 0), a2, voffA);
            PG8_WAIT_V(8); PG8_WAIT_L(0); PG8_BAR; PG8_MMA(1, 0, At, B0); PG8_MMA(1, 1, At, B1); PG8_BAR; PG8_SCHED;
            PG8_LDB(B0, 1, 0); PG8_LDB(B1, 1, 1); PG8_SCHED; PG8_LDA(At, 1, 0); PG8_STAGE(PG8_SA(0, 1), a2 + hstepA, voffA);
            PG8_WAIT_V(8); PG8_WAIT_L(0); PG8_BAR; PG8_MMA(0, 0, At, B0); PG8_MMA(0, 1, At, B1); PG8_BAR; PG8_SCHED;
            PG8_LDA(At, 1, 1); PG8_STAGE(PG8_SB(1, 0), b3, voffB); PG8_STAGE(PG8_SB(1, 1), b3 + hstepB, voffB); PG8_STAGE(PG8_SA(1, 0), a3, voffA);
            PG8_WAIT_V(8); PG8_WAIT_L(0); PG8_BAR; PG8_MMA(1, 0, At, B0); PG8_MMA(1, 1, At, B1); PG8_BAR; PG8_SCHED;
        }
        if (wr == 0) PG8_BAR;
        E(acc, cur, wr, wc, fr, fq);
        if (!has_next) break;
#pragma unroll
        for (int a = 0; a < 2; ++a)
#pragma unroll
            for (int b = 0; b < 2; ++b)
#pragma unroll
                for (int m = 0; m < 4; ++m)
#pragma unroll
                    for (int n = 0; n < 2; ++n) acc[a][b][m][n] = (f32x4){0.f, 0.f, 0.f, 0.f};
        cur = nxt; cA = nA; cB = nB; ++ui;
        if (wr == 1) PG8_BAR;
    }
    PG8_WAIT_V(0);
    PG8_BAR;
#undef PG8_SA
#undef PG8_SB
#undef PG8_STAGE
#undef PG8_LDA
#undef PG8_LDB
#undef PG8_MMA
#undef PG8_WAIT_V
#undef PG8_WAIT_L
#undef PG8_BAR
#undef PG8_SCHED
}

struct Seg { const char* A; const char* B; int nM, nN, start, count; size_t a_tile, b_tile; };
struct SegOrder {
    Seg s[4]; int nseg, total, G, c, dup;
    __device__ __forceinline__ bool next(int i, Unit& u) const {
        int L = i * G + c; if (L >= total * dup) return false; if (L >= total) L -= total;
        int k = 0; const char* gA = s[0].A; const char* gB = s[0].B; int gnM = s[0].nM, gnN = s[0].nN, gstart = 0, nwg = s[0].count; size_t gat = s[0].a_tile, gbt = s[0].b_tile;
#pragma unroll
        for (int j = 1; j < 4; ++j) if (j < nseg && L >= s[j].start) { k = j; gA = s[j].A; gB = s[j].B; gnM = s[j].nM; gnN = s[j].nN; gstart = s[j].start; nwg = s[j].count; gat = s[j].a_tile; gbt = s[j].b_tile; }
        int wgid = L - gstart;
        { const int q = nwg / 8, r = nwg % 8, xcd = wgid % 8, off = wgid / 8; wgid = (xcd < r ? xcd * (q + 1) : r * (q + 1) + (xcd - r) * q) + off; }
        const int nig = 8 * gnN, gid = wgid / nig, fm = gid * 8, gsz = (gnM - fm) < 8 ? (gnM - fm) : 8;
        u.pm = fm + ((wgid % nig) % gsz); u.pn = (wgid % nig) / gsz; u.seg = k;
        u.a = gA + (size_t)u.pm * gat; u.b = gB + (size_t)u.pn * gbt; return true;
    }
};
struct WqlOrder {
    const char* A; const char* B; int G, c;
    __device__ __forceinline__ bool next(int i, Unit& u) const {
        const int nshort = (G == 256) ? 44 : G, cc = G - 1 - c; if (cc >= nshort) return false;
        const int L = i * nshort + cc; if (L >= 64) return false;
        const int h = L >> 2, pm = (L >> 1) & 1, pn = L & 1;
        u.pm = h * 2 + pm; u.pn = pn; u.seg = 1;
        u.a = A + (size_t)pm * 256 * 2048 * 2 + (size_t)h * 128 * 2; u.b = B + (size_t)h * 512 * 256 * 2 + (size_t)pn * 256 * 256 * 2; return true;
    }
};
}

#define XB_TMO      128
#define XB_XCNT(j)  (256  + 64 * (j))
#define XB_XSUB(j)  (1280 + 64 * (j))
#define XB_XGEN(j)  (2304 + 64 * (j))
#define XB_TOP      3328
#define XB_TOPGEN   3392
#define XCD_BAR_WORDS 3456
#define XB_SPIN_CAP (1u << 18)
__device__ __forceinline__ unsigned xb_ld(unsigned* p)              { return __hip_atomic_load(p, __ATOMIC_RELAXED, __HIP_MEMORY_SCOPE_AGENT); }
__device__ __forceinline__ unsigned xb_add(unsigned* p, unsigned v) { return __hip_atomic_fetch_add(p, v, __ATOMIC_RELAXED, __HIP_MEMORY_SCOPE_AGENT); }
__device__ __forceinline__ unsigned xb_xcc_id() { return (unsigned)__builtin_amdgcn_s_getreg((3 << 11) | 20) & 0xFu; }
#define XB_SPIN(cond, bar) do { unsigned _sp = 0; while (cond) { __builtin_amdgcn_s_sleep(1); \
    if ((++_sp & 255u) == 0u) { if (xb_ld(&(bar)[XB_TMO])) break; if (_sp > XB_SPIN_CAP) { atomicAdd(&(bar)[XB_TMO], 1u); break; } } } } while (0)
struct XcdBarrier { unsigned* bar; unsigned x; volatile LAS unsigned* st; };
__device__ __forceinline__ XcdBarrier xcd_barrier_post(unsigned* bar, volatile LAS unsigned* st) {
    XcdBarrier b; b.bar = bar; b.x = xb_xcc_id(); b.st = st;
    if (threadIdx.x == 0) (void)xb_add(&bar[XB_XCNT(b.x)], 1u);
    return b;
}
__device__ __forceinline__ void xcd_barrier_complete(unsigned* bar, unsigned x, unsigned& nloc, unsigned& nx) {
    const unsigned G = gridDim.x * gridDim.y * gridDim.z;
    unsigned sum, cnt, mine, sp = 0u;
    for (;;) {
        sum = 0u; cnt = 0u; mine = 0u;
#pragma unroll
        for (unsigned j = 0; j < 16; ++j) { const unsigned c = xb_ld(&bar[XB_XCNT(j)]); sum += c; cnt += (c > 0u) ? 1u : 0u; mine = (j == x) ? c : mine; }
        if (sum == G) break;
        __builtin_amdgcn_s_sleep(1);
        if ((++sp & 255u) == 0u) { if (xb_ld(&bar[XB_TMO])) break; if (sp > XB_SPIN_CAP) { atomicAdd(&bar[XB_TMO], 1u); break; } }
    }
    nloc = mine > 0u ? mine : 1u; nx = cnt > 0u ? cnt : 1u;
}
__device__ __forceinline__ void xcd_barrier(const XcdBarrier& b) {
    asm volatile("s_waitcnt vmcnt(0)" ::: "memory");
    __syncthreads();
    if (threadIdx.x == 0) {
        unsigned* bar = b.bar;
        __builtin_amdgcn_s_waitcnt(0);
        unsigned nloc = b.st[0], nx = b.st[1];
        if (nloc == 0u) { xcd_barrier_complete(bar, b.x, nloc, nx); b.st[0] = nloc; b.st[1] = nx; }
        const unsigned old = xb_add(&bar[XB_XSUB(b.x)], 1u);
        const unsigned gen = old / nloc;
        if (old + 1u == (gen + 1u) * nloc) {
            __builtin_amdgcn_fence(__ATOMIC_RELEASE, "agent");
            asm volatile("s_waitcnt vmcnt(0)" ::: "memory");
            const unsigned og = xb_add(&bar[XB_TOP], 1u);
            const unsigned tg = og / nx;
            if (og + 1u == (tg + 1u) * nx) xb_add(&bar[XB_TOPGEN], 1u);
            else XB_SPIN(xb_ld(&bar[XB_TOPGEN]) == tg, bar);
            __builtin_amdgcn_fence(__ATOMIC_ACQUIRE, "agent");
            xb_add(&bar[XB_XGEN(b.x)], 1u);
            asm volatile("s_waitcnt vmcnt(0)" ::: "memory");
        } else {
            XB_SPIN(xb_ld(&bar[XB_XGEN(b.x)]) == gen, bar);
            __builtin_amdgcn_fence(__ATOMIC_ACQUIRE, "agent");
            asm volatile("s_waitcnt vmcnt(0)" ::: "memory");
        }
    }
    __syncthreads();
}

struct Args { const float* in[28]; float* out; unsigned char* ws; int ph_lo, ph_hi; };
struct Frame {
    LAS unsigned char* lds;
    int tid, lane, wave, vcu, G;
    unsigned char* ws; float* out;
};

__device__ __forceinline__ void p0_transpose_item(const float* W, int K, int N, bf16_t* WT, int ldt, int k0, int n0, int drow0, LAS float* scr, int lane, const float* kscale = nullptr) {
    float tv[32];
#pragma unroll
    for (int i = 0; i < 32; ++i) { const int kk = 2 * i + (lane >> 5); tv[i] = __builtin_nontemporal_load(W + (size_t)(k0 + kk) * N + n0 + (lane & 31)); }
#pragma unroll
    for (int i = 0; i < 32; ++i) { const int kk = 2 * i + (lane >> 5); scr[kk * 33 + (lane & 31)] = kscale ? tv[i] * kscale[k0 + kk] : tv[i]; }
    LDS_WAIT(); asm volatile("" ::: "memory");
    const int c = lane & 7;
#pragma unroll
    for (int j = 0; j < 4; ++j) { const int n = (lane >> 3) + 8 * j; const LAS float* s = scr + (8 * c) * 33 + n;
        u32x4 o; o.x = pk2(s[0 * 33], s[1 * 33]); o.y = pk2(s[2 * 33], s[3 * 33]); o.z = pk2(s[4 * 33], s[5 * 33]); o.w = pk2(s[6 * 33], s[7 * 33]);
        *(u32x4*)(WT + (size_t)(drow0 + n) * ldt + k0 + 8 * c) = o; }
    LDS_WAIT(); asm volatile("" ::: "memory");
}
__device__ __forceinline__ int win_dst_col(int n0) {
    if (n0 < 8192) return n0;
    if (n0 < 8224) return 9280 + (n0 - 8192);
    if (n0 < 8736) return 8192 + (n0 - 8224);
    if (n0 < 9248) return 8704 + (n0 - 8736);
    return 9216 + (n0 - 9248);
}
struct TItem { const float* W; int K, N; bf16_t* WT; int kind; };

__device__ __forceinline__ void p0_prologue(Frame& F, const Args& args) {
    LAS float* scr = (LAS float*)(F.lds + F.wave * 16384);
    const int gw = F.vcu * NWAVES + F.wave, NGW = F.G * NWAVES, lane = F.lane;
    unsigned char* ws = F.ws;
    {
        const float* Ws[9] = {args.in[6], args.in[16], args.in[18], args.in[19], args.in[14], args.in[20], args.in[21], args.in[24], args.in[25]};
        const int Ks[9] = {1024, 512, 512, 512, 2048, 2048, 1024, 1024, 4096};
        const int Ns[9] = {IN_COLS, 3072, 2048, 2048, 1024, 1024, 1024, 4096, 1024};
        const size_t Os[9] = {WS_WIN, WS_WQ, WS_WUK, WS_WUV, WS_WSSM, WS_WMLA, WS_WOUT, WS_WUP, WS_WDOWN};
        int base = 0;
#pragma unroll
        for (int w = 0; w < 9; ++w) {
            const int nblk = Ns[w] / 32, nitems = (Ks[w] / 64) * nblk;
            int first = gw - (base % NGW); if (first < 0) first += NGW;
            for (int it = first; it < nitems; it += NGW) {
                const int kb = it / nblk, nb = it % nblk, n0 = 32 * nb;
                const int drow0 = (w == 0) ? win_dst_col(n0) : n0;
                p0_transpose_item(Ws[w], Ks[w], Ns[w], (bf16_t*)(ws + Os[w]), Ks[w], 64 * kb, n0, drow0, scr, lane, (w == 7) ? args.in[22] : nullptr);
            }
            base += nitems;
        }
    }
    const int gt = F.vcu * NTHREADS + F.tid, NGT = F.G * NTHREADS;
    for (int i = gt; i < 20480; i += NGT) ((u32x4*)(ws + WS_WIN + (size_t)9312 * 1024 * 2))[i] = (u32x4){0u, 0u, 0u, 0u};
    {
        const f32x4* xp = (const f32x4*)args.in[0]; const f32x4* xs = (const f32x4*)args.in[1]; u32x4* xb = (u32x4*)(ws + WS_XB);
        const int n8p = MP * D_MODEL / 8, n8 = M * D_MODEL / 8;
        for (int i0 = gt; i0 < n8; i0 += 4 * NGT) {
            f32x4 a[4], b[4];
#pragma unroll
            for (int u = 0; u < 4; ++u) { const int i = i0 + u * NGT; const int ii = (i < n8) ? i : 0; const f32x4* src = (ii < n8p) ? xp + 2 * (size_t)ii : xs + 2 * (size_t)(ii - n8p); a[u] = __builtin_nontemporal_load(src); b[u] = __builtin_nontemporal_load(src + 1); }
#pragma unroll
            for (int u = 0; u < 4; ++u) { const int i = i0 + u * NGT; if (i < n8) xb[i] = (u32x4){pk2(a[u].x, a[u].y), pk2(a[u].z, a[u].w), pk2(b[u].x, b[u].y), pk2(b[u].z, b[u].w)}; }
        }
    }
    {
        const f32x4* src = (const f32x4*)args.in[18]; u32x4* dst = (u32x4*)(ws + WS_WUKB);
        for (int i = gt; i < 512 * 2048 / 8; i += NGT) { const f32x4 a = src[2 * (size_t)i], b = src[2 * (size_t)i + 1]; dst[i] = (u32x4){pk2(a.x, a.y), pk2(a.z, a.w), pk2(b.x, b.y), pk2(b.z, b.w)}; }
        for (int i = gt; i < 64; i += NGT) dst[512 * 2048 / 8 + i] = (u32x4){0u, 0u, 0u, 0u};
    }
    {
        const float* wq = args.in[16]; u32x4* dst = (u32x4*)(ws + WS_BQL);
        for (int i = gt; i < 16 * 512 * 32; i += NGT) {
            const int d8 = i & 31, r = (i >> 5) & 511, h = i >> 14;
            u32x4 o = (u32x4){0u, 0u, 0u, 0u};
            if (d8 < 16) { const f32x4* s = (const f32x4*)(wq + (size_t)r * 3072 + h * 192 + d8 * 8); const f32x4 a = s[0], b = s[1]; o = (u32x4){pk2(a.x, a.y), pk2(a.z, a.w), pk2(b.x, b.y), pk2(b.z, b.w)}; }
            dst[i] = o;
        }
    }
    {
        float* ct = (float*)(ws + WS_ROPE); float* st = ct + 2080 * 32;
        for (int i = gt; i < 2080 * 32; i += NGT) {
            const int p = i >> 5, j = i & 31; const float pos = (float)(p < 2048 ? p : 4096 + (p - 2048));
            const float inv = powf(10000.0f, -(float)(2 * j) / 64.0f); const float ang = pos * inv;
            ct[i] = cosf(ang); st[i] = sinf(ang);
        }
    }
    {
        const float* wup = args.in[24]; const float* g1 = args.in[22]; const float* b1 = args.in[23]; float* part = (float*)(ws + WS_GWP);
        for (int i = gt; i < 32 * 4096; i += NGT) { const int n = i & 4095, ks = i >> 12; float sg = 0.f, sb = 0.f;
#pragma unroll 8
            for (int k = 0; k < 32; ++k) { const float wv_ = wup[(size_t)(ks * 32 + k) * 4096 + n]; sg += bf2f((unsigned short)f2bf(g1[ks * 32 + k] * wv_)); sb += b1[ks * 32 + k] * wv_; }
            part[(ks * 2) * 4096 + n] = sg; part[(ks * 2 + 1) * 4096 + n] = sb; }
    }
}

struct EpiStore {
    static constexpr bool PERM = true;
    bf16_t *b0, *b1, *b2, *b3; int l0, l1, l2, l3;
    __device__ __forceinline__ void operator()(const f32x4 (&acc)[2][2][4][2], const pg8::Unit& u, int wr, int wc, int fr, int fq) const {
        bf16_t* b = (u.seg == 0) ? b0 : (u.seg == 1) ? b1 : (u.seg == 2) ? b2 : b3;
        const int ld = (u.seg == 0) ? l0 : (u.seg == 1) ? l1 : (u.seg == 2) ? l2 : l3;
        bf16_t* p = b + (size_t)(u.pm * 256 + wr * 64 + fr) * ld + u.pn * 256 + wc * 32 + 8 * fq;
#pragma unroll
        for (int ai = 0; ai < 2; ++ai)
#pragma unroll
            for (int m = 0; m < 4; ++m) { bf16_t* rowp = p + (size_t)(ai * 128 + m * 16) * ld;
#pragma unroll
                for (int bj = 0; bj < 2; ++bj) { const f32x4 v0 = acc[ai][bj][m][0], v1 = acc[ai][bj][m][1];
                    *(u32x4*)(rowp + bj * 128) = (u32x4){pg8::cvt_pk_bf16(v0[0], v0[1]), pg8::cvt_pk_bf16(v0[2], v0[3]), pg8::cvt_pk_bf16(v1[0], v1[1]), pg8::cvt_pk_bf16(v1[2], v1[3])}; } }
    }
};

struct EpiProj {
    static constexpr bool PERM = true;
    unsigned char* ws; float* out;
    __device__ __forceinline__ void operator()(const f32x4 (&acc)[2][2][4][2], const pg8::Unit& u, int wr, int wc, int fr, int fq) const {
        const int row0 = u.pm * 256 + wr * 64 + fr, colt = wc * 32 + 8 * fq;
        if (u.pn < 32) {
            bf16_t* base; int ldc, c0;
            if (u.pn < 8) { base = (bf16_t*)(ws + WS_G); ldc = 2048; c0 = u.pn * 256; }
            else if (u.pn < 16) { base = (bf16_t*)(ws + WS_Z); ldc = 2048; c0 = (u.pn - 8) * 256; }
            else { base = (bf16_t*)(ws + WS_XBC); ldc = 4096; c0 = (u.pn - 16) * 256; }
#pragma unroll
            for (int ai = 0; ai < 2; ++ai)
#pragma unroll
                for (int m = 0; m < 4; ++m) { const int row = row0 + ai * 128 + m * 16; bf16_t* rowp = base + (size_t)row * ldc + c0 + colt;
#pragma unroll
                    for (int bj = 0; bj < 2; ++bj) { const f32x4 v0 = acc[ai][bj][m][0], v1 = acc[ai][bj][m][1];
                        *(u32x4*)(rowp + bj * 128) = (u32x4){pg8::cvt_pk_bf16(v0[0], v0[1]), pg8::cvt_pk_bf16(v0[2], v0[3]), pg8::cvt_pk_bf16(v1[0], v1[1]), pg8::cvt_pk_bf16(v1[2], v1[3])}; } }
            if (u.pn >= 16 && ((u.pm & 7) == 7 || u.pm >= MP / 256)) {
#pragma unroll
                for (int ai = 0; ai < 2; ++ai)
#pragma unroll
                    for (int m = 0; m < 4; ++m) { const int row = row0 + ai * 128 + m * 16;
                        long off = -1;
                        if (row < MP) { const int t = row & 2047; if (t >= 2045) off = (long)O_CONVP + ((long)(row >> 11) * 3 + (t - 2045)) * 4096; }
                        else { const int q = (row - MP) & 31; if (q >= 29) off = (long)O_CONVS + ((long)((row - MP) >> 5) * 3 + (q - 29)) * 4096; }
                        if (off >= 0) { float* cp = out + off + c0 + colt;
#pragma unroll
                            for (int bj = 0; bj < 2; ++bj) { *(f32x4*)(cp + bj * 128) = acc[ai][bj][m][0]; *(f32x4*)(cp + bj * 128 + 4) = acc[ai][bj][m][1]; } } }
            }
        } else {
            bf16_t* base = (bf16_t*)(ws + WS_SMALL); const int c0 = (u.pn - 32) * 256;
#pragma unroll
            for (int ai = 0; ai < 2; ++ai)
#pragma unroll
                for (int m = 0; m < 4; ++m) { bf16_t* rowp = base + (size_t)(row0 + ai * 128 + m * 16) * SMALL_LD + c0 + colt;
#pragma unroll
                    for (int bj = 0; bj < 2; ++bj) { const f32x4 v0 = acc[ai][bj][m][0], v1 = acc[ai][bj][m][1];
                        *(u32x4*)(rowp + bj * 128) = (u32x4){pg8::cvt_pk_bf16(v0[0], v0[1]), pg8::cvt_pk_bf16(v0[2], v0[3]), pg8::cvt_pk_bf16(v1[0], v1[1]), pg8::cvt_pk_bf16(v1[2], v1[3])}; } }
        }
    }
};

__device__ __forceinline__ void p1b_rows(Frame& F, const Args& args) {
    const int gw = (F.G - 1 - F.vcu) * NWAVES + F.wave, NGW = F.G * NWAVES, lane = F.lane;
    unsigned char* ws = F.ws;
    const float* gq = args.in[15]; const float* gkv = args.in[17]; const float* dtb = args.in[10];
    const float* ct = (const float*)(ws + WS_ROPE); const float* st = ct + 2080 * 32;
    const f32x4 gq0 = *(const f32x4*)(gq + 4 * lane), gq1 = *(const f32x4*)(gq + 256 + 4 * lane);
    const f32x4 gk0 = *(const f32x4*)(gkv + 4 * lane), gk1 = *(const f32x4*)(gkv + 256 + 4 * lane);
    for (int m = gw; m < M; m += NGW) {
        const bf16_t* srow = (const bf16_t*)(ws + WS_SMALL) + (size_t)m * SMALL_LD;
        const u32x2 tq0 = __builtin_nontemporal_load((const u32x2*)(srow + 4 * lane)), tq1 = __builtin_nontemporal_load((const u32x2*)(srow + 256 + 4 * lane));
        const u32x2 tk0 = __builtin_nontemporal_load((const u32x2*)(srow + 512 + 4 * lane)), tk1 = __builtin_nontemporal_load((const u32x2*)(srow + 768 + 4 * lane));
        const f32x4 q0 = (f32x4){bflo(tq0[0]), bfhi(tq0[0]), bflo(tq0[1]), bfhi(tq0[1])}, q1 = (f32x4){bflo(tq1[0]), bfhi(tq1[0]), bflo(tq1[1]), bfhi(tq1[1])};
        const f32x4 k0 = (f32x4){bflo(tk0[0]), bfhi(tk0[0]), bflo(tk0[1]), bfhi(tk0[1])}, k1 = (f32x4){bflo(tk1[0]), bfhi(tk1[0]), bflo(tk1[1]), bfhi(tk1[1])};
        float sq = (q0.x * q0.x + q0.y * q0.y) + (q0.z * q0.z + q0.w * q0.w) + (q1.x * q1.x + q1.y * q1.y) + (q1.z * q1.z + q1.w * q1.w);
        float sk = (k0.x * k0.x + k0.y * k0.y) + (k0.z * k0.z + k0.w * k0.w) + (k1.x * k1.x + k1.y * k1.y) + (k1.z * k1.z + k1.w * k1.w);
        sq = wave_sum(sq); sk = wave_sum(sk);
        const float rq = 1.0f / sqrtf(sq * (1.0f / 512.0f) + RMS_EPS), rk = 1.0f / sqrtf(sk * (1.0f / 512.0f) + RMS_EPS);
        { bf16_t* o = (bf16_t*)(ws + WS_QAN) + (size_t)m * 512;
          const f32x4 a = q0 * rq * gq0, b = q1 * rq * gq1;
          *(u32x2*)(o + 4 * lane) = (u32x2){pk2(a.x, a.y), pk2(a.z, a.w)}; *(u32x2*)(o + 256 + 4 * lane) = (u32x2){pk2(b.x, b.y), pk2(b.z, b.w)}; }
        { bf16_t* o = (bf16_t*)(ws + WS_CKVN) + (size_t)m * 512;
          const f32x4 a = k0 * rk * gk0, b = k1 * rk * gk1;
          *(u32x2*)(o + 4 * lane) = (u32x2){pk2(a.x, a.y), pk2(a.z, a.w)}; *(u32x2*)(o + 256 + 4 * lane) = (u32x2){pk2(b.x, b.y), pk2(b.z, b.w)};
          float* fo = (m < MP) ? F.out + O_CKVP + (size_t)m * 512 : F.out + O_CKVS + (size_t)(m - MP) * 512;
          __builtin_nontemporal_store(a, (f32x4*)(fo + 4 * lane)); __builtin_nontemporal_store(b, (f32x4*)(fo + 256 + 4 * lane));
          if (m >= MP) { bf16_t* cr = (bf16_t*)(ws + WS_CACHE) + ((size_t)((m - MP) >> 5) * KVLEN + PAST + ((m - MP) & 31)) * 576;
              *(u32x2*)(cr + 4 * lane) = (u32x2){pk2(a.x, a.y), pk2(a.z, a.w)}; *(u32x2*)(cr + 256 + 4 * lane) = (u32x2){pk2(b.x, b.y), pk2(b.z, b.w)}; } }
        const int pidx = (m < MP) ? (m & 2047) : 2048 + ((m - MP) & 31);
        if (lane < 32) {
            const float t1 = bf2f(srow[1024 + lane]), t2 = bf2f(srow[1056 + lane]); const float c = ct[pidx * 32 + lane], s = st[pidx * 32 + lane];
            const float o1 = t1 * c - t2 * s, o2 = t1 * s + t2 * c;
            float* fo = (m < MP) ? F.out + O_KPEP + (size_t)m * 64 : F.out + O_KPES + (size_t)(m - MP) * 64;
            fo[lane] = o1; fo[32 + lane] = o2;
            bf16_t* o = (bf16_t*)(ws + WS_KPER) + (size_t)m * 64; o[lane] = (bf16_t)f2bf(o1); o[32 + lane] = (bf16_t)f2bf(o2);
            if (m >= MP) { bf16_t* cr = (bf16_t*)(ws + WS_CACHE) + ((size_t)((m - MP) >> 5) * KVLEN + PAST + ((m - MP) & 31)) * 576 + 512; cr[lane] = (bf16_t)f2bf(o1); cr[32 + lane] = (bf16_t)f2bf(o2); }
        } else {
            const int hh = lane - 32; const float x = bf2f(srow[1088 + hh]) + dtb[hh];
            const float sp = (x > 20.f) ? x : log1pf(expf(x));
            ((float*)(ws + WS_DT))[(size_t)m * 32 + hh] = sp;
        }
    }
}


__device__ __forceinline__ void conv_item(Frame& F, const Args& args, int item) {
    int tid_o = F.tid; asm volatile("" : "+v"(tid_o));
    const int tid = tid_o, rb = item >> 3, sl = item & 7, ch = sl * 512 + (tid & 63) * 8, r0 = rb * 64 + (tid >> 6) * 8;
    unsigned char* ws = F.ws; const bf16_t* xbc = (const bf16_t*)(ws + WS_XBC);
    const float* conv_w = args.in[8]; const float* conv_b = args.in[9];
    float wv[4][8], bv[8];
#pragma unroll
    for (int k = 0; k < 4; ++k) { const f32x4 a = *(const f32x4*)(conv_w + k * 4096 + ch), c = *(const f32x4*)(conv_w + k * 4096 + ch + 4);
        wv[k][0] = a[0]; wv[k][1] = a[1]; wv[k][2] = a[2]; wv[k][3] = a[3]; wv[k][4] = c[0]; wv[k][5] = c[1]; wv[k][6] = c[2]; wv[k][7] = c[3]; }
    { const f32x4 a = *(const f32x4*)(conv_b + ch), c = *(const f32x4*)(conv_b + ch + 4); bv[0] = a[0]; bv[1] = a[1]; bv[2] = a[2]; bv[3] = a[3]; bv[4] = c[0]; bv[5] = c[1]; bv[6] = c[2]; bv[7] = c[3]; }
    float h0[8], h1[8], h2[8];
    const bool prompt = r0 < MP; const int t0 = prompt ? (r0 & 2047) : ((r0 - MP) & 31);
    u32x4 hv[3];
    if (t0 == 0) {
        if (prompt) { hv[0] = hv[1] = hv[2] = (u32x4){0u, 0u, 0u, 0u}; }
        else { const float* sc = args.in[5] + (size_t)((r0 - MP) >> 5) * 3 * 4096 + ch;
#pragma unroll
            for (int k = 0; k < 3; ++k) { const f32x4 a = *(const f32x4*)(sc + k * 4096), c = *(const f32x4*)(sc + k * 4096 + 4); hv[k] = (u32x4){pk2(a.x, a.y), pk2(a.z, a.w), pk2(c.x, c.y), pk2(c.z, c.w)}; } }
    } else {
#pragma unroll
        for (int k = 0; k < 3; ++k) hv[k] = *(const u32x4*)(xbc + (size_t)(r0 - 3 + k) * 4096 + ch);
    }
#pragma unroll
    for (int e = 0; e < 4; ++e) { h0[2 * e] = bflo(hv[0][e]); h0[2 * e + 1] = bfhi(hv[0][e]); h1[2 * e] = bflo(hv[1][e]); h1[2 * e + 1] = bfhi(hv[1][e]); h2[2 * e] = bflo(hv[2][e]); h2[2 * e + 1] = bfhi(hv[2][e]); }
    u32x4 rv[8];
#pragma unroll
    for (int i = 0; i < 8; ++i) rv[i] = (i < 5) ? __builtin_nontemporal_load((const u32x4*)(xbc + (size_t)(r0 + i) * 4096 + ch)) : *(const u32x4*)(xbc + (size_t)(r0 + i) * 4096 + ch);
    bf16_t* dst = (ch < 2048) ? (bf16_t*)(ws + WS_XACT) + (size_t)r0 * 2048 + ch : (bf16_t*)(ws + WS_BCACT) + (size_t)r0 * 2048 + (ch - 2048);
#pragma unroll
    for (int i = 0; i < 8; ++i) {
        float x[8], o[8];
#pragma unroll
        for (int e = 0; e < 4; ++e) { x[2 * e] = bflo(rv[i][e]); x[2 * e + 1] = bfhi(rv[i][e]); }
#pragma unroll
        for (int e = 0; e < 8; ++e) { o[e] = siluf_(bv[e] + wv[0][e] * h0[e] + wv[1][e] * h1[e] + wv[2][e] * h2[e] + wv[3][e] * x[e]); h0[e] = h1[e]; h1[e] = h2[e]; h2[e] = x[e]; }
        *(u32x4*)(dst + (size_t)i * 2048) = (u32x4){pk2(o[0], o[1]), pk2(o[2], o[3]), pk2(o[4], o[5]), pk2(o[6], o[7])};
    }
}

namespace ssd {
constexpr int SC = 272, SX = 144;
constexpr int L_CT = 0, L_BN = L_CT + 64 * SC, L_SB = L_BN + 64 * SC, L_XT = L_SB + 64 * SC, L_XS = L_XT + 64 * SX, L_MM = L_XS + 64 * SX, L_YO = L_MM + 64 * SX, L_SCAL = L_YO + 64 * SX, L_END = L_SCAL + 1024;
static_assert(L_END <= LDSCTL_OFF, "ssd LDS map");
typedef short v4i16 __attribute__((ext_vector_type(4)));
__device__ __forceinline__ v4i16 tr16(LAS const unsigned char* p) { return __builtin_amdgcn_ds_read_tr16_b64_v4i16((LAS v4i16*)p); }
}
__device__ __forceinline__ void ssd_item(Frame& F, const Args& args, int item, int nseq) {
    using namespace ssd;
    LAS unsigned char* lds = F.lds;
    int tid_o = F.tid; asm volatile("" : "+v"(tid_o));
    const int tid = tid_o, lane = tid & 63, w = F.wave, g = lane >> 4, c16 = lane & 15;
    const bool sample = item >= 256;
    const int bb = sample ? (item - 256) >> 5 : item >> 5, h = item & 31, grp = h >> 2;
    const int nchunks = sample ? nseq : 32, nvalid = sample ? 32 : 64, istep = F.G;
    const int rowbase = sample ? MP + bb * 32 : bb * 2048;
    unsigned char* ws = F.ws;
    const bf16_t* xact = (const bf16_t*)(ws + WS_XACT); const bf16_t* bcact = (const bf16_t*)(ws + WS_BCACT); const bf16_t* zbuf = (const bf16_t*)(ws + WS_Z); const float* dtbuf = (const float*)(ws + WS_DT);
    const int it = w >> 1, half = w & 1;
    f32x4 st[4];
#pragma unroll
    for (int nt = 0; nt < 4; ++nt) st[nt] = (f32x4){0.f, 0.f, 0.f, 0.f};
    if (sample) {
        const float* s0 = args.in[4] + ((size_t)(bb * 32 + h) * 64) * 128;
#pragma unroll
        for (int nt = 0; nt < 4; ++nt) st[nt] = *(const f32x4*)(s0 + (size_t)(16 * it + c16) * 128 + 16 * (4 * half + nt) + 4 * g);
    }
    __syncthreads();
#pragma unroll
    for (int nt = 0; nt < 4; ++nt) *(LAS u32x2*)(lds + L_SB + (16 * it + c16) * SC + (16 * (4 * half + nt) + 4 * g) * 2) = (u32x2){pk2(st[nt][0], st[nt][1]), pk2(st[nt][2], st[nt][3])};

    struct PF { u32x4 px, pb[2], pc[2]; float pdt; u32x2 pz[2]; };
    PF pfA, pfB;
    const int prow = tid >> 3, ppx = tid & 7, brow = tid >> 4, bpc = tid & 15;
    auto prefetch = [&](PF& P, int c) {
        const int itc = sample ? item + c * istep : item, h = itc & 31, grp = h >> 2;
        const size_t r0 = sample ? (size_t)(MP + ((itc - 256) >> 5) * 32) : (size_t)(rowbase + c * 64);
        const u32x4 zero4 = (u32x4){0u, 0u, 0u, 0u};
        P.px = (prow < nvalid) ? *(const u32x4*)(xact + (r0 + prow) * 2048 + h * 64 + ppx * 8) : zero4;
#pragma unroll
        for (int q = 0; q < 2; ++q) { const int rr = brow + 32 * q;
            P.pb[q] = (rr < nvalid) ? *(const u32x4*)(bcact + (r0 + rr) * 2048 + grp * 128 + bpc * 8) : zero4;
            P.pc[q] = (rr < nvalid) ? *(const u32x4*)(bcact + (r0 + rr) * 2048 + 1024 + grp * 128 + bpc * 8) : zero4; }
        P.pdt = (lane < nvalid) ? dtbuf[(r0 + lane) * 32 + h] : 0.f;
#pragma unroll
        for (int pt = 0; pt < 2; ++pt) P.pz[pt] = (16 * it + c16 < nvalid) ? *(const u32x2*)(zbuf + (r0 + 16 * it + c16) * 2048 + h * 64 + 16 * (2 * half + pt) + 4 * g) : (u32x2){0u, 0u};
    };
    prefetch(pfA, 0); if (nchunks > 1) prefetch(pfB, 1);
    const float* cache_c = args.in[2]; const float* cache_k = args.in[3]; bf16_t* cache_dst = (bf16_t*)(ws + WS_CACHE);
    constexpr int NPIECES = DEC_BATCH * PAST * 72;
    float a_cur = -__expf(args.in[11][h]), d_cur = args.in[12][h], a_nxt = 0.f, d_nxt = 0.f;
    auto chunk = [&](PF& P, int c) {
        const int itc = sample ? item + c * istep : item, h = itc & 31;
        const size_t r0 = sample ? (size_t)(MP + ((itc - 256) >> 5) * 32) : (size_t)(rowbase + c * 64);
        const float a_h = a_cur, d_h = d_cur;
        f32x4 stn[4];
        const bool more = sample && c + 1 < nchunks;
        if (more) { const int itn = itc + istep; a_nxt = -__expf(args.in[11][itn & 31]); d_nxt = args.in[12][itn & 31]; const float* s0 = args.in[4] + ((size_t)(((itn - 256) >> 5) * 32 + (itn & 31)) * 64) * 128;
#pragma unroll
            for (int nt = 0; nt < 4; ++nt) stn[nt] = *(const f32x4*)(s0 + (size_t)(16 * it + c16) * 128 + 16 * (4 * half + nt) + 4 * g); }
        f32x4 cva[3], cvc[3]; int cdo[3];
        if (!sample) {
#pragma unroll
            for (int u = 0; u < 3; ++u) { const int i = ((c * 3 + u) * 256 + item) * 512 + tid; const bool ok = i < NPIECES; const int ii = ok ? i : 0;
                const int pc = ii % 72, row = ii / 72;
                const float* src = (pc < 64) ? cache_c + (size_t)row * 512 + pc * 8 : cache_k + (size_t)row * 64 + (pc - 64) * 8;
                cva[u] = __builtin_nontemporal_load((const f32x4*)src); cvc[u] = __builtin_nontemporal_load((const f32x4*)(src + 4)); cdo[u] = ok ? ((row >> 12) * KVLEN + (row & 4095)) * 72 + pc : -1; }
        }
        const float dtl = P.pdt; float acl = dtl * a_h; const u32x4 px = P.px; const u32x4 pb0 = P.pb[0], pb1 = P.pb[1], pc0 = P.pc[0], pc1 = P.pc[1];
#pragma unroll
        for (int o = 1; o < 64; o <<= 1) { const float t = __shfl_up(acl, o); if (lane >= o) acl += t; }
        const float tot = __shfl(acl, 63), dec = __expf(tot);
        const float s4l = dtl * __expf(tot - acl);
        {
            const float s4r = __shfl(s4l, prow);
            *(LAS u32x4*)(lds + L_XT + prow * SX + ppx * 16) = px;
            *(LAS u32x4*)(lds + L_XS + prow * SX + ppx * 16) = (u32x4){pk2(bflo(px[0]) * s4r, bfhi(px[0]) * s4r), pk2(bflo(px[1]) * s4r, bfhi(px[1]) * s4r), pk2(bflo(px[2]) * s4r, bfhi(px[2]) * s4r), pk2(bflo(px[3]) * s4r, bfhi(px[3]) * s4r)};
            *(LAS u32x4*)(lds + L_BN + brow * SC + bpc * 16) = pb0; *(LAS u32x4*)(lds + L_CT + brow * SC + bpc * 16) = pc0;
            *(LAS u32x4*)(lds + L_BN + (brow + 32) * SC + bpc * 16) = pb1; *(LAS u32x4*)(lds + L_CT + (brow + 32) * SC + bpc * 16) = pc1;
        }
        const u32x2 zc0 = P.pz[0], zc1 = P.pz[1];
        const float acum_i = __shfl(acl, 16 * it + c16);
        __syncthreads();
        f32x4 acc3[2];
        {
            bf16x8 cb[4];
#pragma unroll
            for (int ks = 0; ks < 4; ++ks) cb[ks] = *(LAS const bf16x8*)(lds + L_CT + (16 * it + c16) * SC + (32 * ks + 8 * g) * 2);
#pragma unroll
            for (int t2 = 0; t2 < 2; ++t2) { const int jt = 2 * half + t2; f32x4 a1 = (f32x4){0.f, 0.f, 0.f, 0.f}, a3 = (f32x4){0.f, 0.f, 0.f, 0.f};
                bf16x8 bfr[4], sfr[4];
#pragma unroll
                for (int ks = 0; ks < 4; ++ks) { bfr[ks] = *(LAS const bf16x8*)(lds + L_BN + (16 * jt + c16) * SC + (32 * ks + 8 * g) * 2); sfr[ks] = *(LAS const bf16x8*)(lds + L_SB + (16 * jt + c16) * SC + (32 * ks + 8 * g) * 2); }
#pragma unroll
                for (int ks = 0; ks < 4; ++ks) { a1 = __builtin_amdgcn_mfma_f32_16x16x32_bf16(bfr[ks], cb[ks], a1, 0, 0, 0); a3 = __builtin_amdgcn_mfma_f32_16x16x32_bf16(sfr[ks], cb[ks], a3, 0, 0, 0); }
                if (t2 == 0 && c + 2 < nchunks) prefetch(P, c + 2);
                acc3[t2] = a3;
                const int i = 16 * it + c16; float mv[4];
#pragma unroll
                for (int r = 0; r < 4; ++r) { const int j = 16 * jt + 4 * g + r; const float acj = __shfl(acl, j), dtj = __shfl(dtl, j); mv[r] = (j <= i) ? a1[r] * __expf(acum_i - acj) * dtj : 0.f; }
                *(LAS u32x2*)(lds + L_MM + i * SX + (16 * jt + 4 * g) * 2) = (u32x2){pk2(mv[0], mv[1]), pk2(mv[2], mv[3])};
            }
        }
        {
            bf16x8 xb[2];
#pragma unroll
            for (int ks = 0; ks < 2; ++ks) { LAS const unsigned char* tp = lds + L_XS + (32 * ks + 8 * g + (c16 >> 2)) * SX + (16 * it + 4 * (c16 & 3)) * 2;
                const v4i16 lo = tr16(tp), hi = tr16(tp + 4 * SX); xb[ks] = (bf16x8){lo[0], lo[1], lo[2], lo[3], hi[0], hi[1], hi[2], hi[3]}; }
#pragma unroll
            for (int nt = 0; nt < 4; ++nt) { f32x4 a4 = st[nt] * dec; const int n0 = 16 * (4 * half + nt);
#pragma unroll
                for (int ks = 0; ks < 2; ++ks) {
                    LAS const unsigned char* tp = lds + L_BN + (32 * ks + 8 * g + (c16 >> 2)) * SC + (n0 + 4 * (c16 & 3)) * 2;
                    const v4i16 lo = tr16(tp), hi = tr16(tp + 4 * SC);
                    a4 = __builtin_amdgcn_mfma_f32_16x16x32_bf16((bf16x8){lo[0], lo[1], lo[2], lo[3], hi[0], hi[1], hi[2], hi[3]}, xb[ks], a4, 0, 0, 0);
                }
                st[nt] = a4; }
        }
        __syncthreads();
        {
            bf16x8 mb[2];
#pragma unroll
            for (int ks = 0; ks < 2; ++ks) mb[ks] = *(LAS const bf16x8*)(lds + L_MM + (16 * it + c16) * SX + (32 * ks + 8 * g) * 2);
            const float ea = __expf(acum_i); const int i = 16 * it + c16;
            float ss = 0.f;
#pragma unroll
            for (int t2 = 0; t2 < 2; ++t2) { const int pt = 2 * half + t2;
                f32x4 y = acc3[t2] * ea;
#pragma unroll
                for (int ks = 0; ks < 2; ++ks) { LAS const unsigned char* tp = lds + L_XT + (32 * ks + 8 * g + (c16 >> 2)) * SX + (16 * pt + 4 * (c16 & 3)) * 2;
                    const v4i16 lo = tr16(tp), hi = tr16(tp + 4 * SX);
                    y = __builtin_amdgcn_mfma_f32_16x16x32_bf16((bf16x8){lo[0], lo[1], lo[2], lo[3], hi[0], hi[1], hi[2], hi[3]}, mb[ks], y, 0, 0, 0); }
                const u32x2 xi = *(LAS const u32x2*)(lds + L_XT + i * SX + (16 * pt + 4 * g) * 2); const u32x2 zz = t2 ? zc1 : zc0;
                const float y0 = (y[0] + d_h * bflo(xi.x)) * siluf_(bflo(zz.x)), y1 = (y[1] + d_h * bfhi(xi.x)) * siluf_(bfhi(zz.x)), y2 = (y[2] + d_h * bflo(xi.y)) * siluf_(bflo(zz.y)), y3 = (y[3] + d_h * bfhi(xi.y)) * siluf_(bfhi(zz.y));
                ss += (y0 * y0 + y1 * y1) + (y2 * y2 + y3 * y3);
                *(LAS u32x2*)(lds + L_YO + i * SX + (16 * pt + 4 * g) * 2) = (u32x2){pk2(y0, y1), pk2(y2, y3)};
            }
            ss += __shfl_xor(ss, 16); ss += __shfl_xor(ss, 32);
            if (g == 0) *(LAS float*)(lds + L_SCAL + half * 256 + i * 4) = ss;
            if (sample) {
                float* so = F.out + O_SSMS + ((size_t)(((itc - 256) >> 5) * 32 + h) * 64) * 128;
#pragma unroll
                for (int nt = 0; nt < 4; ++nt) __builtin_nontemporal_store(st[nt], (f32x4*)(so + (size_t)(16 * it + c16) * 128 + 16 * (4 * half + nt) + 4 * g));
                if (more) { a_cur = a_nxt; d_cur = d_nxt;
#pragma unroll
                    for (int nt = 0; nt < 4; ++nt) st[nt] = stn[nt]; }
            }
#pragma unroll
            for (int nt = 0; nt < 4; ++nt) *(LAS u32x2*)(lds + L_SB + (16 * it + c16) * SC + (16 * (4 * half + nt) + 4 * g) * 2) = (u32x2){pk2(st[nt][0], st[nt][1]), pk2(st[nt][2], st[nt][3])};
        }
        __syncthreads();
        {
            const int row = tid >> 3, pc8 = tid & 7;
            if (row < nvalid) { const u32x4 v = *(LAS const u32x4*)(lds + L_YO + row * SX + pc8 * 16);
                *(u32x4*)((bf16_t*)(ws + WS_YZ) + (r0 + row) * 2048 + h * 64 + pc8 * 8) = v; }
            if (tid < nvalid) { LAS const float* pp = (LAS const float*)(lds + L_SCAL); ((float*)(ws + WS_SSQ))[(r0 + tid) * 32 + h] = pp[tid] + pp[64 + tid]; }
            if (!sample) {
#pragma unroll
                for (int u = 0; u < 3; ++u) if (cdo[u] >= 0) *(u32x4*)(cache_dst + (size_t)cdo[u] * 8) = (u32x4){pk2(cva[u].x, cva[u].y), pk2(cva[u].z, cva[u].w), pk2(cvc[u].x, cvc[u].y), pk2(cvc[u].z, cvc[u].w)};
            }
        }
    };
    for (int c = 0; c < nchunks; c += 2) { chunk(pfA, c); if (c + 1 < nchunks) chunk(pfB, c + 1); }
    if (!sample) {
        float* so = F.out + O_SSMP + ((size_t)(bb * 32 + h) * 64) * 128;
#pragma unroll
        for (int nt = 0; nt < 4; ++nt) __builtin_nontemporal_store(st[nt], (f32x4*)(so + (size_t)(16 * it + c16) * 128 + 16 * (4 * half + nt) + 4 * g));
    }
    __syncthreads();
}

namespace att {
typedef float f32x16 __attribute__((ext_vector_type(16)));
typedef short v4i16 __attribute__((ext_vector_type(4)));
__device__ __forceinline__ v4i16 tr16(LAS const unsigned char* p) { return __builtin_amdgcn_ds_read_tr16_b64_v4i16((LAS v4i16*)p); }
constexpr float QSCALE = 0.07216878364870322f * 1.4426950408889634f;
constexpr int PK_STR = 400, PV_STR = 320, PK_BYTES = 64 * PK_STR, PV_BYTES = 64 * PV_STR, PBUF = PK_BYTES + PV_BYTES;
static_assert(2 * PBUF <= LDSCTL_OFF, "prompt attention LDS");
constexpr int SK_STR = 1056, SK_MAIN = 32 * SK_STR, SK_TAIL = 32 * 128, SK_BUF = SK_MAIN + SK_TAIL;
constexpr int SQ_STR = 208, SQ_WAVE = 32 * SQ_STR, SQ_OFF = 2 * SK_BUF;
constexpr int SX_OFF = SQ_OFF + 8 * SQ_WAVE;
static_assert(SX_OFF + 8 * 4096 <= LDSCTL_OFF, "sample attention LDS");
__device__ __forceinline__ unsigned pkbf(float lo, float hi) { return pg8::cvt_pk_bf16(lo, hi); }
__device__ __forceinline__ void glds16(const void* gsrc, unsigned lds_dst) { unsigned keep;
    asm volatile("s_mov_b32 %0, m0\n\ts_mov_b32 m0, %2\n\ts_nop 0\n\tglobal_load_lds_dwordx4 %1, off\n\ts_mov_b32 m0, %0" : "=&s"(keep) : "v"(gsrc), "s"(lds_dst) : "memory"); }
__device__ __forceinline__ void glds16s(const void* sbase, unsigned voff, unsigned lds_dst) { unsigned keep;
    asm volatile("s_mov_b32 %0, m0\n\ts_mov_b32 m0, %2\n\ts_nop 4\n\tglobal_load_lds_dwordx4 %1, %3\n\ts_mov_b32 m0, %0" : "=&s"(keep) : "v"(voff), "s"(lds_dst), "s"(sbase) : "memory"); }
}

template <int MODE> __device__ __forceinline__ void attn_prompt_unit(Frame& F, int b, int h, int qb) {
    using namespace att;
    LAS unsigned char* lds = F.lds; unsigned char* ws = F.ws;
    int tid_o = F.tid; asm volatile("" : "+v"(tid_o));
    const int tid = tid_o, lane = tid & 63, w = F.wave, r32 = lane & 31, hi = lane >> 5, i16 = lane & 15, gi = lane >> 4;
    const bf16_t* qg = (const bf16_t*)(ws + WS_Q); const bf16_t* kn = (const bf16_t*)(ws + WS_KN); const bf16_t* vv = (const bf16_t*)(ws + WS_V); const bf16_t* kpe = (const bf16_t*)(ws + WS_KPER);
    const float* ct = (const float*)(ws + WS_ROPE); const float* st = ct + 2080 * 32;
    const size_t rowb = (size_t)b * SEQ;
    const int NT = 4 * qb + 4, my_last = 4 * qb + (w >> 1);
    bf16x8 qf[12];
    {
        const int pos = 256 * qb + 32 * w + r32; const bf16_t* qrow = qg + (rowb + pos) * 3072 + h * 192 + 8 * hi;
#pragma unroll
        for (int ks = 0; ks < 8; ++ks) { const u32x4 v = *(const u32x4*)(qrow + 16 * ks); u32x4 o;
#pragma unroll
            for (int e = 0; e < 4; ++e) o[e] = pkbf(bflo(v[e]) * QSCALE, bfhi(v[e]) * QSCALE);
            qf[ks] = __builtin_bit_cast(bf16x8, o); }
#pragma unroll
        for (int kp = 0; kp < 2; ++kp) {
            const u32x4 v1 = *(const u32x4*)(qrow + 128 + 16 * kp), v2 = *(const u32x4*)(qrow + 160 + 16 * kp);
            const float* cp = ct + pos * 32 + 16 * kp + 8 * hi; const float* sp = st + pos * 32 + 16 * kp + 8 * hi;
            const f32x4 c0 = *(const f32x4*)cp, c1 = *(const f32x4*)(cp + 4), s0 = *(const f32x4*)sp, s1 = *(const f32x4*)(sp + 4);
            float t1[8], t2[8], o1[8], o2[8];
#pragma unroll
            for (int e = 0; e < 4; ++e) { t1[2 * e] = bflo(v1[e]); t1[2 * e + 1] = bfhi(v1[e]); t2[2 * e] = bflo(v2[e]); t2[2 * e + 1] = bfhi(v2[e]); }
#pragma unroll
            for (int e = 0; e < 8; ++e) { const float c = (e < 4) ? c0[e & 3] : c1[e & 3], sn = (e < 4) ? s0[e & 3] : s1[e & 3];
                o1[e] = (t1[e] * c - t2[e] * sn) * QSCALE; o2[e] = (t1[e] * sn + t2[e] * c) * QSCALE; }
            qf[8 + kp] = __builtin_bit_cast(bf16x8, (u32x4){pkbf(o1[0], o1[1]), pkbf(o1[2], o1[3]), pkbf(o1[4], o1[5]), pkbf(o1[6], o1[7])});
            qf[10 + kp] = __builtin_bit_cast(bf16x8, (u32x4){pkbf(o2[0], o2[1]), pkbf(o2[2], o2[3]), pkbf(o2[4], o2[5]), pkbf(o2[6], o2[7])});
        }
    }
    f32x16 oT[4];
#pragma unroll
    for (int d = 0; d < 4; ++d)
#pragma unroll
        for (int r = 0; r < 16; ++r) oT[d][r] = 0.f;
    float m_run = -INFINITY, l_run = 0.f;
    u32x4 pk[3], pv[2];
    auto gloadK = [&](int t) {
        const size_t r0 = rowb + (size_t)t * 64;
#pragma unroll
        for (int i = 0; i < 3; ++i) { const int idx = tid + 512 * i, row = idx / 24, pc = idx % 24;
            pk[i] = (pc < 16) ? *(const u32x4*)(kn + (r0 + row) * 2048 + h * 128 + pc * 8) : *(const u32x4*)(kpe + (r0 + row) * 64 + (pc - 16) * 8); }
    };
    auto gloadV = [&](int t) {
        const size_t r0 = rowb + (size_t)t * 64;
#pragma unroll
        for (int i = 0; i < 2; ++i) { const int idx = tid + 512 * i, row = idx >> 4, pc = idx & 15; pv[i] = *(const u32x4*)(vv + (r0 + row) * 2048 + h * 128 + pc * 8); }
    };
    auto gload = [&](int t) { gloadK(t); gloadV(t); };
    auto lstore = [&](int buf) {
        LAS unsigned char* kb = lds + buf * PBUF; LAS unsigned char* vb = kb + PK_BYTES;
#pragma unroll
        for (int i = 0; i < 3; ++i) { const int idx = tid + 512 * i, row = idx / 24, pc = idx % 24; *(LAS u32x4*)(kb + row * PK_STR + pc * 16) = pk[i]; }
#pragma unroll
        for (int i = 0; i < 2; ++i) { const int idx = tid + 512 * i, row = idx >> 4, pc = idx & 15; *(LAS u32x4*)(vb + row * PV_STR + pc * 16) = pv[i]; }
    };
    __syncthreads();
    if (MODE != 1) { gload(0); lstore(0); }
    __syncthreads();
    for (int t = 0; t < NT; ++t) {
        const bool fetch = (MODE != 1) && t + 1 < NT;
        if (!(MODE != 2 && t <= my_last)) { if (fetch) gload(t + 1); }
        if (MODE != 2 && t <= my_last) {
            LAS const unsigned char* kb = lds + (t & 1) * PBUF; LAS const unsigned char* vb = kb + PK_BYTES;
#pragma unroll
            for (int T = 0; T < 2; ++T) {
                f32x16 sT;
#pragma unroll
                for (int r = 0; r < 16; ++r) sT[r] = 0.f;
                {
                    LAS const unsigned char* kp = kb + (32 * T + r32) * PK_STR + 16 * hi;
#define PA_LDK(dst, k0) do { _Pragma("unroll") for (int i_ = 0; i_ < 4; ++i_) dst[i_] = *(LAS const bf16x8*)(kp + ((k0) + i_) * 32); } while (0)
#define PA_MMK(src, k0) do { _Pragma("unroll") for (int i_ = 0; i_ < 4; ++i_) sT = __builtin_amdgcn_mfma_f32_32x32x16_bf16(src[i_], qf[(k0) + i_], sT, 0, 0, 0); } while (0)
                    bf16x8 ka[4], kc[4];
                    PA_LDK(ka, 0); PA_LDK(kc, 4); __builtin_amdgcn_sched_barrier(0);
                    PA_MMK(ka, 0); if (T == 0 && fetch) gloadK(t + 1); __builtin_amdgcn_sched_barrier(0);
                    PA_LDK(ka, 8); __builtin_amdgcn_sched_barrier(0);
                    PA_MMK(kc, 4); if (T == 0 && fetch) gloadV(t + 1); __builtin_amdgcn_sched_barrier(0);
                    PA_MMK(ka, 8); __builtin_amdgcn_sched_barrier(0);
#undef PA_LDK
#undef PA_MMK
                }
                float mt = sT[0];
#pragma unroll
                for (int r = 1; r < 16; ++r) mt = fmaxf(mt, sT[r]);
                if (__any(mt > m_run + 8.0f)) {
                    mt = fmaxf(mt, __shfl_xor(mt, 32));
                    const float m_new = fmaxf(m_run, mt); const float alpha = __builtin_amdgcn_exp2f(m_run - m_new); m_run = m_new; l_run *= alpha;
#pragma unroll
                    for (int d = 0; d < 4; ++d)
#pragma unroll
                        for (int r = 0; r < 16; ++r) oT[d][r] *= alpha;
                }
                float ps = 0.f;
#pragma unroll
                for (int r = 0; r < 16; ++r) { const float p = __builtin_amdgcn_exp2f(sT[r] - m_run); sT[r] = p; ps += p; }
                l_run += ps;
                bf16x8 pf[2];
#pragma unroll
                for (int sp = 0; sp < 2; ++sp) pf[sp] = __builtin_bit_cast(bf16x8, (u32x4){pkbf(sT[8 * sp], sT[8 * sp + 1]), pkbf(sT[8 * sp + 2], sT[8 * sp + 3]), pkbf(sT[8 * sp + 4], sT[8 * sp + 5]), pkbf(sT[8 * sp + 6], sT[8 * sp + 7])});
                __builtin_amdgcn_sched_barrier(0);
                {
                    LAS const unsigned char* tp0 = vb + (32 * T + 4 * hi + (i16 >> 2)) * PV_STR + (16 * (gi & 1) + 4 * (i16 & 3)) * 2;
#define PA_LDV(dst, d_) do { dst[0] = tr16(tp0 + (d_) * 64); dst[1] = tr16(tp0 + (d_) * 64 + 8 * PV_STR); dst[2] = tr16(tp0 + (d_) * 64 + 16 * PV_STR); dst[3] = tr16(tp0 + (d_) * 64 + 24 * PV_STR); } while (0)
#define PA_MMV(src, d_) do { oT[d_] = __builtin_amdgcn_mfma_f32_32x32x16_bf16((bf16x8){src[0][0], src[0][1], src[0][2], src[0][3], src[1][0], src[1][1], src[1][2], src[1][3]}, pf[0], oT[d_], 0, 0, 0); \
                        oT[d_] = __builtin_amdgcn_mfma_f32_32x32x16_bf16((bf16x8){src[2][0], src[2][1], src[2][2], src[2][3], src[3][0], src[3][1], src[3][2], src[3][3]}, pf[1], oT[d_], 0, 0, 0); } while (0)
                    v4i16 va[4], vc[4];
                    PA_LDV(va, 0); PA_LDV(vc, 1); __builtin_amdgcn_sched_barrier(0);
                    PA_MMV(va, 0); __builtin_amdgcn_sched_barrier(0);
                    PA_LDV(va, 2); __builtin_amdgcn_sched_barrier(0);
                    PA_MMV(vc, 1); __builtin_amdgcn_sched_barrier(0);
                    PA_LDV(vc, 3); __builtin_amdgcn_sched_barrier(0);
                    PA_MMV(va, 2); __builtin_amdgcn_sched_barrier(0);
                    PA_MMV(vc, 3); __builtin_amdgcn_sched_barrier(0);
#undef PA_LDV
#undef PA_MMV
                }
            }
        }
        if (MODE != 1 && t + 1 < NT) lstore((t + 1) & 1);
        __syncthreads();
    }
    if (MODE != 0 && l_run != 12345.f) return;
    l_run += __shfl_xor(l_run, 32);
    const float rl = 1.0f / l_run;
    bf16_t* orow = (bf16_t*)(ws + WS_O) + (rowb + 256 * qb + 32 * w + r32) * 2048 + h * 128 + 8 * hi;
#pragma unroll
    for (int d = 0; d < 4; ++d)
#pragma unroll
        for (int v = 0; v < 2; ++v) {
            const unsigned a0 = pkbf(oT[d][8 * v] * rl, oT[d][8 * v + 1] * rl), a1 = pkbf(oT[d][8 * v + 2] * rl, oT[d][8 * v + 3] * rl);
            const unsigned b0 = pkbf(oT[d][8 * v + 4] * rl, oT[d][8 * v + 5] * rl), b1 = pkbf(oT[d][8 * v + 6] * rl, oT[d][8 * v + 7] * rl);
            const auto s0 = __builtin_amdgcn_permlane32_swap(a0, b0, false, false), s1 = __builtin_amdgcn_permlane32_swap(a1, b1, false, false);
            *(u32x4*)(orow + 32 * d + 16 * v) = (u32x4){s0[0], s1[0], s0[1], s1[1]};
        }
}

template <int MODE> __device__ __forceinline__ void attn_sample_item(Frame& F, int b, int rg) {
    using namespace att;
    LAS unsigned char* lds = F.lds; unsigned char* ws = F.ws;
    int tid_o = F.tid; asm volatile("" : "+v"(tid_o));
    const int tid = tid_o, lane = tid & 63, w = F.wave, c16 = lane & 15, g = lane >> 4;
    const int wu = __builtin_amdgcn_readfirstlane(w), hh = 4 * rg + (wu >> 1), half = wu & 1;
    const bf16_t* cache = (const bf16_t*)(ws + WS_CACHE) + (size_t)b * KVLEN * 576;
    const float* ct = (const float*)(ws + WS_ROPE); const float* st = ct + 2080 * 32;
    __syncthreads();
    bf16x8 qf[2][6];
    LAS unsigned char* qlp = lds + SQ_OFF + wu * SQ_WAVE + c16 * SQ_STR + 16 * g;
#pragma unroll
    for (int Qb = 0; Qb < 2; ++Qb) {
        const int qrow = b * 32 + 16 * Qb + c16; const bf16_t* ql = (const bf16_t*)(ws + WS_QLAT) + (size_t)qrow * 8192 + hh * 512 + 8 * g + 288 * half;
#pragma unroll
        for (int i = 0; i < 7; ++i) { const u32x4 v = *(const u32x4*)(ql + 32 * i); u32x4 o;
#pragma unroll
            for (int e = 0; e < 4; ++e) o[e] = pkbf(bflo(v[e]) * QSCALE, bfhi(v[e]) * QSCALE);
            if (i < 6) qf[Qb][i] = __builtin_bit_cast(bf16x8, o); else *(LAS u32x4*)(qlp + Qb * 16 * SQ_STR) = o; }
        LAS unsigned char* qd = qlp + Qb * 16 * SQ_STR + 64;
        if (half == 0) {
#pragma unroll
            for (int i = 7; i < 9; ++i) { const u32x4 v = *(const u32x4*)(ql + 32 * i); u32x4 o;
#pragma unroll
                for (int e = 0; e < 4; ++e) o[e] = pkbf(bflo(v[e]) * QSCALE, bfhi(v[e]) * QSCALE);
                *(LAS u32x4*)(qd + (i - 7) * 64) = o; }
        } else {
            const bf16_t* qp = (const bf16_t*)(ws + WS_Q) + (size_t)(MP + qrow) * 3072 + hh * 192 + 128 + 8 * g;
            const u32x4 v1 = *(const u32x4*)qp, v2 = *(const u32x4*)(qp + 32);
            const int pidx = 2048 + 16 * Qb + c16; const float* cp = ct + pidx * 32 + 8 * g; const float* sp = st + pidx * 32 + 8 * g;
            const f32x4 c0 = *(const f32x4*)cp, c1 = *(const f32x4*)(cp + 4), s0 = *(const f32x4*)sp, s1 = *(const f32x4*)(sp + 4);
            float t1[8], t2[8], o1[8], o2[8];
#pragma unroll
            for (int e = 0; e < 4; ++e) { t1[2 * e] = bflo(v1[e]); t1[2 * e + 1] = bfhi(v1[e]); t2[2 * e] = bflo(v2[e]); t2[2 * e + 1] = bfhi(v2[e]); }
#pragma unroll
            for (int e = 0; e < 8; ++e) { const float c = (e < 4) ? c0[e & 3] : c1[e & 3], sn = (e < 4) ? s0[e & 3] : s1[e & 3];
                o1[e] = (t1[e] * c - t2[e] * sn) * QSCALE; o2[e] = (t1[e] * sn + t2[e] * c) * QSCALE; }
            *(LAS u32x4*)(qd) = (u32x4){pkbf(o1[0], o1[1]), pkbf(o1[2], o1[3]), pkbf(o1[4], o1[5]), pkbf(o1[6], o1[7])};
            *(LAS u32x4*)(qd + 64) = (u32x4){pkbf(o2[0], o2[1]), pkbf(o2[2], o2[3]), pkbf(o2[4], o2[5]), pkbf(o2[6], o2[7])};
        }
    }
    f32x4 oT[16][2];
#pragma unroll
    for (int c = 0; c < 16; ++c) { oT[c][0] = (f32x4){0.f, 0.f, 0.f, 0.f}; oT[c][1] = oT[c][0]; }
    float m_run0 = -INFINITY, m_run1 = -INFINITY, l_run0 = 0.f, l_run1 = 0.f;
    const unsigned lds0 = (unsigned)(uintptr_t)lds;
    const unsigned voff_main = (unsigned)lane * 16u, voff_tail = (unsigned)(((lane & 31) * 576 + 512 + (lane >> 5) * 8) * 2);
    auto dma_piece = [&](int t, int buf, int i) {
        const unsigned long long src = (unsigned long long)(uintptr_t)(cache + (size_t)t * 32 * 576);
        { const int p = wu + 8 * i;
            if (p < 32) { const unsigned long long sb = src + (unsigned long long)p * 1152ull;
                glds16s((const void*)(uintptr_t)(((unsigned long long)(unsigned)__builtin_amdgcn_readfirstlane((unsigned)(sb >> 32)) << 32) | (unsigned)__builtin_amdgcn_readfirstlane((unsigned)sb)), voff_main, (unsigned)__builtin_amdgcn_readfirstlane(lds0 + buf * SK_BUF + p * SK_STR)); }
            else if (p < 36) { const unsigned long long sb = src + (unsigned long long)(p - 32) * 32ull;
                glds16s((const void*)(uintptr_t)(((unsigned long long)(unsigned)__builtin_amdgcn_readfirstlane((unsigned)(sb >> 32)) << 32) | (unsigned)__builtin_amdgcn_readfirstlane((unsigned)sb)), voff_tail, (unsigned)__builtin_amdgcn_readfirstlane(lds0 + buf * SK_BUF + SK_MAIN + (p - 32) * 1024)); } }
    };
    auto dma = [&](int t, int buf) {
#pragma unroll
        for (int i = 0; i < 5; ++i) dma_piece(t, buf, i); };
    const int kofs = c16 * SK_STR + 16 * g + 576 * half;
    const int kofs7 = half ? SK_MAIN + g * 512 + c16 * 16 : c16 * SK_STR + 16 * g + 448;
    const int k8st = half ? 2048 : 64, ktst = half ? 256 : 16 * SK_STR;
    const int exwo = SX_OFF + wu * 4096, exro = SX_OFF + (wu ^ 1) * 4096;
    constexpr int NT = KVLEN / 32;
    dma(0, 0);
    asm volatile("s_waitcnt vmcnt(0)" ::: "memory");
    __syncthreads();
    for (int t = 0; t < NT; ++t) {
        const bool more = t + 1 < NT;
        LAS const unsigned char* kb = lds + (t & 1) * SK_BUF;
        f32x4 sT[2][2];
        sT[0][0] = (f32x4){0.f, 0.f, 0.f, 0.f}; sT[0][1] = sT[0][0]; sT[1][0] = sT[0][0]; sT[1][1] = sT[0][0];
        {
#define ZK_LD(dst, i) do { if ((i) < 7) { dst[0] = *(LAS const bf16x8*)(kb + kofs + 64 * (i)); dst[1] = *(LAS const bf16x8*)(kb + kofs + 16 * SK_STR + 64 * (i)); } \
                           else { const int o_ = ((i) == 7) ? kofs7 : kofs7 + k8st; dst[0] = *(LAS const bf16x8*)(kb + o_); dst[1] = *(LAS const bf16x8*)(kb + o_ + ktst); } } while (0)
#define ZK_Q(Qb, i) (((i) < 6) ? qf[Qb][(i) < 6 ? (i) : 0] : *(LAS const bf16x8*)(qlp + (Qb) * 16 * SQ_STR + ((i) - 6) * 64))
#define ZK_MM(src, i) do { const bf16x8 qa_ = ZK_Q(0, i), qb_ = ZK_Q(1, i); \
            sT[0][0] = __builtin_amdgcn_mfma_f32_16x16x32_bf16(src[0], qa_, sT[0][0], 0, 0, 0); sT[1][0] = __builtin_amdgcn_mfma_f32_16x16x32_bf16(src[1], qa_, sT[1][0], 0, 0, 0); \
            sT[0][1] = __builtin_amdgcn_mfma_f32_16x16x32_bf16(src[0], qb_, sT[0][1], 0, 0, 0); sT[1][1] = __builtin_amdgcn_mfma_f32_16x16x32_bf16(src[1], qb_, sT[1][1], 0, 0, 0); } while (0)
            bf16x8 ka[2], kc[2], ke[2];
            ZK_LD(ka, 0); ZK_LD(kc, 1); __builtin_amdgcn_sched_barrier(0);
#pragma unroll
            for (int i = 0; i < 9; i += 3) {
                if (i + 2 < 9) { ZK_LD(ke, i + 2); } __builtin_amdgcn_sched_barrier(0);
                ZK_MM(ka, i); if (more && i < 5) dma_piece(t + 1, (t + 1) & 1, i); __builtin_amdgcn_sched_barrier(0);
                if (i + 3 < 9) { ZK_LD(ka, i + 3); } __builtin_amdgcn_sched_barrier(0);
                ZK_MM(kc, i + 1); if (more && i + 1 < 5) dma_piece(t + 1, (t + 1) & 1, i + 1); __builtin_amdgcn_sched_barrier(0);
                if (i + 4 < 9) { ZK_LD(kc, i + 4); } __builtin_amdgcn_sched_barrier(0);
                ZK_MM(ke, i + 2); if (more && i + 2 < 5) dma_piece(t + 1, (t + 1) & 1, i + 2); __builtin_amdgcn_sched_barrier(0);
            }
#undef ZK_LD
#undef ZK_Q
#undef ZK_MM
        }
        { LAS unsigned char* exw = lds + exwo + lane * 16;
          *(LAS f32x4*)(exw) = sT[0][0]; *(LAS f32x4*)(exw + 1024) = sT[1][0]; *(LAS f32x4*)(exw + 2048) = sT[0][1]; *(LAS f32x4*)(exw + 3072) = sT[1][1]; }
        LAS const unsigned char* tp0 = kb + (4 * g + (c16 >> 2)) * SK_STR + (4 * (c16 & 3)) * 2 + 512 * half;
#define ZV_LD(dst, c0) do { dst[0] = tr16(tp0 + (c0) * 32); dst[1] = tr16(tp0 + (c0) * 32 + 16 * SK_STR); dst[2] = tr16(tp0 + ((c0) + 1) * 32); dst[3] = tr16(tp0 + ((c0) + 1) * 32 + 16 * SK_STR); } while (0)
        v4i16 va[4], vc[4], ve[4];
        ZV_LD(va, 0);
        __syncthreads();
        { LAS const unsigned char* exr = lds + exro + lane * 16;
          const f32x4 e0 = *(LAS const f32x4*)(exr), e1 = *(LAS const f32x4*)(exr + 1024), e2 = *(LAS const f32x4*)(exr + 2048), e3 = *(LAS const f32x4*)(exr + 3072);
          sT[0][0] = sT[0][0] + e0; sT[1][0] = sT[1][0] + e1; sT[0][1] = sT[0][1] + e2; sT[1][1] = sT[1][1] + e3; }
        ZV_LD(vc, 2);
        float mt0 = fmaxf(fmaxf(fmaxf(sT[0][0][0], sT[0][0][1]), fmaxf(sT[0][0][2], sT[0][0][3])), fmaxf(fmaxf(sT[1][0][0], sT[1][0][1]), fmaxf(sT[1][0][2], sT[1][0][3])));
        float mt1 = fmaxf(fmaxf(fmaxf(sT[0][1][0], sT[0][1][1]), fmaxf(sT[0][1][2], sT[0][1][3])), fmaxf(fmaxf(sT[1][1][0], sT[1][1][1]), fmaxf(sT[1][1][2], sT[1][1][3])));
        if (__any(mt0 > m_run0 + 8.0f || mt1 > m_run1 + 8.0f)) {
            mt0 = fmaxf(mt0, __shfl_xor(mt0, 16)); mt0 = fmaxf(mt0, __shfl_xor(mt0, 32)); mt1 = fmaxf(mt1, __shfl_xor(mt1, 16)); mt1 = fmaxf(mt1, __shfl_xor(mt1, 32));
            const float n0 = fmaxf(m_run0, mt0), n1 = fmaxf(m_run1, mt1); const float a0 = __builtin_amdgcn_exp2f(m_run0 - n0), a1 = __builtin_amdgcn_exp2f(m_run1 - n1);
            m_run0 = n0; m_run1 = n1; l_run0 *= a0; l_run1 *= a1;
#pragma unroll
            for (int c = 0; c < 16; ++c) { oT[c][0] = oT[c][0] * a0; oT[c][1] = oT[c][1] * a1; }
        }
        bf16x8 pf0, pf1;
        { float p[8];
#pragma unroll
          for (int T = 0; T < 2; ++T)
#pragma unroll
              for (int r = 0; r < 4; ++r) { p[4 * T + r] = __builtin_amdgcn_exp2f(sT[T][0][r] - m_run0); l_run0 += p[4 * T + r]; }
          pf0 = __builtin_bit_cast(bf16x8, (u32x4){pkbf(p[0], p[1]), pkbf(p[2], p[3]), pkbf(p[4], p[5]), pkbf(p[6], p[7])});
#pragma unroll
          for (int T = 0; T < 2; ++T)
#pragma unroll
              for (int r = 0; r < 4; ++r) { p[4 * T + r] = __builtin_amdgcn_exp2f(sT[T][1][r] - m_run1); l_run1 += p[4 * T + r]; }
          pf1 = __builtin_bit_cast(bf16x8, (u32x4){pkbf(p[0], p[1]), pkbf(p[2], p[3]), pkbf(p[4], p[5]), pkbf(p[6], p[7])}); }
        {
#define ZV_MM(src, c0) do { const bf16x8 v0_ = (bf16x8){src[0][0], src[0][1], src[0][2], src[0][3], src[1][0], src[1][1], src[1][2], src[1][3]}, v1_ = (bf16x8){src[2][0], src[2][1], src[2][2], src[2][3], src[3][0], src[3][1], src[3][2], src[3][3]}; \
                oT[(c0)][0] = __builtin_amdgcn_mfma_f32_16x16x32_bf16(v0_, pf0, oT[(c0)][0], 0, 0, 0); oT[(c0)][1] = __builtin_amdgcn_mfma_f32_16x16x32_bf16(v0_, pf1, oT[(c0)][1], 0, 0, 0); \
                oT[(c0) + 1][0] = __builtin_amdgcn_mfma_f32_16x16x32_bf16(v1_, pf0, oT[(c0) + 1][0], 0, 0, 0); oT[(c0) + 1][1] = __builtin_amdgcn_mfma_f32_16x16x32_bf16(v1_, pf1, oT[(c0) + 1][1], 0, 0, 0); } while (0)
#pragma unroll
            for (int cb = 0; cb < 8; cb += 3) {
                if (cb + 2 < 8) { ZV_LD(ve, 2 * (cb + 2)); } __builtin_amdgcn_sched_barrier(0);
                ZV_MM(va, 2 * cb); __builtin_amdgcn_sched_barrier(0);
                if (cb + 3 < 8) { ZV_LD(va, 2 * (cb + 3)); } __builtin_amdgcn_sched_barrier(0);
                if (cb + 1 < 8) { ZV_MM(vc, 2 * (cb + 1)); } __builtin_amdgcn_sched_barrier(0);
                if (cb + 4 < 8) { ZV_LD(vc, 2 * (cb + 4)); } __builtin_amdgcn_sched_barrier(0);
                if (cb + 2 < 8) { ZV_MM(ve, 2 * (cb + 2)); } __builtin_amdgcn_sched_barrier(0);
            }
#undef ZV_LD
#undef ZV_MM
        }
        asm volatile("s_waitcnt vmcnt(0)" ::: "memory");
        __syncthreads();
    }
    l_run0 += __shfl_xor(l_run0, 16); l_run0 += __shfl_xor(l_run0, 32); l_run1 += __shfl_xor(l_run1, 16); l_run1 += __shfl_xor(l_run1, 32);
    const float rl0 = 1.0f / l_run0, rl1 = 1.0f / l_run1;
    bf16x8 of[8][2];
#pragma unroll
    for (int kb2 = 0; kb2 < 8; ++kb2) {
        { const f32x4 a = oT[2 * kb2][0] * rl0, c2 = oT[2 * kb2 + 1][0] * rl0; of[kb2][0] = __builtin_bit_cast(bf16x8, (u32x4){pkbf(a[0], a[1]), pkbf(a[2], a[3]), pkbf(c2[0], c2[1]), pkbf(c2[2], c2[3])}); }
        { const f32x4 a = oT[2 * kb2][1] * rl1, c2 = oT[2 * kb2 + 1][1] * rl1; of[kb2][1] = __builtin_bit_cast(bf16x8, (u32x4){pkbf(a[0], a[1]), pkbf(a[2], a[3]), pkbf(c2[0], c2[1]), pkbf(c2[2], c2[3])}); } }
    const bf16_t* wuv = (const bf16_t*)(ws + WS_WUV) + (size_t)(hh * 128 + c16) * 512 + 256 * half + 4 * g;
    LAS unsigned char* e2w = lds + wu * 8192 + lane * 16; LAS const unsigned char* e2r = lds + (wu ^ 1) * 8192 + lane * 16;
    f32x4 keep[8];
#pragma unroll
    for (int vt = 0; vt < 8; ++vt) { f32x4 a0 = (f32x4){0.f, 0.f, 0.f, 0.f}, a1 = a0;
#pragma unroll
        for (int kb2 = 0; kb2 < 8; ++kb2) { const u32x2 w0 = *(const u32x2*)(wuv + (size_t)vt * 16 * 512 + 32 * kb2), w1 = *(const u32x2*)(wuv + (size_t)vt * 16 * 512 + 32 * kb2 + 16);
            const bf16x8 wa = __builtin_bit_cast(bf16x8, (u32x4){w0.x, w0.y, w1.x, w1.y});
            a0 = __builtin_amdgcn_mfma_f32_16x16x32_bf16(wa, of[kb2][0], a0, 0, 0, 0); a1 = __builtin_amdgcn_mfma_f32_16x16x32_bf16(wa, of[kb2][1], a1, 0, 0, 0); }
        keep[vt] = half ? a1 : a0; *(LAS f32x4*)(e2w + vt * 1024) = half ? a0 : a1; }
    __syncthreads();
    bf16_t* orow = (bf16_t*)(ws + WS_O) + (size_t)(MP + b * 32 + 16 * half + c16) * 2048 + hh * 128 + 4 * g;
#pragma unroll
    for (int vt = 0; vt < 8; ++vt) { const f32x4 a = keep[vt] + *(LAS const f32x4*)(e2r + vt * 1024);
        *(u32x2*)(orow + 16 * vt) = (u32x2){pkbf(a[0], a[1]), pkbf(a[2], a[3])}; }
}


struct MixOrder {
    const char *A0, *B0, *A1, *B1; int G, c;
    __device__ __forceinline__ bool next(int i, pg8::Unit& u) const {
        const int idx = (i >> 1) * G + c; if (idx >= (MP / 256) * 4) return false;
        u.pm = idx >> 2; u.pn = idx & 3; u.seg = i & 1;
        u.a = ((i & 1) ? A1 : A0) + (size_t)u.pm * 256 * 2048 * 2; u.b = ((i & 1) ? B1 : B0) + (size_t)u.pn * 256 * 2048 * 2; return true;
    }
};
struct EpiMix {
    static constexpr bool PERM = true;
    const bf16_t* gates; const float* bgate; bf16_t* t1; bf16_t* uo;
    __device__ __forceinline__ void operator()(const f32x4 (&acc)[2][2][4][2], const pg8::Unit& u, int wr, int wc, int fr, int fq) const {
        const int row0 = u.pm * 256 + wr * 64 + fr, col0 = u.pn * 256 + wc * 32 + 8 * fq, gofs = u.seg ? 1024 : 0;
#pragma unroll
        for (int bj = 0; bj < 2; ++bj) { const int col = col0 + bj * 128;
            const f32x4 bg0 = *(const f32x4*)(bgate + gofs + col), bg1 = *(const f32x4*)(bgate + gofs + col + 4);
#pragma unroll
            for (int ai = 0; ai < 2; ++ai)
#pragma unroll
                for (int m = 0; m < 4; ++m) { const size_t row = (size_t)(row0 + ai * 128 + m * 16);
                    const u32x4 gv = *(const u32x4*)(gates + row * 2048 + gofs + col);
                    const f32x4 a0 = acc[ai][bj][m][0], a1 = acc[ai][bj][m][1];
                    f32x4 r0, r1;
                    r0[0] = sigmoidf_(bflo(gv[0]) + bg0[0]) * a0[0]; r0[1] = sigmoidf_(bfhi(gv[0]) + bg0[1]) * a0[1]; r0[2] = sigmoidf_(bflo(gv[1]) + bg0[2]) * a0[2]; r0[3] = sigmoidf_(bfhi(gv[1]) + bg0[3]) * a0[3];
                    r1[0] = sigmoidf_(bflo(gv[2]) + bg1[0]) * a1[0]; r1[1] = sigmoidf_(bfhi(gv[2]) + bg1[1]) * a1[1]; r1[2] = sigmoidf_(bflo(gv[3]) + bg1[2]) * a1[2]; r1[3] = sigmoidf_(bfhi(gv[3]) + bg1[3]) * a1[3];
                    bf16_t* tp = t1 + row * 1024 + col;
                    if (u.seg == 0) { *(u32x4*)tp = (u32x4){pg8::cvt_pk_bf16(r0[0], r0[1]), pg8::cvt_pk_bf16(r0[2], r0[3]), pg8::cvt_pk_bf16(r1[0], r1[1]), pg8::cvt_pk_bf16(r1[2], r1[3])}; }
                    else { const u32x4 pv = *(const u32x4*)tp; r0 = r0 + (f32x4){bflo(pv[0]), bfhi(pv[0]), bflo(pv[1]), bfhi(pv[1])}; r1 = r1 + (f32x4){bflo(pv[2]), bfhi(pv[2]), bflo(pv[3]), bfhi(pv[3])};
                        *(u32x4*)(uo + row * 1024 + col) = (u32x4){pg8::cvt_pk_bf16(r0[0], r0[1]), pg8::cvt_pk_bf16(r0[2], r0[3]), pg8::cvt_pk_bf16(r1[0], r1[1]), pg8::cvt_pk_bf16(r1[2], r1[3])}; } } }
    }
};
struct EpiV1 {
    static constexpr bool PERM = true;
    const bf16_t* xin; bf16_t* ao; float* st;
    __device__ __forceinline__ void operator()(const f32x4 (&acc)[2][2][4][2], const pg8::Unit& u, int wr, int wc, int fr, int fq) const {
        const int row0 = u.pm * 256 + wr * 64 + fr, col0 = u.pn * 256 + wc * 32 + 8 * fq;
#pragma unroll
        for (int ai = 0; ai < 2; ++ai)
#pragma unroll
            for (int m = 0; m < 4; ++m) { const int row = row0 + ai * 128 + m * 16; const bf16_t* rp = xin + (size_t)row * 1024; float s1 = 0.f, s2 = 0.f;
#pragma unroll
                for (int bj = 0; bj < 2; ++bj) { const int col = col0 + bj * 128;
                    const u32x4 xv = *(const u32x4*)(rp + col); const f32x4 x0 = (f32x4){bflo(xv[0]), bfhi(xv[0]), bflo(xv[1]), bfhi(xv[1])}, x1 = (f32x4){bflo(xv[2]), bfhi(xv[2]), bflo(xv[3]), bfhi(xv[3])};
                    const f32x4 a = x0 * ALPHA + acc[ai][bj][m][0], b = x1 * ALPHA + acc[ai][bj][m][1];
                    s1 += ((a[0] + a[1]) + (a[2] + a[3])) + ((b[0] + b[1]) + (b[2] + b[3]));
                    s2 += ((a[0] * a[0] + a[1] * a[1]) + (a[2] * a[2] + a[3] * a[3])) + ((b[0] * b[0] + b[1] * b[1]) + (b[2] * b[2] + b[3] * b[3]));
                    *(u32x4*)(ao + (size_t)row * 1024 + col) = (u32x4){pg8::cvt_pk_bf16(a[0], a[1]), pg8::cvt_pk_bf16(a[2], a[3]), pg8::cvt_pk_bf16(b[0], b[1]), pg8::cvt_pk_bf16(b[2], b[3])}; }
                s1 += __shfl_xor(s1, 16); s1 += __shfl_xor(s1, 32); s2 += __shfl_xor(s2, 16); s2 += __shfl_xor(s2, 32);
                if (fq == 0) { atomicAdd(st + 2 * (size_t)row, s1); atomicAdd(st + 2 * (size_t)row + 1, s2); } }
    }
};
struct EpiV2 {
    static constexpr bool PERM = true;
    const bf16_t* v1i; const float* st; const float* g1; const float* b1; bf16_t* out;
    __device__ __forceinline__ void operator()(const f32x4 (&acc)[2][2][4][2], const pg8::Unit& u, int wr, int wc, int fr, int fq) const {
        const int row0 = u.pm * 256 + wr * 64 + fr, col0 = u.pn * 256 + wc * 32 + 8 * fq;
        f32x4 gA[2][2], bA[2][2];
#pragma unroll
        for (int bj = 0; bj < 2; ++bj) { gA[bj][0] = *(const f32x4*)(g1 + col0 + bj * 128) * ALPHA; gA[bj][1] = *(const f32x4*)(g1 + col0 + bj * 128 + 4) * ALPHA; bA[bj][0] = *(const f32x4*)(b1 + col0 + bj * 128) * ALPHA; bA[bj][1] = *(const f32x4*)(b1 + col0 + bj * 128 + 4) * ALPHA; }
#pragma unroll
        for (int ai = 0; ai < 2; ++ai)
#pragma unroll
            for (int m = 0; m < 4; ++m) { const int row = row0 + ai * 128 + m * 16; const bf16_t* rp = v1i + (size_t)row * 1024;
                const f32x2 ss = *(const f32x2*)(st + 2 * (size_t)row); const float mu = ss.x * (1.f / 1024.f), rs = 1.0f / sqrtf(ss.y * (1.f / 1024.f) - mu * mu + LN_EPS);
#pragma unroll
                for (int bj = 0; bj < 2; ++bj) { const int col = col0 + bj * 128;
                    const u32x4 xv = *(const u32x4*)(rp + col);
                    const f32x4 x0 = ((f32x4){bflo(xv[0]), bfhi(xv[0]), bflo(xv[1]), bfhi(xv[1])} - mu) * rs, x1 = ((f32x4){bflo(xv[2]), bfhi(xv[2]), bflo(xv[3]), bfhi(xv[3])} - mu) * rs;
                    const f32x4 o0 = x0 * gA[bj][0] + bA[bj][0] + acc[ai][bj][m][0], o1 = x1 * gA[bj][1] + bA[bj][1] + acc[ai][bj][m][1];
                    *(u32x4*)(out + (size_t)row * 1024 + col) = (u32x4){pg8::cvt_pk_bf16(o0[0], o0[1]), pg8::cvt_pk_bf16(o0[2], o0[3]), pg8::cvt_pk_bf16(o1[0], o1[1]), pg8::cvt_pk_bf16(o1[2], o1[3])}; } }
    }
};
struct EpiRelu2 {
    static constexpr bool PERM = true;
    bf16_t* out; const float* st; const float* gw;
    __device__ __forceinline__ void operator()(const f32x4 (&acc)[2][2][4][2], const pg8::Unit& u, int wr, int wc, int fr, int fq) const {
        const int row0 = u.pm * 256 + wr * 64 + fr, col0 = u.pn * 256 + wc * 32 + 8 * fq;
        bf16_t* p = out + (size_t)row0 * 4096 + col0;
        f32x4 gA[2][2], bA[2][2];
#pragma unroll
        for (int bj = 0; bj < 2; ++bj) { gA[bj][0] = *(const f32x4*)(gw + col0 + bj * 128); gA[bj][1] = *(const f32x4*)(gw + col0 + bj * 128 + 4); bA[bj][0] = *(const f32x4*)(gw + 4096 + col0 + bj * 128); bA[bj][1] = *(const f32x4*)(gw + 4096 + col0 + bj * 128 + 4); }
#pragma unroll
        for (int ai = 0; ai < 2; ++ai)
#pragma unroll
            for (int m = 0; m < 4; ++m) { const int row = row0 + ai * 128 + m * 16;
                const f32x2 ss = *(const f32x2*)(st + 2 * (size_t)row); const float mu = ss.x * (1.f / 1024.f), rs = 1.0f / sqrtf(ss.y * (1.f / 1024.f) - mu * mu + LN_EPS), rm = rs * mu;
#pragma unroll
                for (int bj = 0; bj < 2; ++bj) { f32x4 v0 = acc[ai][bj][m][0] * rs - gA[bj][0] * rm + bA[bj][0], v1 = acc[ai][bj][m][1] * rs - gA[bj][1] * rm + bA[bj][1];
#pragma unroll
                    for (int e = 0; e < 4; ++e) { const float a = fmaxf(v0[e], 0.f), b = fmaxf(v1[e], 0.f); v0[e] = a * a; v1[e] = b * b; }
                    *(u32x4*)(p + (size_t)(ai * 128 + m * 16) * 4096 + bj * 128) = (u32x4){pg8::cvt_pk_bf16(v0[0], v0[1]), pg8::cvt_pk_bf16(v0[2], v0[3]), pg8::cvt_pk_bf16(v1[0], v1[1]), pg8::cvt_pk_bf16(v1[2], v1[3])}; } }
    }
};
template <bool FINAL> __device__ __forceinline__ void ln_rows(Frame& F, const void* srcv, const float* gam, const float* bet, float* dstf, bf16_t* dstb) {
    const int gw = F.vcu * NWAVES + F.wave, NGW = F.G * NWAVES, lane = F.lane;
    f32x4 gg[4], bb[4];
#pragma unroll
    for (int j = 0; j < 4; ++j) { gg[j] = *(const f32x4*)(gam + 4 * lane + 256 * j); bb[j] = *(const f32x4*)(bet + 4 * lane + 256 * j); }
    for (int m = gw; m < M; m += NGW) {
        f32x4 v[4]; float s = 0.f;
#pragma unroll
        for (int j = 0; j < 4; ++j) {
            if (FINAL) { const u32x2 t = __builtin_nontemporal_load((const u32x2*)((const bf16_t*)srcv + (size_t)m * 1024 + 4 * lane + 256 * j)); v[j] = (f32x4){bflo(t[0]), bfhi(t[0]), bflo(t[1]), bfhi(t[1])}; }
            else v[j] = *(const f32x4*)((const float*)srcv + (size_t)m * 1024 + 4 * lane + 256 * j);
            s += (v[j].x + v[j].y) + (v[j].z + v[j].w); }
        const float mean = wave_sum(s) * (1.f / 1024.f); float s2 = 0.f;
#pragma unroll
        for (int j = 0; j < 4; ++j) { v[j] = v[j] - mean; s2 += (v[j].x * v[j].x + v[j].y * v[j].y) + (v[j].z * v[j].z + v[j].w * v[j].w); }
        const float rstd = 1.f / sqrtf(wave_sum(s2) * (1.f / 1024.f) + LN_EPS);
        float* of = FINAL ? ((m < MP) ? F.out + O_YP + (size_t)m * 1024 : F.out + O_YS + (size_t)(m - MP) * 1024) : dstf + (size_t)m * 1024;
#pragma unroll
        for (int j = 0; j < 4; ++j) { const f32x4 o = v[j] * rstd * gg[j] + bb[j]; if (FINAL) __builtin_nontemporal_store(o, (f32x4*)(of + 4 * lane + 256 * j)); else *(f32x4*)(of + 4 * lane + 256 * j) = o;
            if (!FINAL) *(u32x2*)(dstb + (size_t)m * 1024 + 4 * lane + 256 * j) = (u32x2){pk2(o.x, o.y), pk2(o.z, o.w)}; }
    }
}
__device__ __forceinline__ void yz_norm_item(Frame& F, const float* gain, int pm) {
    int lane_o = F.lane; asm volatile("" : "+v"(lane_o));
    const int lane = lane_o; unsigned char* ws = F.ws;
    f32x4 g0[4], g1[4];
#pragma unroll
    for (int i = 0; i < 4; ++i) { const int ch = lane * 8 + 512 * i; g0[i] = *(const f32x4*)(gain + ch); g1[i] = *(const f32x4*)(gain + ch + 4); }
#pragma unroll 1
    for (int hb = 0; hb < 4; ++hb) {
        u32x4 v[2][4]; f32x4 q4[2][4];
#pragma unroll
        for (int r = 0; r < 2; ++r) { const size_t row = (size_t)pm * 64 + F.wave * 8 + hb * 2 + r; const bf16_t* p = (const bf16_t*)(ws + WS_YZ) + row * 2048; const float* sq = (const float*)(ws + WS_SSQ) + row * 32;
#pragma unroll
            for (int i = 0; i < 4; ++i) { const int ch = lane * 8 + 512 * i; v[r][i] = *(const u32x4*)(p + ch); q4[r][i] = *(const f32x4*)(sq + 4 * (ch >> 8)); } }
#pragma unroll
        for (int r = 0; r < 2; ++r) { const size_t row = (size_t)pm * 64 + F.wave * 8 + hb * 2 + r; bf16_t* p = (bf16_t*)(ws + WS_YZ) + row * 2048;
#pragma unroll
            for (int i = 0; i < 4; ++i) { const int ch = lane * 8 + 512 * i; const f32x4 q = q4[r][i]; const float rs = 1.0f / sqrtf(((q.x + q.y) + (q.z + q.w)) * (1.0f / 256.0f) + RMS_EPS); const u32x4 x = v[r][i];
                *(u32x4*)(p + ch) = (u32x4){pk2(bflo(x[0]) * rs * g0[i][0], bfhi(x[0]) * rs * g0[i][1]), pk2(bflo(x[1]) * rs * g0[i][2], bfhi(x[1]) * rs * g0[i][3]),
                                            pk2(bflo(x[2]) * rs * g1[i][0], bfhi(x[2]) * rs * g1[i][1]), pk2(bflo(x[3]) * rs * g1[i][2], bfhi(x[3]) * rs * g1[i][3])}; } }
    }
}

template <int K> __device__ __forceinline__ void sgemm_tile(Frame& F, const bf16_t* a0, int lda, const bf16_t* b0, int ldb, float (&v)[8]) {
    int tid_o = F.tid; asm volatile("" : "+v"(tid_o));
    const int tid = tid_o, lane = tid & 63, c16 = lane & 15, g = lane >> 4;
    const int wu = __builtin_amdgcn_readfirstlane(tid >> 6);
    LAS unsigned char* lds = F.lds;
    constexpr int NST = K / 128, STB = 32768, OUT_OFF = 4 * STB;
    const unsigned char* gbase = (wu < 4) ? (const unsigned char*)a0 : (const unsigned char*)b0; const int ld = (wu < 4) ? lda : ldb;
    unsigned gofs[4];
#pragma unroll
    for (int i = 0; i < 4; ++i) { const int row = 16 * (wu & 3) + 4 * i + (lane >> 4); gofs[i] = (unsigned)row * (unsigned)ld * 2u + 16u * (unsigned)((lane & 15) ^ (row & 15)); }
#define SG_ISSUE(st_) do { _Pragma("unroll") for (int i = 0; i < 4; ++i) __builtin_amdgcn_global_load_lds((const unsigned*)(gbase + gofs[i] + (size_t)(st_) * 256), (LAS unsigned*)(lds + ((st_) & 3) * STB + wu * 4096 + i * 1024), 16, 0, 0); } while (0)
    f32x4 acc0 = (f32x4){0.f, 0.f, 0.f, 0.f}, acc1 = acc0;
    const int ib = wu >> 1, jh = wu & 1;
    const int aoff = (16 * ib + c16) * 256, boff = 16384 + (32 * jh + c16) * 256;
    __syncthreads();
    SG_ISSUE(0); if (NST > 1) SG_ISSUE(1); if (NST > 2) SG_ISSUE(2);
#pragma unroll 1
    for (int st = 0; st < NST; ++st) {
        if (st + 2 < NST) asm volatile("s_waitcnt vmcnt(8)" ::: "memory"); else if (st + 1 < NST) asm volatile("s_waitcnt vmcnt(4)" ::: "memory"); else asm volatile("s_waitcnt vmcnt(0)" ::: "memory");
        __syncthreads();
        if (st + 3 < NST) SG_ISSUE(st + 3);
        LAS const unsigned char* sb = lds + (st & 3) * STB;
        bf16x8 fa[4], fb0[4], fb1[4];
#pragma unroll
        for (int ks = 0; ks < 4; ++ks) { const int sw = 16 * ((4 * ks + g) ^ c16);
            fa[ks] = *(LAS const bf16x8*)(sb + aoff + sw); fb0[ks] = *(LAS const bf16x8*)(sb + boff + sw); fb1[ks] = *(LAS const bf16x8*)(sb + boff + 16 * 256 + sw); }
#pragma unroll
        for (int ks = 0; ks < 4; ++ks) { acc0 = __builtin_amdgcn_mfma_f32_16x16x32_bf16(fa[ks], fb0[ks], acc0, 0, 0, 0); acc1 = __builtin_amdgcn_mfma_f32_16x16x32_bf16(fa[ks], fb1[ks], acc1, 0, 0, 0); }
    }
#undef SG_ISSUE
    LAS float* ot = (LAS float*)(lds + OUT_OFF);
#pragma unroll
    for (int r = 0; r < 4; ++r) { ot[(16 * ib + 4 * g + r) * 64 + 32 * jh + c16] = acc0[r]; ot[(16 * ib + 4 * g + r) * 64 + 32 * jh + 16 + c16] = acc1[r]; }
    __syncthreads();
    { LAS const float* pr = ot + (tid >> 3) * 64 + (tid & 7) * 8; const f32x4 s0 = *(LAS const f32x4*)pr, s1 = *(LAS const f32x4*)(pr + 4);
      v[0] = s0[0]; v[1] = s0[1]; v[2] = s0[2]; v[3] = s0[3]; v[4] = s1[0]; v[5] = s1[1]; v[6] = s1[2]; v[7] = s1[3]; }
}

constexpr int N_PHASES = 11;
__global__ void __launch_bounds__(NTHREADS, 2) fwd_kernel(Args args) {
    extern __shared__ __attribute__((aligned(16))) unsigned char lds_raw[];
    Frame F;
    F.lds = (LAS unsigned char*)lds_raw;
    F.tid = threadIdx.x; F.lane = F.tid & 63; F.wave = __builtin_amdgcn_readfirstlane(F.tid >> 6);
    F.G = gridDim.x; { const int bx = blockIdx.x; F.vcu = (F.G % 8 == 0) ? (bx % 8) * (F.G / 8) + bx / 8 : bx; }
    F.ws = args.ws; F.out = args.out;
    unsigned* ctl = (unsigned*)(args.ws + WS_CTL);
    volatile LAS unsigned* MISC = (volatile LAS unsigned*)(F.lds + MISC_OFF);
    for (int u = F.tid; u < (LDS_BYTES - LDSCTL_OFF) / 4; u += NTHREADS) ((LAS unsigned*)(F.lds + LDSCTL_OFF))[u] = 0u;
    __syncthreads();
    XcdBarrier bar; bar.bar = ctl + CW_BAR; bar.x = 0; bar.st = nullptr;
#if !MK_PER_PHASE
    bar = xcd_barrier_post(ctl + CW_BAR, MISC + 8);
#define GRID_BAR() xcd_barrier(bar)
#else
#define GRID_BAR() do {} while (0)
#endif
    const int lo = args.ph_lo, hi = args.ph_hi;
#define IN(k) (lo <= (k) && (k) < hi)
#define BOTH(k) (IN(k) && IN((k) + 1))

    if (IN(0)) { for (int rep = 0; rep < NREP(0); ++rep) { p0_prologue(F, args); if (BOTH(0)) GRID_BAR(); } }
    if (IN(1)) {
        unsigned char* ws = args.ws;
        {
            pg8::SegOrder S; S.nseg = 1; S.G = F.G; S.c = (int)blockIdx.x; S.dup = 1;
            S.s[0] = pg8::Seg{(const char*)(ws + WS_XB), (const char*)(ws + WS_WIN), M / 256, NPROJ / 256, 0, (M / 256) * (NPROJ / 256), (size_t)256 * 1024 * 2, (size_t)256 * 1024 * 2};
            S.total = S.s[0].count; S.dup = DIAG_DUP_G1;
            EpiProj E{ws, args.out};
            pg8::gemm_phase<EpiProj, pg8::SegOrder>(F.lds, 1024, 1024, 1024, S, E);
        }
        {
            pg8::WqlOrder S{(const char*)(ws + WS_WUKB), (const char*)(ws + WS_BQL), F.G, (int)blockIdx.x};
            bf16_t* wq = (bf16_t*)(ws + WS_WQL); EpiStore E{wq, wq, wq, wq, 512, 512, 512, 512};
            pg8::gemm_phase<EpiStore, pg8::WqlOrder>(F.lds, 256, 2048, 256, S, E);
        }
        if (BOTH(1)) GRID_BAR();
    }
    if (IN(2)) { p1b_rows(F, args);
        {
            const int gt = F.vcu * NTHREADS + F.tid, NGT = F.G * NTHREADS; const float* part = (const float*)(args.ws + WS_GWP); float* gwv = (float*)(args.ws + WS_GW); float* stz = (float*)(args.ws + WS_ST);
            for (int i = gt; i < 2 * 4096; i += NGT) { const int n = i & 4095, wh = i >> 12; float a = 0.f;
#pragma unroll 8
                for (int ks = 0; ks < 32; ++ks) a += part[(ks * 2 + wh) * 4096 + n];
                gwv[i] = a; }
            for (int i = gt; i < M * 2; i += NGT) stz[i] = 0.f;
        }
        for (int item = F.vcu; item < (M / 64) * 8; item += F.G) conv_item(F, args, item);
        if (BOTH(2)) GRID_BAR(); }
    if (IN(3)) {
        unsigned char* ws = args.ws;
        { int item = F.vcu;
          for (; item < 256; item += F.G) ssd_item(F, args, item, 1);
          if (item < 1280) ssd_item(F, args, item, (1280 - item + F.G - 1) / F.G); }
        {
            pg8::SegOrder S; S.nseg = 4; S.G = F.G; S.c = (int)blockIdx.x; S.dup = DIAG_DUP_G2;
            const size_t pt = (size_t)256 * 512 * 2;
            S.s[0] = pg8::Seg{(const char*)(ws + WS_QAN), (const char*)(ws + WS_WQ), M / 256, 12, 0, (M / 256) * 12, pt, pt};
            S.s[1] = pg8::Seg{(const char*)(ws + WS_CKVN), (const char*)(ws + WS_WUK), MP / 256, 8, 816, 512, pt, pt};
            S.s[2] = pg8::Seg{(const char*)(ws + WS_CKVN), (const char*)(ws + WS_WUV), MP / 256, 8, 1328, 512, pt, pt};
            S.s[3] = pg8::Seg{(const char*)(ws + WS_QAN) + (size_t)MP * 512 * 2, (const char*)(ws + WS_WQL), MS / 256, 32, 1840, 128, pt, pt};
            S.total = 1968;
            EpiStore E{(bf16_t*)(ws + WS_Q), (bf16_t*)(ws + WS_KN), (bf16_t*)(ws + WS_V), (bf16_t*)(ws + WS_QLAT), 3072, 2048, 2048, 8192};
            pg8::gemm_phase<EpiStore, pg8::SegOrder>(F.lds, 512, 512, 512, S, E);
        }
        if (BOTH(3)) GRID_BAR();
    }
    if (IN(4)) for (int rep = 0; rep < NREP(4); ++rep) {
        constexpr int NNORM = M / 64;
        const int NITEMS = 128 + NNORM + 1024;
        const bool pin_mode = F.G >= 256;
        bool pinned = pin_mode && (F.vcu & 1) == 0 && (F.vcu >> 1) < 128;
        for (;;) {
            __syncthreads();
            if (F.tid == 0) MISC[0] = pinned ? (unsigned)(F.vcu >> 1) : (pin_mode ? 128u : 0u) + __hip_atomic_fetch_add(ctl + CW_QUEUE + 64 * rep, 1u, __ATOMIC_RELAXED, __HIP_MEMORY_SCOPE_AGENT);
            __syncthreads();
            pinned = false;
            const int item = (int)MISC[0];
            if (item >= NITEMS) break;
            if (item < 128) attn_sample_item<0>(F, item >> 2, item & 3);
            else if (item >= 128 + 1024) yz_norm_item(F, args.in[13], item - 128 - 1024);
            else { const int j = item - 128, qb = 7 - (j >> 7), bh = j & 127; attn_prompt_unit<0>(F, bh >> 4, bh & 15, qb); }
        }
        if (BOTH(4)) GRID_BAR();
    }
    if (IN(5)) for (int rep = 0; rep < NREP(5); ++rep) {
        unsigned char* ws = args.ws;
        MixOrder S{(const char*)(ws + WS_YZ), (const char*)(ws + WS_WSSM), (const char*)(ws + WS_O), (const char*)(ws + WS_WMLA), F.G, (int)blockIdx.x};
        EpiMix E{(const bf16_t*)(ws + WS_G), args.in[7], (bf16_t*)(ws + WS_T1), (bf16_t*)(ws + WS_U)};
        pg8::gemm_phase<EpiMix, MixOrder>(F.lds, 2048, 2048, 2048, S, E);
        for (int tile = F.vcu; tile < 256; tile += F.G) {
            const int rt = tile >> 4, ctile = tile & 15, row = MP + rt * 64 + (F.tid >> 3), col = ctile * 64 + (F.tid & 7) * 8;
            const bf16_t* gp = (const bf16_t*)(ws + WS_G) + (size_t)row * 2048 + col; const float* bg = args.in[7] + col;
            float v[8], r1[8];
            sgemm_tile<2048>(F, (const bf16_t*)(ws + WS_YZ) + (size_t)(MP + rt * 64) * 2048, 2048, (const bf16_t*)(ws + WS_WSSM) + (size_t)(ctile * 64) * 2048, 2048, v);
            { const u32x4 gv = *(const u32x4*)gp;
#pragma unroll
              for (int e = 0; e < 8; ++e) { const float gg = (e & 1) ? bfhi(gv[e >> 1]) : bflo(gv[e >> 1]); r1[e] = sigmoidf_(gg + bg[e]) * v[e]; } }
            sgemm_tile<2048>(F, (const bf16_t*)(ws + WS_O) + (size_t)(MP + rt * 64) * 2048, 2048, (const bf16_t*)(ws + WS_WMLA) + (size_t)(ctile * 64) * 2048, 2048, v);
            { const u32x4 gv = *(const u32x4*)(gp + 1024);
#pragma unroll
              for (int e = 0; e < 8; ++e) { const float gg = (e & 1) ? bfhi(gv[e >> 1]) : bflo(gv[e >> 1]); r1[e] += sigmoidf_(gg + bg[1024 + e]) * v[e]; } }
            *(u32x4*)((bf16_t*)(ws + WS_U) + (size_t)row * 1024 + col) = (u32x4){pk2(r1[0], r1[1]), pk2(r1[2], r1[3]), pk2(r1[4], r1[5]), pk2(r1[6], r1[7])};
        }
        if (BOTH(5)) GRID_BAR();
    }
    if (IN(6)) for (int rep = 0; rep < NREP(6); ++rep) {
        unsigned char* ws = args.ws;
        pg8::SegOrder S; S.nseg = 1; S.G = F.G; S.c = (int)blockIdx.x; S.dup = 1;
        S.s[0] = pg8::Seg{(const char*)(ws + WS_U), (const char*)(ws + WS_WOUT), MP / 256, 4, 0, (MP / 256) * 4, (size_t)256 * 1024 * 2, (size_t)256 * 1024 * 2}; S.total = S.s[0].count;
        EpiV1 E{(const bf16_t*)(ws + WS_XB), (bf16_t*)(ws + WS_HB), (float*)(ws + WS_ST)};
        pg8::gemm_phase<EpiV1, pg8::SegOrder>(F.lds, 1024, 1024, 1024, S, E);
        for (int tile = F.vcu; tile < 256; tile += F.G) {
            const int rt = tile >> 4, ctile = tile & 15, row = MP + rt * 64 + (F.tid >> 3), col = ctile * 64 + (F.tid & 7) * 8;
            float v[8];
            sgemm_tile<1024>(F, (const bf16_t*)(ws + WS_U) + (size_t)(MP + rt * 64) * 1024, 1024, (const bf16_t*)(ws + WS_WOUT) + (size_t)(ctile * 64) * 1024, 1024, v);
            const float* xr = args.in[1] + (size_t)(row - MP) * 1024 + col; const f32x4 x0 = *(const f32x4*)xr, x1 = *(const f32x4*)(xr + 4);
            const f32x4 a = (f32x4){x0[0] * ALPHA + v[0], x0[1] * ALPHA + v[1], x0[2] * ALPHA + v[2], x0[3] * ALPHA + v[3]}, b = (f32x4){x1[0] * ALPHA + v[4], x1[1] * ALPHA + v[5], x1[2] * ALPHA + v[6], x1[3] * ALPHA + v[7]};
            *(u32x4*)((bf16_t*)(ws + WS_HB) + (size_t)row * 1024 + col) = (u32x4){pk2(a[0], a[1]), pk2(a[2], a[3]), pk2(b[0], b[1]), pk2(b[2], b[3])};
            float s1 = ((a[0] + a[1]) + (a[2] + a[3])) + ((b[0] + b[1]) + (b[2] + b[3]));
            float s2 = ((a[0] * a[0] + a[1] * a[1]) + (a[2] * a[2] + a[3] * a[3])) + ((b[0] * b[0] + b[1] * b[1]) + (b[2] * b[2] + b[3] * b[3]));
            s1 += __shfl_xor(s1, 1); s1 += __shfl_xor(s1, 2); s1 += __shfl_xor(s1, 4); s2 += __shfl_xor(s2, 1); s2 += __shfl_xor(s2, 2); s2 += __shfl_xor(s2, 4);
            if ((F.tid & 7) == 0) { float* stp = (float*)(ws + WS_ST) + 2 * (size_t)row; atomicAdd(stp, s1); atomicAdd(stp + 1, s2); }
        }
        if (BOTH(6)) GRID_BAR();
    }
    if (IN(8)) for (int rep = 0; rep < NREP(8); ++rep) {
        unsigned char* ws = args.ws;
        pg8::SegOrder S; S.nseg = 1; S.G = F.G; S.c = (int)blockIdx.x; S.dup = 1;
        S.s[0] = pg8::Seg{(const char*)(ws + WS_HB), (const char*)(ws + WS_WUP), M / 256, 16, 0, (M / 256) * 16, (size_t)256 * 1024 * 2, (size_t)256 * 1024 * 2}; S.total = S.s[0].count;
        EpiRelu2 E{(bf16_t*)(ws + WS_A1), (const float*)(ws + WS_ST), (const float*)(ws + WS_GW)};
        pg8::gemm_phase<EpiRelu2, pg8::SegOrder>(F.lds, 1024, 1024, 1024, S, E);
        if (BOTH(8)) GRID_BAR();
    }
    if (IN(9)) for (int rep = 0; rep < NREP(9); ++rep) {
        unsigned char* ws = args.ws;
        pg8::SegOrder S; S.nseg = 1; S.G = F.G; S.c = (int)blockIdx.x; S.dup = 1;
        S.s[0] = pg8::Seg{(const char*)(ws + WS_A1), (const char*)(ws + WS_WDOWN), MP / 256, 4, 0, (MP / 256) * 4, (size_t)256 * 4096 * 2, (size_t)256 * 4096 * 2}; S.total = S.s[0].count;
        EpiV2 E{(const bf16_t*)(ws + WS_HB), (const float*)(ws + WS_ST), args.in[22], args.in[23], (bf16_t*)(ws + WS_V2)};
        pg8::gemm_phase<EpiV2, pg8::SegOrder>(F.lds, 4096, 4096, 4096, S, E);
        for (int tile = F.vcu; tile < 256; tile += F.G) {
            const int rt = tile >> 4, ctile = tile & 15, row = MP + rt * 64 + (F.tid >> 3), col = ctile * 64 + (F.tid & 7) * 8;
            float v[8];
            sgemm_tile<4096>(F, (const bf16_t*)(ws + WS_A1) + (size_t)(MP + rt * 64) * 4096, 4096, (const bf16_t*)(ws + WS_WDOWN) + (size_t)(ctile * 64) * 4096, 4096, v);
            const u32x4 xv = *(const u32x4*)((const bf16_t*)(ws + WS_HB) + (size_t)row * 1024 + col); const f32x4 x0 = (f32x4){bflo(xv[0]), bfhi(xv[0]), bflo(xv[1]), bfhi(xv[1])}, x1 = (f32x4){bflo(xv[2]), bfhi(xv[2]), bflo(xv[3]), bfhi(xv[3])};
            const f32x2 ss = *(const f32x2*)((const float*)(ws + WS_ST) + 2 * (size_t)row); const float mu = ss.x * (1.f / 1024.f), rs = 1.0f / sqrtf(ss.y * (1.f / 1024.f) - mu * mu + LN_EPS);
            const f32x4 g0 = *(const f32x4*)(args.in[22] + col), g1v = *(const f32x4*)(args.in[22] + col + 4), b0 = *(const f32x4*)(args.in[23] + col), b1v = *(const f32x4*)(args.in[23] + col + 4);
            const f32x4 h0 = (x0 - mu) * rs * g0 + b0, h1 = (x1 - mu) * rs * g1v + b1v;
            *(u32x4*)((bf16_t*)(ws + WS_V2) + (size_t)row * 1024 + col) = (u32x4){pk2(h0[0] * ALPHA + v[0], h0[1] * ALPHA + v[1]), pk2(h0[2] * ALPHA + v[2], h0[3] * ALPHA + v[3]), pk2(h1[0] * ALPHA + v[4], h1[1] * ALPHA + v[5]), pk2(h1[2] * ALPHA + v[6], h1[3] * ALPHA + v[7])};
        }
        if (BOTH(9)) GRID_BAR();
    }
    if (IN(10)) { ln_rows<true>(F, (const void*)(args.ws + WS_V2), args.in[26], args.in[27], nullptr, nullptr); }
#undef IN
#undef BOTH
}

extern "C" void kernel_launch(void* const* d_in, const int* in_sizes, int n_in, void* d_out, int out_size, void* d_ws, size_t ws_size, hipStream_t stream) {
    static int grid = 0;
    if (grid == 0) {
        int dev = 0, cus = 0;
        if (hipGetDevice(&dev) != hipSuccess || hipDeviceGetAttribute(&cus, hipDeviceAttributeMultiprocessorCount, dev) != hipSuccess) { fprintf(stderr, "kernel_launch: device query failed\n"); grid = -1; return; }
        if (hipFuncSetAttribute((const void*)fwd_kernel, hipFuncAttributeMaxDynamicSharedMemorySize, LDS_BYTES) != hipSuccess) { fprintf(stderr, "kernel_launch: hipFuncSetAttribute failed\n"); grid = -1; return; }
        int per_cu = 0;
        (void)hipOccupancyMaxActiveBlocksPerMultiprocessor(&per_cu, (const void*)fwd_kernel, NTHREADS, LDS_BYTES);
        (void)hipGetLastError();
        if (ws_size < WS_END) { fprintf(stderr, "kernel_launch: workspace too small (%zu < %zu)\n", ws_size, (size_t)WS_END); grid = -1; return; }
        grid = cus;
    }
    if (grid < 0) return;
    (void)hipMemsetAsync((char*)d_ws + WS_CTL, 0, CTL_ZERO_BYTES, stream);
    Args a{};
    for (int i = 0; i < 28; ++i) a.in[i] = (const float*)d_in[i];
    a.out = (float*)d_out; a.ws = (unsigned char*)d_ws;
#if MK_PER_PHASE
    for (int p = 0; p < N_PHASES; ++p) { a.ph_lo = p; a.ph_hi = p + 1; hipLaunchKernelGGL(fwd_kernel, dim3(grid), dim3(NTHREADS), LDS_BYTES, stream, a); }
#else
    a.ph_lo = 0; a.ph_hi = N_PHASES; hipLaunchKernelGGL(fwd_kernel, dim3(grid), dim3(NTHREADS), LDS_BYTES, stream, a);
#endif
}
```
